# Optimizing an MI355X kernel written in HIP

```python
import math
import jax, jax.numpy as jnp
from jax import lax
import numpy as np

D_MODEL = 1024
BATCH = 16
SEQ = 4096
DEPTH = 1

N_HEADS = 8
HEAD_DIM = D_MODEL // (2 * N_HEADS)
V_DIM = 2 * HEAD_DIM
ATT_QK_WIDTH = N_HEADS * 2 * HEAD_DIM
ATT_V_WIDTH = N_HEADS * V_DIM
ROPE_DIM = HEAD_DIM // 4
ROPE_THETA = 500000.0
Q_BLOCK = 128
POOL_WINDOWS = (2, 4, 8, 16)
N_POOL_GROUPS = 4
POOL_GROUP_IN = 128
POOL_WIDTH = N_POOL_GROUPS * POOL_GROUP_IN
POOL_GROUP_OUT = D_MODEL // N_POOL_GROUPS
N_BRANCHES = 2
D_FF = 4 * D_MODEL
IN_WIDTH = 2 * ATT_QK_WIDTH + ATT_V_WIDTH + POOL_WIDTH + N_BRANCHES * D_MODEL
RMS_EPS = 1e-6

kernel_name = "hybrid_diffattn_pool_gated_block"


def lambda_init(layer_idx):
    return 0.8 - 0.6 * math.exp(-0.3 * layer_idx)


def rmsnorm(x, g):
    xf = x.astype(jnp.float32)
    y = xf * lax.rsqrt(jnp.mean(xf * xf, axis=-1, keepdims=True) + RMS_EPS)
    return (y * g.astype(jnp.float32)).astype(x.dtype)


def rope_partial(t, cos, sin):
    half = ROPE_DIM // 2
    t1 = t[..., :half]
    t2 = t[..., half:ROPE_DIM]
    rest = t[..., ROPE_DIM:]
    return jnp.concatenate([t1 * cos - t2 * sin, t2 * cos + t1 * sin, rest], axis=-1)


def diff_attention(q, k, v, positions, lam, subln_g, lam_init):
    B, S = q.shape[0], q.shape[1]
    inv_freq = ROPE_THETA ** (-jnp.arange(0, ROPE_DIM, 2, dtype=jnp.float32) / ROPE_DIM)
    ang = positions.astype(jnp.float32)[..., None] * inv_freq
    cos = jnp.cos(ang)[:, :, None, :].astype(q.dtype)
    sin = jnp.sin(ang)[:, :, None, :].astype(q.dtype)
    q = rope_partial(q.reshape(B, S, N_HEADS * 2, HEAD_DIM), cos, sin).reshape(B, S, N_HEADS, 2, HEAD_DIM)
    k = rope_partial(k.reshape(B, S, N_HEADS * 2, HEAD_DIM), cos, sin).reshape(B, S, N_HEADS, 2, HEAD_DIM)
    q = q * (HEAD_DIM ** -0.5)
    outs = []
    for i in range(S // Q_BLOCK):
        q0 = i * Q_BLOCK
        kend = q0 + Q_BLOCK
        qb = q[:, q0:kend]
        kb = k[:, :kend]
        vb = v[:, :kend]
        s = jnp.einsum('bqhcd,bkhcd->bhcqk', qb, kb).astype(jnp.float32)
        mask = jnp.arange(kend)[None, :] <= (q0 + jnp.arange(Q_BLOCK))[:, None]
        s = jnp.where(mask, s, -jnp.inf)
        p = jax.nn.softmax(s, axis=-1)
        w = p[:, :, 0] - lam * p[:, :, 1]
        outs.append(jnp.einsum('bhqk,bkhd->bqhd', w.astype(v.dtype), vb))
    o = jnp.concatenate(outs, axis=1)
    o = rmsnorm(o, subln_g) * (1.0 - lam_init)
    return o.reshape(B, S, ATT_V_WIDTH)


def multiscale_pool(u, w_pool, pool_scale):
    B, S = u.shape[0], u.shape[1]
    uf = u.astype(jnp.float32).reshape(B, S, N_POOL_GROUPS, POOL_GROUP_IN)
    c = lax.cumsum(uf, axis=1)
    idx = jnp.arange(S)
    parts = []
    for g, w in enumerate(POOL_WINDOWS):
        cg = c[:, :, g]
        c_prev = jnp.pad(cg, ((0, 0), (w, 0), (0, 0)))[:, :S]
        cnt = jnp.minimum(idx + 1, w).astype(jnp.float32)[None, :, None]
        parts.append((cg - c_prev) / cnt - uf[:, :, g])
    d = jnp.stack(parts, axis=2).astype(u.dtype)
    y = jnp.einsum('bsgc,gcd->bsgd', d, w_pool).reshape(B, S, D_MODEL)
    return y * pool_scale


def setup_inputs(seed: int = 0) -> dict:
    key = jax.random.key(seed)
    ks = jax.random.split(key, 18)
    f32 = jnp.float32
    x = jax.random.normal(ks[0], (BATCH, SEQ, D_MODEL), f32)
    offs = jax.random.randint(ks[1], (BATCH, 1), 0, 1024, dtype=jnp.int32)
    positions = (offs + jnp.arange(SEQ, dtype=jnp.int32)[None, :]).astype(jnp.int32)
    gain = lambda k, n: 1.0 + 0.02 * jax.random.normal(k, (DEPTH, n), f32)
    return {
        "x": x,
        "positions": positions,
        "norm_attn_g": gain(ks[2], D_MODEL),
        "w_in": jax.random.normal(ks[3], (DEPTH, D_MODEL, IN_WIDTH), f32) * D_MODEL ** -0.5,
        "lam_q1": 0.1 * jax.random.normal(ks[4], (DEPTH, HEAD_DIM), f32),
        "lam_k1": 0.1 * jax.random.normal(ks[5], (DEPTH, HEAD_DIM), f32),
        "lam_q2": 0.1 * jax.random.normal(ks[6], (DEPTH, HEAD_DIM), f32),
        "lam_k2": 0.1 * jax.random.normal(ks[7], (DEPTH, HEAD_DIM), f32),
        "subln_g": gain(ks[8], V_DIM),
        "w_pool": jax.random.normal(ks[9], (DEPTH, N_POOL_GROUPS, POOL_GROUP_IN, POOL_GROUP_OUT), f32) * POOL_GROUP_IN ** -0.5,
        "pool_scale": 1.0 + 0.1 * jax.random.normal(ks[10], (DEPTH, D_MODEL), f32),
        "w_out": jax.random.normal(ks[11], (DEPTH, D_MODEL, D_MODEL), f32) * D_MODEL ** -0.5,
        "norm_mlp_g": gain(ks[12], D_MODEL),
        "w_up": jax.random.normal(ks[13], (DEPTH, D_MODEL, D_FF), f32) * D_MODEL ** -0.5,
        "w_down": jax.random.normal(ks[14], (DEPTH, D_FF, D_MODEL), f32) * D_FF ** -0.5,
        "final_norm_g": 1.0 + 0.02 * jax.random.normal(ks[15], (D_MODEL,), f32),
    }


def reference(x, positions, norm_attn_g, w_in, lam_q1, lam_k1, lam_q2, lam_k2, subln_g,
              w_pool, pool_scale, w_out, norm_mlp_g, w_up, w_down, final_norm_g):
    B, S = x.shape[0], x.shape[1]
    splits = np.cumsum([ATT_QK_WIDTH, ATT_QK_WIDTH, ATT_V_WIDTH, POOL_WIDTH]).tolist()
    for l in range(DEPTH):
        lam_init = lambda_init(l)
        h = rmsnorm(x, norm_attn_g[l])
        u = h @ w_in[l]
        u_q, u_k, u_v, u_pool, u_gate = jnp.split(u, splits, axis=-1)
        q = u_q.reshape(B, S, N_HEADS, 2, HEAD_DIM)
        k = u_k.reshape(B, S, N_HEADS, 2, HEAD_DIM)
        v = u_v.reshape(B, S, N_HEADS, V_DIM)
        lam = (jnp.exp(jnp.sum(lam_q1[l].astype(jnp.float32) * lam_k1[l].astype(jnp.float32)))
               - jnp.exp(jnp.sum(lam_q2[l].astype(jnp.float32) * lam_k2[l].astype(jnp.float32)))
               + lam_init)
        a = diff_attention(q, k, v, positions, lam, subln_g[l], lam_init)
        p = multiscale_pool(u_pool, w_pool[l], pool_scale[l])
        gates = jax.nn.sigmoid(u_gate.reshape(B, S, N_BRANCHES, D_MODEL))
        merged = gates[:, :, 0] * a + gates[:, :, 1] * p
        x = x + (merged @ w_out[l]).astype(x.dtype)
        h2 = rmsnorm(x, norm_mlp_g[l])
        z = jnp.square(jax.nn.relu(h2 @ w_up[l]))
        x = x + (z @ w_down[l]).astype(x.dtype)
    return rmsnorm(x, final_norm_g)
```

```cpp
#include <hip/hip_runtime.h>
#include <hip/hip_cooperative_groups.h>
#include <cstdio>
#include <cstdint>
#include <cmath>
namespace cg = cooperative_groups;
template <int K> __device__ __forceinline__ float xor_swz(float v) { return __int_as_float(__builtin_amdgcn_ds_swizzle(__float_as_int(v), (K << 10) | 0x1f)); }
__device__ __forceinline__ float half_sum(float v) { auto rr = __builtin_amdgcn_permlane32_swap(__float_as_uint(v), __float_as_uint(v), false, false); return __uint_as_float(rr[0]) + __uint_as_float(rr[1]); }
__device__ __forceinline__ float half_max(float v) { auto rr = __builtin_amdgcn_permlane32_swap(__float_as_uint(v), __float_as_uint(v), false, false); return fmaxf(__uint_as_float(rr[0]), __uint_as_float(rr[1])); }
namespace pg8 {
#define PG8_LAS __attribute__((address_space(3)))
typedef unsigned short bf16_t;
typedef short bf16x8 __attribute__((ext_vector_type(8)));
typedef float f32x4 __attribute__((ext_vector_type(4)));
typedef unsigned u32x4 __attribute__((ext_vector_type(4)));
constexpr int BM = 256, BK = 64, HALF = 128, HTB = HALF * BK * 2  , STAGE_BYTES = 8 * HTB, NXCD = 8, WGM = 8;

__host__ __device__ __forceinline__ int lds_byte(int r, int c) { const int st = (r >> 4) * 2 + (c >> 5), rr = r & 15, cc = c & 31, ob = rr * 64 + cc * 2; return st * 1024 + (ob ^ (((ob >> 9) & 1) << 5)); }
__host__ __device__ __forceinline__ void stage_rc(int b, int& R, int& C) { const int st = b / 1024, sb = b % 1024, swz = sb ^ (((sb >> 9) & 1) << 5); R = (st >> 1) * 16 + swz / 64; C = (st & 1) * 32 + (swz % 64) / 2; }
__host__ __device__ __forceinline__ int perm32(int rho) { const int n = rho >> 4, i = rho & 15; return 8 * (i >> 2) + 4 * n + (i & 3); }

struct Unit { int pm, pn; };
struct Gemm { const bf16_t* A; const bf16_t* Bt; int M, N, K; size_t a_pn_off; };

struct StaticOrder {
    int nM, nN, nwg, G, c;
    __host__ __device__ void init(int M, int N, int G_, int c_) { nM = M / BM; nN = N / BM; nwg = nM * nN; G = G_; c = c_; }
    __host__ __device__ bool next(int i, Unit& u) const {
        const long L = (long)i * G + c; if (L >= nwg) return false;
        int wgid = (int)L; { const int q = nwg / NXCD, r = nwg % NXCD, xcd = wgid % NXCD, off = wgid / NXCD; wgid = (xcd < r ? xcd * (q + 1) : r * (q + 1) + (xcd - r) * q) + off; }
        const int nig = WGM * nN, gid = wgid / nig, fm = gid * WGM, gsz = (nM - fm) < WGM ? (nM - fm) : WGM;
        u.pm = fm + ((wgid % nig) % gsz); u.pn = (wgid % nig) / gsz; return true;
    }
    __device__ __forceinline__ void a_ready(const Unit&) const {}
    __device__ __forceinline__ void done(const Unit&) const {}
};

__device__ __forceinline__ unsigned cvt_pk_bf16(float lo, float hi) { unsigned r; asm volatile("v_cvt_pk_bf16_f32 %0, %1, %2" : "=v"(r) : "v"(lo), "v"(hi)); return r; }
typedef float f32x2 __attribute__((ext_vector_type(2)));
template <class Epi, class Sched, bool ALIGN_EPI = false, bool SP2 = false>
__device__ __forceinline__ void gemm_phase(PG8_LAS unsigned char* lds, const Gemm g, const Sched& S, const Epi& E) {
    int tid = threadIdx.x; asm volatile("" : "+v"(tid));
    const int wid = __builtin_amdgcn_readfirstlane(tid >> 6), lane = tid & 63, wr = wid >> 2, wc = wid & 3, fr = lane & 15, fq = lane >> 4;
    const int K = g.K, nt = K / BK;
    unsigned voffA[2], voffB[2];
#pragma unroll
    for (int i = 0; i < 2; ++i) { int R, C; stage_rc(tid * 16 + i * 8192, R, C); const int Rb = Epi::PERM ? ((R & ~31) + perm32(R & 31)) : R;
        voffA[i] = (unsigned)(R * K + C) * 2u; voffB[i] = (unsigned)(Rb * K + C) * 2u; }
    const size_t kstep = (size_t)(BK * 2);
    const size_t hstep = (size_t)HALF * K * 2;
    const size_t tstep = 2 * hstep;
    const unsigned ldsw = (unsigned)wid * 1024u;
    const int aoff = lds_byte(wr * 64 + fr, fq * 8), boff = lds_byte(wc * 32 + fr, fq * 8);
#define PG8_SA(b, h) (((b) * 2 + (h)) * HTB)
#define PG8_SB(b, h) ((4 + (b) * 2 + (h)) * HTB)
#define PG8_STAGE(bufoff, gbase, voff) do { _Pragma("unroll") for (int _i = 0; _i < 2; ++_i) \
        __builtin_amdgcn_global_load_lds((const unsigned*)((const char*)(gbase) + (voff)[_i]), (PG8_LAS unsigned*)(lds + (bufoff) + ldsw + _i * 8192), 16, 0, 0); } while (0)
#define PG8_LDA(dst, b, h) do { _Pragma("unroll") for (int m = 0; m < 4; ++m) _Pragma("unroll") for (int k = 0; k < 2; ++k) dst[m][k] = *(const PG8_LAS bf16x8*)(lds + PG8_SA(b, h) + aoff + m * 2048 + k * 1024); } while (0)
#define PG8_LDB(dst, b, h) do { _Pragma("unroll") for (int n = 0; n < 2; ++n) _Pragma("unroll") for (int k = 0; k < 2; ++k) dst[n][k] = *(const PG8_LAS bf16x8*)(lds + PG8_SB(b, h) + boff + n * 2048 + k * 1024); } while (0)
#define PG8_MMA(ai, bj, At, Bt) do { __builtin_amdgcn_s_setprio(1); _Pragma("unroll") for (int m = 0; m < 4; ++m) _Pragma("unroll") for (int n = 0; n < 2; ++n) _Pragma("unroll") for (int k = 0; k < 2; ++k) \
        acc[ai][bj][m][n] = __builtin_amdgcn_mfma_f32_16x16x32_bf16(Bt[n][k], At[m][k], acc[ai][bj][m][n], 0, 0, 0); __builtin_amdgcn_s_setprio(0); } while (0)
#define PG8_WAIT_V(n) asm volatile("s_waitcnt vmcnt(" #n ")" ::: "memory")
#define PG8_WAIT_L(n) asm volatile("s_waitcnt lgkmcnt(" #n ")" ::: "memory")
#define PG8_BAR __builtin_amdgcn_s_barrier()
#define PG8_SCHED __builtin_amdgcn_sched_barrier(0)
    Unit cur, nxt; int ui = 0;
    if (!S.next(0, cur)) return;
    f32x4 acc[2][2][4][2];
#pragma unroll
    for (int a = 0; a < 2; ++a)
#pragma unroll
        for (int b = 0; b < 2; ++b)
#pragma unroll
            for (int m = 0; m < 4; ++m)
#pragma unroll
                for (int n = 0; n < 2; ++n) acc[a][b][m][n] = (f32x4){0.f, 0.f, 0.f, 0.f};
    bf16x8 At[4][2], B0[2][2], B1[2][2];
    const char* cA = (const char*)g.A + (size_t)cur.pm * tstep + (size_t)cur.pn * g.a_pn_off; const char* cB = (const char*)g.Bt + (size_t)cur.pn * tstep;
    S.a_ready(cur);
    if constexpr (SP2) {
        PG8_STAGE(PG8_SB(0, 0), cB, voffB); PG8_STAGE(PG8_SB(0, 1), cB + hstep, voffB); PG8_STAGE(PG8_SA(0, 0), cA, voffA); PG8_STAGE(PG8_SA(0, 1), cA + hstep, voffA);
        if (wr == 1) PG8_BAR;
        PG8_WAIT_V(2); PG8_BAR;
        PG8_STAGE(PG8_SB(1, 0), cB + kstep, voffB); PG8_STAGE(PG8_SA(1, 0), cA + kstep, voffA); PG8_STAGE(PG8_SB(1, 1), cB + hstep + kstep, voffB);
        PG8_WAIT_V(6); PG8_BAR;
    } else {
        PG8_STAGE(PG8_SB(0, 0), cB, voffB); PG8_STAGE(PG8_SA(0, 0), cA, voffA); PG8_STAGE(PG8_SB(0, 1), cB + hstep, voffB); PG8_STAGE(PG8_SA(0, 1), cA + hstep, voffA);
        if (wr == 1) PG8_BAR;
        PG8_WAIT_V(4); PG8_BAR;
        PG8_STAGE(PG8_SB(1, 0), cB + kstep, voffB); PG8_STAGE(PG8_SA(1, 0), cA + kstep, voffA); PG8_STAGE(PG8_SB(1, 1), cB + hstep + kstep, voffB);
        PG8_WAIT_V(6); PG8_BAR;
    }
    for (;;) {
        const bool has_next = S.next(ui + 1, nxt);
        const char* nA = has_next ? (const char*)g.A + (size_t)nxt.pm * tstep + (size_t)nxt.pn * g.a_pn_off : cA; const char* nB = has_next ? (const char*)g.Bt + (size_t)nxt.pn * tstep : cB;
        for (int t = 0; t < nt; t += 2) {
            const bool last = (t == nt - 2);
            const char* a1 = cA + (size_t)(t + 1) * kstep;
            const char* a2 = last ? nA : cA + (size_t)(t + 2) * kstep; const char* b2 = last ? nB : cB + (size_t)(t + 2) * kstep;
            const char* a3 = a2 + kstep; const char* b3 = b2 + kstep;
            if (last && has_next) S.a_ready(nxt);
            if constexpr (SP2) {
            PG8_LDB(B0, 0, 0); PG8_LDB(B1, 0, 1); PG8_SCHED; PG8_LDA(At, 0, 0); PG8_STAGE(PG8_SA(1, 1), a1 + hstep, voffA);
            PG8_WAIT_V(8); PG8_WAIT_L(0); PG8_BAR; PG8_MMA(0, 0, At, B0); PG8_MMA(0, 1, At, B1); PG8_BAR; PG8_SCHED;
            PG8_LDA(At, 0, 1); PG8_STAGE(PG8_SB(0, 0), b2, voffB); PG8_STAGE(PG8_SB(0, 1), b2 + hstep, voffB); PG8_STAGE(PG8_SA(0, 0), a2, voffA);
            PG8_WAIT_V(8); PG8_WAIT_L(0); PG8_BAR; PG8_MMA(1, 0, At, B0); PG8_MMA(1, 1, At, B1); PG8_BAR; PG8_SCHED;
            PG8_LDB(B0, 1, 0); PG8_LDB(B1, 1, 1); PG8_SCHED; PG8_LDA(At, 1, 0); PG8_STAGE(PG8_SA(0, 1), a2 + hstep, voffA);
            PG8_WAIT_V(8); PG8_WAIT_L(0); PG8_BAR; PG8_MMA(0, 0, At, B0); PG8_MMA(0, 1, At, B1); PG8_BAR; PG8_SCHED;
            PG8_LDA(At, 1, 1); PG8_STAGE(PG8_SB(1, 0), b3, voffB); PG8_STAGE(PG8_SB(1, 1), b3 + hstep, voffB); PG8_STAGE(PG8_SA(1, 0), a3, voffA);
            PG8_WAIT_V(8); PG8_WAIT_L(0); PG8_BAR; PG8_MMA(1, 0, At, B0); PG8_MMA(1, 1, At, B1); PG8_BAR; PG8_SCHED;
            } else {
            PG8_LDB(B0, 0, 0); PG8_SCHED; PG8_LDA(At, 0, 0); PG8_STAGE(PG8_SA(1, 1), a1 + hstep, voffA);
            PG8_WAIT_L(8); PG8_BAR; PG8_WAIT_L(0); PG8_MMA(0, 0, At, B0); PG8_BAR; PG8_SCHED;
            PG8_LDB(B1, 0, 1); PG8_STAGE(PG8_SB(0, 0), b2, voffB);
            PG8_BAR; PG8_WAIT_L(0); PG8_MMA(0, 1, At, B1); PG8_BAR;
            PG8_LDA(At, 0, 1); PG8_STAGE(PG8_SA(0, 0), a2, voffA);
            PG8_BAR; PG8_WAIT_L(0); PG8_MMA(1, 0, At, B0); PG8_BAR; PG8_SCHED;
            PG8_STAGE(PG8_SB(0, 1), b2 + hstep, voffB);
            PG8_WAIT_V(6); PG8_BAR; PG8_MMA(1, 1, At, B1); PG8_BAR;
            PG8_LDB(B0, 1, 0); PG8_SCHED; PG8_LDA(At, 1, 0); PG8_STAGE(PG8_SA(0, 1), a2 + hstep, voffA);
            PG8_WAIT_L(8); PG8_BAR; PG8_WAIT_L(0); PG8_MMA(0, 0, At, B0); PG8_BAR; PG8_SCHED;
            PG8_LDB(B1, 1, 1); PG8_STAGE(PG8_SB(1, 0), b3, voffB);
            PG8_BAR; PG8_WAIT_L(0); PG8_MMA(0, 1, At, B1); PG8_BAR;
            PG8_LDA(At, 1, 1); PG8_STAGE(PG8_SA(1, 0), a3, voffA);
            PG8_BAR; PG8_WAIT_L(0); PG8_MMA(1, 0, At, B0); PG8_BAR; PG8_SCHED;
            PG8_STAGE(PG8_SB(1, 1), b3 + hstep, voffB);
            PG8_WAIT_V(6); PG8_BAR; PG8_MMA(1, 1, At, B1); PG8_BAR;
            }
        }
        if constexpr (ALIGN_EPI) { if (wr == 0) PG8_BAR; }
        if constexpr (!Epi::AFTER_DRAIN) { E(acc, cur, wr, wc, fr, fq); S.done(cur); }
        if (!has_next) break;
#pragma unroll
        for (int a = 0; a < 2; ++a)
#pragma unroll
            for (int b = 0; b < 2; ++b)
#pragma unroll
                for (int m = 0; m < 4; ++m)
#pragma unroll
                    for (int n = 0; n < 2; ++n) acc[a][b][m][n] = (f32x4){0.f, 0.f, 0.f, 0.f};
        cur = nxt; cA = nA; cB = nB; ++ui;
        if constexpr (ALIGN_EPI) { if (wr == 1) PG8_BAR; }
    }
    PG8_WAIT_V(0);
    if constexpr (!ALIGN_EPI) { if (wr == 0) PG8_BAR; }
    PG8_BAR;
    if constexpr (Epi::AFTER_DRAIN) { E.fused(acc, cur, wr, wc, fr, fq, lds, wid, lane); S.done(cur); }
#undef PG8_SA
#undef PG8_SB
#undef PG8_STAGE
#undef PG8_LDA
#undef PG8_LDB
#undef PG8_MMA
#undef PG8_WAIT_V
#undef PG8_WAIT_L
#undef PG8_BAR
#undef PG8_SCHED
}
}
namespace pg8 {
typedef unsigned u32x2 __attribute__((ext_vector_type(2)));
__device__ __forceinline__ float bf_lo(unsigned w) { return __uint_as_float(w << 16); }
__device__ __forceinline__ float bf_hi(unsigned w) { return __uint_as_float(w & 0xffff0000u); }
__device__ __forceinline__ u32x4 pack8(const f32x4 a, const f32x4 b) { u32x4 w; w.x = cvt_pk_bf16(a[0], a[1]); w.y = cvt_pk_bf16(a[2], a[3]); w.z = cvt_pk_bf16(b[0], b[1]); w.w = cvt_pk_bf16(b[2], b[3]); return w; }
constexpr float QSCALE = 0.125f * 1.4426950408889634f;

struct EpiIn {
    static constexpr bool PERM = true, AFTER_DRAIN = false;
    bf16_t *Q, *K, *V, *U, *G; const float* rope;
    __device__ __forceinline__ void operator()(const f32x4 (&acc)[2][2][4][2], const Unit& u, int wr, int wc, int fr, int fq) const {
        const int pn = u.pn; int kind, ldc, colt; bf16_t* base;
        if (pn < 4)       { kind = 0; base = Q; ldc = 1024; colt = pn * 256; }
        else if (pn < 8)  { kind = 1; base = K; ldc = 1024; colt = (pn - 4) * 256; }
        else if (pn < 12) { kind = 2; base = V; ldc = 1024; colt = (pn - 8) * 256; }
        else if (pn < 14) { kind = 2; base = U; ldc = 512;  colt = (pn - 12) * 256; }
        else              { kind = 3; base = G; ldc = 2048; colt = (pn - 14) * 256; }
        const int row0 = u.pm * BM + wr * 64 + fr, col0 = colt + wc * 32 + 8 * fq;
        const bool rl = ((wc & 1) == 0) && (fq < 2);
#pragma unroll
        for (int ai = 0; ai < 2; ++ai)
#pragma unroll
            for (int m = 0; m < 4; ++m) {
                const int row = row0 + ai * HALF + m * 16;
                bf16_t* rowp = base + (size_t)row * ldc + col0;
                if (kind <= 1) {
                    f32x4 c0, c1;
                    if (rl) { const f32x4* rp = (const f32x4*)(rope + (size_t)row * 16 + 8 * fq); c0 = rp[0]; c1 = rp[1]; }
#pragma unroll
                    for (int bj = 0; bj < 2; ++bj) {
                        f32x4 v0 = acc[ai][bj][m][0], v1 = acc[ai][bj][m][1];
                        if (rl) {
                            const float a0 = v0[0], b0 = v0[1], a1 = v0[2], b1 = v0[3], a2 = v1[0], b2 = v1[1], a3 = v1[2], b3 = v1[3];
                            v0[0] = a0 * c0[0] - b0 * c0[1]; v0[1] = b0 * c0[0] + a0 * c0[1]; v0[2] = a1 * c0[2] - b1 * c0[3]; v0[3] = b1 * c0[2] + a1 * c0[3];
                            v1[0] = a2 * c1[0] - b2 * c1[1]; v1[1] = b2 * c1[0] + a2 * c1[1]; v1[2] = a3 * c1[2] - b3 * c1[3]; v1[3] = b3 * c1[2] + a3 * c1[3];
                        }
                        if (kind == 0) { v0 = v0 * QSCALE; v1 = v1 * QSCALE; }
                        __builtin_nontemporal_store(pack8(v0, v1), (u32x4*)(rowp + bj * HALF));
                    }
                } else {
#pragma unroll
                    for (int bj = 0; bj < 2; ++bj) {
                        f32x4 v0 = acc[ai][bj][m][0], v1 = acc[ai][bj][m][1];
                        if (kind == 3) {
#pragma unroll
                            for (int e = 0; e < 4; ++e) { v0[e] = __builtin_amdgcn_rcpf(1.f + __builtin_amdgcn_exp2f(-1.4426950408889634f * v0[e])); v1[e] = __builtin_amdgcn_rcpf(1.f + __builtin_amdgcn_exp2f(-1.4426950408889634f * v1[e])); }
                        }
                        __builtin_nontemporal_store(pack8(v0, v1), (u32x4*)(rowp + bj * HALF));
                    }
                }
            }
    }
};

struct EpiMerge {
    static constexpr bool PERM = true, AFTER_DRAIN = false;
    const bf16_t* A; const bf16_t* G; const float* pscale; bf16_t* Mg;
    __device__ __forceinline__ void operator()(const f32x4 (&acc)[2][2][4][2], const Unit& u, int wr, int wc, int fr, int fq) const {
        const int row0 = u.pm * BM + wr * 64 + fr, col0 = u.pn * BM + wc * 32 + 8 * fq;
        f32x4 ps[2][2];
#pragma unroll
        for (int bj = 0; bj < 2; ++bj) { ps[bj][0] = *(const f32x4*)(pscale + col0 + bj * HALF); ps[bj][1] = *(const f32x4*)(pscale + col0 + bj * HALF + 4); }
#pragma unroll
        for (int ai = 0; ai < 2; ++ai)
#pragma unroll
            for (int m = 0; m < 4; ++m) {
                const size_t row = (size_t)(row0 + ai * HALF + m * 16);
#pragma unroll
                for (int bj = 0; bj < 2; ++bj) {
                    const int c = col0 + bj * HALF;
                    const u32x4 a8 = __builtin_nontemporal_load((const u32x4*)(A + row * 1024 + c)), ga = __builtin_nontemporal_load((const u32x4*)(G + row * 2048 + c)), gp = __builtin_nontemporal_load((const u32x4*)(G + row * 2048 + 1024 + c));
                    const f32x4 y0 = acc[ai][bj][m][0] * ps[bj][0], y1 = acc[ai][bj][m][1] * ps[bj][1];
                    f32x4 o0, o1;
                    o0[0] = bf_lo(ga.x) * bf_lo(a8.x) + bf_lo(gp.x) * y0[0]; o0[1] = bf_hi(ga.x) * bf_hi(a8.x) + bf_hi(gp.x) * y0[1];
                    o0[2] = bf_lo(ga.y) * bf_lo(a8.y) + bf_lo(gp.y) * y0[2]; o0[3] = bf_hi(ga.y) * bf_hi(a8.y) + bf_hi(gp.y) * y0[3];
                    o1[0] = bf_lo(ga.z) * bf_lo(a8.z) + bf_lo(gp.z) * y1[0]; o1[1] = bf_hi(ga.z) * bf_hi(a8.z) + bf_hi(gp.z) * y1[1];
                    o1[2] = bf_lo(ga.w) * bf_lo(a8.w) + bf_lo(gp.w) * y1[2]; o1[3] = bf_hi(ga.w) * bf_hi(a8.w) + bf_hi(gp.w) * y1[3];
                    __builtin_nontemporal_store(pack8(o0, o1), (u32x4*)(Mg + row * 1024 + c));
                }
                asm volatile("" ::: "memory");
            }
    }
};

struct EpiResA {
    static constexpr bool PERM = true, AFTER_DRAIN = false;
    const float* xi; bf16_t* xb; float* ssq;
    __device__ __forceinline__ void operator()(const f32x4 (&acc)[2][2][4][2], const Unit& u, int wr, int wc, int fr, int fq) const {
        const int row0 = u.pm * BM + wr * 64 + fr, col0 = u.pn * BM + wc * 32 + 8 * fq;
#pragma unroll
        for (int ai = 0; ai < 2; ++ai)
#pragma unroll
            for (int m = 0; m < 4; ++m) {
                const size_t row = (size_t)(row0 + ai * HALF + m * 16); float s = 0.f;
#pragma unroll
                for (int bj = 0; bj < 2; ++bj) {
                    const size_t off = row * 1024 + col0 + bj * HALF;
                    const f32x4 r0 = __builtin_nontemporal_load((const f32x4*)(xi + off)) + acc[ai][bj][m][0], r1 = __builtin_nontemporal_load((const f32x4*)(xi + off + 4)) + acc[ai][bj][m][1];
                    *(u32x4*)(xb + off) = pack8(r0, r1);
                    s += (r0[0] * r0[0] + r0[1] * r0[1]) + (r0[2] * r0[2] + r0[3] * r0[3]) + (r1[0] * r1[0] + r1[1] * r1[1]) + (r1[2] * r1[2] + r1[3] * r1[3]);
                }
                s += xor_swz<16>(s); s = half_sum(s);
                if (fq == 0) ssq[row * 16 + u.pn * 4 + wc] = s;
            }
    }
};
struct EpiResB {
    static constexpr bool PERM = true, AFTER_DRAIN = false;
    bf16_t* xb; float* ssq;
    __device__ __forceinline__ void operator()(const f32x4 (&acc)[2][2][4][2], const Unit& u, int wr, int wc, int fr, int fq) const {
        const int row0 = u.pm * BM + wr * 64 + fr, col0 = u.pn * BM + wc * 32 + 8 * fq;
#pragma unroll
        for (int ai = 0; ai < 2; ++ai)
#pragma unroll
            for (int m = 0; m < 4; ++m) {
                const size_t row = (size_t)(row0 + ai * HALF + m * 16); float s = 0.f;
#pragma unroll
                for (int bj = 0; bj < 2; ++bj) {
                    const size_t off = row * 1024 + col0 + bj * HALF;
                    const u32x4 w = __builtin_nontemporal_load((const u32x4*)(xb + off));
                    const f32x4 r0 = (f32x4){bf_lo(w.x), bf_hi(w.x), bf_lo(w.y), bf_hi(w.y)} + acc[ai][bj][m][0], r1 = (f32x4){bf_lo(w.z), bf_hi(w.z), bf_lo(w.w), bf_hi(w.w)} + acc[ai][bj][m][1];
                    __builtin_nontemporal_store(pack8(r0, r1), (u32x4*)(xb + off));
                    s += (r0[0] * r0[0] + r0[1] * r0[1]) + (r0[2] * r0[2] + r0[3] * r0[3]) + (r1[0] * r1[0] + r1[1] * r1[1]) + (r1[2] * r1[2] + r1[3] * r1[3]);
                }
                s += xor_swz<16>(s); s = half_sum(s);
                if (fq == 0) ssq[row * 16 + u.pn * 4 + wc] = s;
            }
    }
};

struct EpiUp {
    static constexpr bool PERM = true, AFTER_DRAIN = false;
    const float* ssq; bf16_t* Z;
    __device__ __forceinline__ void operator()(const f32x4 (&acc)[2][2][4][2], const Unit& u, int wr, int wc, int fr, int fq) const {
        const int row0 = u.pm * BM + wr * 64 + fr, col0 = u.pn * BM + wc * 32 + 8 * fq;
#pragma unroll
        for (int ai = 0; ai < 2; ++ai)
#pragma unroll
            for (int m = 0; m < 4; ++m) {
                const size_t row = (size_t)(row0 + ai * HALF + m * 16);
                const f32x4 pq = *(const f32x4*)(ssq + row * 16 + 4 * fq);
                float s = (pq[0] + pq[1]) + (pq[2] + pq[3]); s += xor_swz<16>(s); s = half_sum(s);
                const float rstd = __builtin_amdgcn_rsqf(s * (1.0f / 1024.0f) + 1e-6f);
#pragma unroll
                for (int bj = 0; bj < 2; ++bj) {
                    f32x4 v0 = acc[ai][bj][m][0] * rstd, v1 = acc[ai][bj][m][1] * rstd;
#pragma unroll
                    for (int e = 0; e < 4; ++e) { const float a = fmaxf(v0[e], 0.f), b = fmaxf(v1[e], 0.f); v0[e] = a * a; v1[e] = b * b; }
                    __builtin_nontemporal_store(pack8(v0, v1), (u32x4*)(Z + row * 4096 + col0 + bj * HALF));
                }
            }
    }
};
}
namespace att {
#define ATT_LAS __attribute__((address_space(3)))
typedef unsigned short bf16_t;
typedef short bf16x8 __attribute__((ext_vector_type(8)));
typedef short s16x4 __attribute__((ext_vector_type(4)));
typedef float f32x16 __attribute__((ext_vector_type(16)));
typedef unsigned u32x4 __attribute__((ext_vector_type(4)));
constexpr int SEQ = 4096, PITCH = 1024;
constexpr int KBUF = 0, VBUF = 32768, WSF = 65536, QBUF = 65536 + 4096, ATT_LDS_BYTES = QBUF + 8 * 8192;
constexpr float THR = 8.0f;
__device__ __forceinline__ int crow(int r, int hi) { return (r & 3) + 8 * (r >> 2) + 4 * hi; }
__device__ __forceinline__ int koffs(int row, int ch) { return row * 256 + ((ch ^ (row & 15)) << 4); }
__device__ __forceinline__ int voffs(int row, int ch) { return 2048 * (row >> 3) + 512 * (ch >> 2) + 64 * (row & 7) + 16 * ((ch & 3) ^ ((row >> 2) & 3)); }
__device__ __forceinline__ unsigned cvtpk(float lo, float hi) { unsigned r; asm volatile("v_cvt_pk_bf16_f32 %0, %1, %2" : "=v"(r) : "v"(lo), "v"(hi)); return r; }
__device__ __forceinline__ s16x4 vtr(const ATT_LAS unsigned char* p) { return __builtin_bit_cast(s16x4, __builtin_amdgcn_ds_read_tr16_b64_v4i16((ATT_LAS s16x4*)p)); }
__device__ __forceinline__ int sub1(int a) { int v = a ^ 128; asm volatile("" : "+v"(v)); return v; }
__device__ __forceinline__ void glds16(const char* sbase, unsigned voff, unsigned lds_dst) { unsigned keep;
    asm volatile("s_mov_b32 %0, m0\n\ts_mov_b32 m0, %3\n\ts_nop 0\n\tglobal_load_lds_dwordx4 %1, %2\n\ts_mov_b32 m0, %0" : "=&s"(keep) : "v"(voff), "s"(sbase), "s"(lds_dst) : "memory"); }
#define ATT_MFMA(a, b, c) __builtin_amdgcn_mfma_f32_32x32x16_bf16((a), (b), (c), 0, 0, 0)

template <bool C1> __device__ __forceinline__ void qk_issue(f32x16& s0, const ATT_LAS unsigned char* kb, const ATT_LAS unsigned char* qb_, const int (&kaddr)[4]) {
#pragma unroll
    for (int i = 0; i < 16; ++i) s0[i] = 0.f;
#pragma unroll
    for (int ds = 0; ds < 4; ++ds) {
        const int ad = C1 ? sub1(kaddr[ds]) : kaddr[ds];
        const bf16x8 a0 = *(const ATT_LAS bf16x8*)(kb + ad);
        const bf16x8 qv = *(const ATT_LAS bf16x8*)(qb_ + ad);
        s0 = ATT_MFMA(a0, qv, s0);
    }
}
__device__ __forceinline__ void rowmax_rescale(bool MASK, f32x16& s0, f32x16 (&O)[4], float& m, float& l, int kvr, int r, int h, ATT_LAS float* wsf) {
    if (MASK) {
        asm volatile("" ::: "memory");
        const int d = r - 4 * h - kvr;
#pragma unroll
        for (int i = 0; i < 16; ++i) { if (((i & 3) + 8 * (i >> 2)) > d) s0[i] = -INFINITY; }
    }
    float ra = __builtin_fmaxf(__builtin_fmaxf(s0[0], s0[1]), s0[2]), rb = __builtin_fmaxf(__builtin_fmaxf(s0[3], s0[4]), s0[5]);
    ra = __builtin_fmaxf(__builtin_fmaxf(ra, s0[6]), s0[7]); rb = __builtin_fmaxf(__builtin_fmaxf(rb, s0[8]), s0[9]);
    ra = __builtin_fmaxf(__builtin_fmaxf(ra, s0[10]), s0[11]); rb = __builtin_fmaxf(__builtin_fmaxf(rb, s0[12]), s0[13]);
    ra = __builtin_fmaxf(__builtin_fmaxf(ra, s0[14]), s0[15]);
    const float rm = half_max(__builtin_fmaxf(ra, rb));
    if (__any(rm > m + THR)) {
        const float mn = fmaxf(m, rm), al = __builtin_amdgcn_exp2f(m - mn);
        l *= al; m = mn;
        if (h == 0) wsf[r] = al;
#pragma unroll
        for (int i = 0; i < 16; ++i) { const float a = wsf[crow(i, h)];
#pragma unroll
            for (int db = 0; db < 4; ++db) O[db][i] *= a; }
    }
}
template <bool HAS_PV, bool HAS_QK, bool C1>
__device__ __forceinline__ void step_fused(f32x16& Scur, float m, float& l, u32x4 (&pkout)[2],
                                           f32x16 (&Opv)[4], const u32x4 (&pkin)[2], const ATT_LAS unsigned char* vb, const int (&vaddr)[2],
                                           f32x16& Snext, const ATT_LAS unsigned char* kb, const ATT_LAS unsigned char* qb_, const int (&kaddr)[4]) {
    s16x4 vlo[2], vhi[2]; bf16x8 ka, qa;
    if (HAS_PV) {
#pragma unroll
        for (int u = 0; u < 2; ++u) { vlo[u] = vtr(vb + vaddr[0] + u * 512); vhi[u] = vtr(vb + vaddr[1] + u * 512); } }
    if (HAS_QK) { const int ad = C1 ? sub1(kaddr[0]) : kaddr[0]; ka = *(const ATT_LAS bf16x8*)(kb + ad); qa = *(const ATT_LAS bf16x8*)(qb_ + ad);
#pragma unroll
        for (int i = 0; i < 16; ++i) Snext[i] = 0.f; }
    float sa = 0.f, sb = 0.f;
#pragma unroll
    for (int g = 0; g < 4; ++g) {
        s16x4 nlo[2], nhi[2]; bf16x8 nk, nq;
        if (g < 3) {
            if (HAS_PV) {
#pragma unroll
                for (int u = 0; u < 2; ++u) { const int off = (2 * ((g + 1) & 1) + u) * 512 + ((g + 1) >> 1) * 4096; nlo[u] = vtr(vb + vaddr[0] + off); nhi[u] = vtr(vb + vaddr[1] + off); } }
            if (HAS_QK) { const int ad = C1 ? sub1(kaddr[g + 1]) : kaddr[g + 1]; nk = *(const ATT_LAS bf16x8*)(kb + ad); nq = *(const ATT_LAS bf16x8*)(qb_ + ad); }
        }
        if (HAS_PV) { const bf16x8 pa = __builtin_bit_cast(bf16x8, pkin[g >> 1]);
#pragma unroll
            for (int u = 0; u < 2; ++u) { const bf16x8 vf = __builtin_shufflevector(vlo[u], vhi[u], 0, 1, 2, 3, 4, 5, 6, 7); Opv[2 * (g & 1) + u] = ATT_MFMA(pa, vf, Opv[2 * (g & 1) + u]); } }
        if (HAS_QK) Snext = ATT_MFMA(ka, qa, Snext);
#pragma unroll
        for (int e = 4 * g; e < 4 * g + 4; e += 2) { Scur[e] = __builtin_amdgcn_exp2f(Scur[e] - m); Scur[e + 1] = __builtin_amdgcn_exp2f(Scur[e + 1] - m); sa += Scur[e]; sb += Scur[e + 1]; }
        if (g & 1) pkout[g >> 1] = (u32x4){cvtpk(Scur[4 * g - 4], Scur[4 * g - 3]), cvtpk(Scur[4 * g - 2], Scur[4 * g - 1]), cvtpk(Scur[4 * g], Scur[4 * g + 1]), cvtpk(Scur[4 * g + 2], Scur[4 * g + 3])};
        if (g < 3) {
            if (HAS_PV) {
#pragma unroll
                for (int u = 0; u < 2; ++u) { vlo[u] = nlo[u]; vhi[u] = nhi[u]; } }
            if (HAS_QK) { ka = nk; qa = nq; }
        }
        __builtin_amdgcn_sched_barrier(0);
    }
    l += sa + sb;
}
__device__ __forceinline__ void pv_issue(f32x16 (&O)[4], const u32x4 (&pk)[2], const ATT_LAS unsigned char* vb, const int (&vaddr)[2]) {
#pragma unroll
    for (int s_ = 0; s_ < 2; ++s_) { const bf16x8 pa = __builtin_bit_cast(bf16x8, pk[s_]);
#pragma unroll
        for (int db = 0; db < 4; ++db) {
            const s16x4 lo = vtr(vb + vaddr[0] + db * 512 + s_ * 4096), hi = vtr(vb + vaddr[1] + db * 512 + s_ * 4096);
            const bf16x8 vf = __builtin_shufflevector(lo, hi, 0, 1, 2, 3, 4, 5, 6, 7);
            O[db] = ATT_MFMA(pa, vf, O[db]); } }
}

__device__ __forceinline__ void tile_body(bool MASK, const ATT_LAS unsigned char* kb, const ATT_LAS unsigned char* vb, const ATT_LAS unsigned char* qbase, const int (&kaddr)[4], const int (&vaddr)[2],
                                                               f32x16 (&O1)[4], f32x16 (&O2)[4], float& m1, float& m2, float& l1, float& l2, int kvrel, int r, int h, ATT_LAS float* wsf) {
    f32x16 Sa, Sb; u32x4 pkA[2], pkB[2];
    qk_issue<false>(Sa, kb, qbase, kaddr);
    rowmax_rescale(MASK, Sa, O1, m1, l1, kvrel, r, h, wsf);
    step_fused<false, true, true>(Sa, m1, l1, pkA, O1, pkA, vb, vaddr, Sb, kb, qbase, kaddr);
    rowmax_rescale(MASK, Sb, O2, m2, l2, kvrel, r, h, wsf);
    step_fused<true, true, false>(Sb, m2, l2, pkB, O1, pkA, vb, vaddr, Sa, kb + 8192, qbase, kaddr);
    rowmax_rescale(MASK, Sa, O1, m1, l1, kvrel + 32, r, h, wsf);
    step_fused<true, true, true>(Sa, m1, l1, pkA, O2, pkB, vb, vaddr, Sb, kb + 8192, qbase, kaddr);
    rowmax_rescale(MASK, Sb, O2, m2, l2, kvrel + 32, r, h, wsf);
    step_fused<true, false, false>(Sb, m2, l2, pkB, O1, pkA, vb + 8192, vaddr, Sa, kb, qbase, kaddr);
    pv_issue(O2, pkB, vb + 8192, vaddr);
}

__device__ __forceinline__ void attn_unit(ATT_LAS unsigned char* lds, const bf16_t* Qg, const bf16_t* Kg, const bf16_t* Vg, bf16_t* Og, int b, int head, int qb, float lam, const float* subg) {
    int tid = threadIdx.x; asm volatile("" : "+v"(tid));
    const int lane = tid & 63, r = lane & 31, h = lane >> 5;
    const int w = __builtin_amdgcn_readfirstlane(tid >> 6);
    const size_t rowbase = (size_t)b * SEQ; const int q0 = qb * 256, NT = (q0 + 256) >> 6;
    const int wq = (w < 4) ? w : 11 - w;
    const char* Kt = (const char*)(Kg + rowbase * PITCH + head * 128);
    const char* Vt = (const char*)(Vg + rowbase * PITCH + head * 128);
    unsigned ksrc[2], vsrc[2];
#pragma unroll
    for (int i = 0; i < 2; ++i) { const int ii = w * 2 + i;
        { const int row = 4 * ii + (lane >> 4), pc = lane & 15; ksrc[i] = (unsigned)(row * 2048 + ((pc ^ (row & 15)) << 4)); }
        { const int row = 8 * (ii >> 1) + ((lane >> 2) & 7), ch = 4 * (2 * (ii & 1) + (lane >> 5)) + ((lane & 3) ^ ((row >> 2) & 3)); vsrc[i] = (unsigned)(row * 2048 + ch * 16); } }
    const unsigned ldsb = (unsigned)(uintptr_t)lds;
#define ATT_STAGE(t, buf) do { _Pragma("unroll") for (int i_ = 0; i_ < 2; ++i_) { \
        glds16(Kt + (size_t)(t) * 131072, ksrc[i_], (unsigned)__builtin_amdgcn_readfirstlane(ldsb + KBUF + (buf) * 16384 + (w * 2 + i_) * 1024)); \
        glds16(Vt + (size_t)(t) * 131072, vsrc[i_], (unsigned)__builtin_amdgcn_readfirstlane(ldsb + VBUF + (buf) * 16384 + (w * 2 + i_) * 1024)); } } while (0)
    ATT_STAGE(0, 0);
    { const char* Qw = (const char*)(Qg + (rowbase + q0 + wq * 32) * PITCH + head * 128);
#pragma unroll
      for (int i = 0; i < 8; ++i) { const int row = 4 * i + (lane >> 4), pc = lane & 15;
          glds16(Qw, (unsigned)(row * 2048 + ((pc ^ (row & 15)) << 4)), (unsigned)__builtin_amdgcn_readfirstlane(ldsb + QBUF + w * 8192 + i * 1024)); } }
    const ATT_LAS unsigned char* qbase = lds + QBUF + w * 8192;
    int kaddr[4], vaddr[2];
#pragma unroll
    for (int ds = 0; ds < 4; ++ds) kaddr[ds] = koffs(r, 2 * ds + h);
    { const int q = (lane & 15) >> 2, p = lane & 3, blk = (lane >> 4) & 1;
#pragma unroll
      for (int sub = 0; sub < 2; ++sub) vaddr[sub] = voffs(8 * sub + 4 * h + q, 2 * blk + (p >> 1)) + 8 * (p & 1); }
    ATT_LAS float* wsf = (ATT_LAS float*)(lds + WSF + w * 512);
    f32x16 O1[4], O2[4];
#pragma unroll
    for (int db = 0; db < 4; ++db)
#pragma unroll
        for (int i = 0; i < 16; ++i) { O1[db][i] = 0.f; O2[db][i] = 0.f; }
    float m1 = -1e30f, m2 = -1e30f, l1 = 0.f, l2 = 0.f;
    asm volatile("s_waitcnt vmcnt(0)" ::: "memory"); __syncthreads();
    for (int t = 0; t < NT; ++t) {
        const int buf = t & 1;
        if (t + 1 < NT) ATT_STAGE(t + 1, buf ^ 1);
        const int kvrel = 64 * t - q0 - 32 * wq;
        if (kvrel <= 31) {
            const ATT_LAS unsigned char* kb = lds + KBUF + buf * 16384;
            const ATT_LAS unsigned char* vb = lds + VBUF + buf * 16384;
            tile_body(kvrel + 63 > 0, kb, vb, qbase, kaddr, vaddr, O1, O2, m1, m2, l1, l2, kvrel, r, h, wsf);
        }
        asm volatile("s_waitcnt vmcnt(0)" ::: "memory"); __syncthreads();
    }
    l1 = half_sum(l1); l2 = half_sum(l2);
    if (h == 0) { wsf[r] = 1.0f / l1; wsf[32 + r] = lam / l2; }
    float sg[4];
#pragma unroll
    for (int db = 0; db < 4; ++db) sg[db] = subg[32 * db + r] * 0.8f;
    bf16_t* Ow = Og + (rowbase + q0 + wq * 32) * PITCH + head * 128 + r;
#pragma unroll
    for (int i = 0; i < 16; ++i) {
        const int qr = crow(i, h); const float a1 = wsf[qr], a2 = wsf[32 + qr];
        float o[4], ss = 0.f;
#pragma unroll
        for (int db = 0; db < 4; ++db) { o[db] = O1[db][i] * a1 - O2[db][i] * a2; ss += o[db] * o[db]; }
        ss += xor_swz<1>(ss); ss += xor_swz<2>(ss); ss += xor_swz<4>(ss); ss += xor_swz<8>(ss); ss += xor_swz<16>(ss);
        const float rs = __builtin_amdgcn_rsqf(ss * (1.0f / 128.0f) + 1e-6f);
#pragma unroll
        for (int db = 0; db < 4; ++db) Ow[(size_t)qr * PITCH + 32 * db] = (bf16_t)(cvtpk(o[db] * rs * sg[db], 0.f) & 0xffffu);
    }
#undef ATT_STAGE
}
}
constexpr int NWAVES = 8;
constexpr int BATCH = 16, SEQ = 4096, D = 1024, NH = 8, FF = 4096, INW = 5632, M = BATCH * SEQ;
constexpr float RMS_EPS = 1e-6f;
constexpr size_t MiB = 1u << 20;
constexpr size_t WS_WIN = 0, WS_WOUT = 11 * MiB, WS_WUP = 13 * MiB, WS_WDOWN = 21 * MiB, WS_WPOOL = 29 * MiB;
constexpr size_t WS_ROPE = 30 * MiB;
constexpr size_t WS_SSQ1 = 34 * MiB, WS_SSQ2 = 38 * MiB;
constexpr size_t WS_BAR = 42 * MiB, BAR_ZERO_BYTES = 32768;
constexpr size_t WS_XN = 48 * MiB;
constexpr size_t WS_Q = 176 * MiB;
constexpr size_t WS_K = 304 * MiB;
constexpr size_t WS_V = 432 * MiB;
constexpr size_t WS_U = 560 * MiB;
constexpr size_t WS_G = 624 * MiB;
constexpr size_t WS_DP = 880 * MiB;
constexpr size_t WS_Z = 176 * MiB;
constexpr size_t WS_END = 944 * MiB;
static_assert(WS_Z + (size_t)M * FF * 2 <= WS_DP && WS_DP + (size_t)M * 512 * 2 <= WS_END, "d_ws map");
constexpr int LDS_MISC_OFF = 147456 - 256;
constexpr int LDS_BYTES = 147456;

#define LAS __attribute__((address_space(3)))
typedef unsigned short bf16;
typedef unsigned v4u __attribute__((ext_vector_type(4)));
typedef float f32x4 __attribute__((ext_vector_type(4)));
__device__ __forceinline__ unsigned f2bf(float f) { unsigned u = __builtin_bit_cast(unsigned, f); return (u + 0x7fffu + ((u >> 16) & 1u)) >> 16; }
__device__ __forceinline__ unsigned pk2(float lo, float hi) { return f2bf(lo) | (f2bf(hi) << 16); }
__device__ __forceinline__ float wave_sum(float v) {
    v += xor_swz<1>(v); v += xor_swz<2>(v); v += xor_swz<4>(v); v += xor_swz<8>(v); v += xor_swz<16>(v);
    return half_sum(v);
}
template <bool ROPE_PERM = false>
__device__ __forceinline__ void p0_transpose_item(const float* W, int K, int N, bf16* WT, int row_off, const float* kscale, LAS float* scr, int item, int lane) {
    const int nblk = N / 32, kb = item / nblk, nb = item % nblk, k0 = 64 * kb, n0 = 32 * nb;
#pragma unroll 8
    for (int i = 0; i < 32; ++i) { const int kk = 2 * i + (lane >> 5); float v = W[(size_t)(k0 + kk) * N + n0 + (lane & 31)]; if (kscale) v *= kscale[k0 + kk]; scr[kk * 33 + (lane & 31)] = v; }
    asm volatile("s_waitcnt lgkmcnt(0)" ::: "memory");
    const int c = lane & 7;
#pragma unroll
    for (int j = 0; j < 4; ++j) { const int n = (lane >> 3) + 8 * j; const LAS float* s = scr + (8 * c) * 33 + n;
        v4u o; o.x = pk2(s[0 * 33], s[1 * 33]); o.y = pk2(s[2 * 33], s[3 * 33]); o.z = pk2(s[4 * 33], s[5 * 33]); o.w = pk2(s[6 * 33], s[7 * 33]);
        int nn = n0 + n;
        if (ROPE_PERM && nn < 2048 && (nn & 63) < 16) { const int j = nn & 15; nn = (nn & ~15) | (2 * (j & 7) + (j >> 3)); }
        *(v4u*)(WT + (size_t)(row_off + nn) * K + k0 + 8 * c) = o; }
    asm volatile("s_waitcnt lgkmcnt(0)" ::: "memory");
}

#define XB_TMO      128
#define XB_XCNT(j)  (256  + 64 * (j))
#define XB_XSUB(j)  (1280 + 64 * (j))
#define XB_XGEN(j)  (2304 + 64 * (j))
#define XB_TOP      3328
#define XB_TOPGEN   3392
#define XCD_BAR_WORDS 3456
#define XB_SPIN_CAP (1u << 18)

__device__ __forceinline__ unsigned xb_ld(unsigned* p)              { return __hip_atomic_load(p, __ATOMIC_RELAXED, __HIP_MEMORY_SCOPE_AGENT); }
__device__ __forceinline__ unsigned xb_add(unsigned* p, unsigned v) { return __hip_atomic_fetch_add(p, v, __ATOMIC_RELAXED, __HIP_MEMORY_SCOPE_AGENT); }
__device__ __forceinline__ unsigned xb_xcc_id() { return (unsigned)__builtin_amdgcn_s_getreg((3 << 11) | 20) & 0xFu; }
#define XB_SPIN(cond, bar) do { unsigned _sp = 0; while (cond) { __builtin_amdgcn_s_sleep(1); \
    if ((++_sp & 255u) == 0u) { if (xb_ld(&(bar)[XB_TMO])) break; if (_sp > XB_SPIN_CAP) { atomicAdd(&(bar)[XB_TMO], 1u); break; } } } } while (0)

struct XcdBarrier {
    unsigned* bar; unsigned x;
    volatile LAS unsigned* st;
};

__device__ __forceinline__ XcdBarrier xcd_barrier_post(unsigned* bar, volatile LAS unsigned* st) {
    XcdBarrier b; b.bar = bar; b.x = xb_xcc_id(); b.st = st;
    if (threadIdx.x == 0) (void)xb_add(&bar[XB_XCNT(b.x)], 1u);
    return b;
}
__device__ __forceinline__ void xcd_barrier_complete(unsigned* bar, unsigned x, unsigned& nloc, unsigned& nx) {
    const unsigned G = gridDim.x * gridDim.y * gridDim.z;
    unsigned sum, cnt, mine, sp = 0u;
    for (;;) {
        sum = 0u; cnt = 0u; mine = 0u;
#pragma unroll
        for (unsigned j = 0; j < 16; ++j) { const unsigned c = xb_ld(&bar[XB_XCNT(j)]); sum += c; cnt += (c > 0u) ? 1u : 0u; mine = (j == x) ? c : mine; }
        if (sum == G) break;
        __builtin_amdgcn_s_sleep(1);
        if ((++sp & 255u) == 0u) { if (xb_ld(&bar[XB_TMO])) break; if (sp > XB_SPIN_CAP) { atomicAdd(&bar[XB_TMO], 1u); break; } }
    }
    nloc = mine > 0u ? mine : 1u; nx = cnt > 0u ? cnt : 1u;
}

__device__ __forceinline__ void xcd_barrier(const XcdBarrier& b) {
    asm volatile("s_waitcnt vmcnt(0)" ::: "memory");
    __syncthreads();
    if (threadIdx.x == 0) {
        unsigned* bar = b.bar;
        __builtin_amdgcn_s_waitcnt(0);
        unsigned nloc = b.st[0], nx = b.st[1];
        if (nloc == 0u) { xcd_barrier_complete(bar, b.x, nloc, nx); b.st[0] = nloc; b.st[1] = nx; }
        const unsigned old = xb_add(&bar[XB_XSUB(b.x)], 1u);
        const unsigned gen = old / nloc;
        if (old + 1u == (gen + 1u) * nloc) {
            __builtin_amdgcn_fence(__ATOMIC_RELEASE, "agent");
            asm volatile("s_waitcnt vmcnt(0)" ::: "memory");
            const unsigned og = xb_add(&bar[XB_TOP], 1u);
            const unsigned tg = og / nx;
            if (og + 1u == (tg + 1u) * nx) xb_add(&bar[XB_TOPGEN], 1u);
            else XB_SPIN(xb_ld(&bar[XB_TOPGEN]) == tg, bar);
            __builtin_amdgcn_fence(__ATOMIC_ACQUIRE, "agent");
            xb_add(&bar[XB_XGEN(b.x)], 1u);
            asm volatile("s_waitcnt vmcnt(0)" ::: "memory");
        } else {
            XB_SPIN(xb_ld(&bar[XB_XGEN(b.x)]) == gen, bar);
            __builtin_amdgcn_fence(__ATOMIC_ACQUIRE, "agent");
            asm volatile("s_waitcnt vmcnt(0)" ::: "memory");
        }
    }
    __syncthreads();
}

#ifndef REP_P0
#define REP_P0 1
#endif
#ifndef REP_P1
#define REP_P1 1
#endif
#ifndef REP_P2
#define REP_P2 1
#endif
#ifndef REP_P3
#define REP_P3 1
#endif
#ifndef REP_P4
#define REP_P4 1
#endif
#ifndef REP_P5
#define REP_P5 1
#endif
template <int W> __device__ __forceinline__ v4u pool_window(const bf16* up, int t) {
    v4u q[W];
#pragma unroll
    for (int j = 0; j < W; ++j) q[j] = *(const v4u*)(up - (size_t)((j <= t) ? j : 0) * 512);
    float acc[8];
#pragma unroll
    for (int e = 0; e < 8; ++e) acc[e] = 0.f;
#pragma unroll
    for (int j = 0; j < W; ++j) { const float wgt = (j <= t) ? 1.f : 0.f;
        acc[0] += wgt * pg8::bf_lo(q[j].x); acc[1] += wgt * pg8::bf_hi(q[j].x); acc[2] += wgt * pg8::bf_lo(q[j].y); acc[3] += wgt * pg8::bf_hi(q[j].y);
        acc[4] += wgt * pg8::bf_lo(q[j].z); acc[5] += wgt * pg8::bf_hi(q[j].z); acc[6] += wgt * pg8::bf_lo(q[j].w); acc[7] += wgt * pg8::bf_hi(q[j].w); }
    const float inv = 1.0f / (float)((t + 1 < W) ? (t + 1) : W);
    v4u o;
    o.x = pk2(acc[0] * inv - pg8::bf_lo(q[0].x), acc[1] * inv - pg8::bf_hi(q[0].x)); o.y = pk2(acc[2] * inv - pg8::bf_lo(q[0].y), acc[3] * inv - pg8::bf_hi(q[0].y));
    o.z = pk2(acc[4] * inv - pg8::bf_lo(q[0].z), acc[5] * inv - pg8::bf_hi(q[0].z)); o.w = pk2(acc[6] * inv - pg8::bf_lo(q[0].w), acc[7] * inv - pg8::bf_hi(q[0].w));
    return o;
}

struct Args {
    const float* x; const int* pos; const float* g_attn; const float* w_in; const float* lq1; const float* lk1; const float* lq2; const float* lk2;
    const float* subln_g; const float* w_pool; const float* pool_scale; const float* w_out; const float* g_mlp; const float* w_up; const float* w_down; const float* g_final;
    float* out; unsigned char* ws;
};

__global__ void __launch_bounds__(NWAVES * 64, 2) hybrid_fwd(Args a) {
    extern __shared__ __attribute__((aligned(16))) unsigned char lds_raw[];
    LAS unsigned char* lds = (LAS unsigned char*)lds_raw;
    cg::grid_group grid = cg::this_grid();
    if (threadIdx.x < 2) ((volatile LAS unsigned*)(lds + LDS_MISC_OFF))[threadIdx.x] = 0u;
    __syncthreads();
    const int G = gridDim.x, bx = blockIdx.x;
#define PHASE_IDS int tid = threadIdx.x; asm volatile("" : "+v"(tid)); const int lane = tid & 63, wave = __builtin_amdgcn_readfirstlane(tid >> 6); const int gw = vcu * NWAVES + wave, NGW = G * NWAVES; (void)lane; (void)gw; (void)NGW
    const int vcu = (G % 8 == 0) ? (bx % 8) * (G / 8) + bx / 8 : bx;
    unsigned char* ws = a.ws;
    bf16* Win_t = (bf16*)(ws + WS_WIN); bf16* Wout_t = (bf16*)(ws + WS_WOUT); bf16* Wup_t = (bf16*)(ws + WS_WUP); bf16* Wdown_t = (bf16*)(ws + WS_WDOWN); bf16* Wpool_t = (bf16*)(ws + WS_WPOOL);
    float* rope = (float*)(ws + WS_ROPE); float* ssq1 = (float*)(ws + WS_SSQ1); float* ssq2 = (float*)(ws + WS_SSQ2);
    bf16* XN = (bf16*)(ws + WS_XN); bf16* Qb = (bf16*)(ws + WS_Q); bf16* Kb = (bf16*)(ws + WS_K); bf16* Vb = (bf16*)(ws + WS_V);
    bf16* Ub = (bf16*)(ws + WS_U); bf16* Gb = (bf16*)(ws + WS_G); bf16* Dp = (bf16*)(ws + WS_DP); bf16* Zb = (bf16*)(ws + WS_Z); bf16* Mg = Kb; bf16* Ab = XN;

    if (bx == 0) { for (int i = threadIdx.x; i < (int)(BAR_ZERO_BYTES / 4); i += NWAVES * 64) ((unsigned*)(a.ws + WS_BAR))[i] = 0u; }
    grid.sync();
    unsigned seam_no = 0, seam2_no = 0, xc_nloc = 1, xc_ngroups = 1;
    const unsigned xcc = (unsigned)__builtin_amdgcn_s_getreg((3 << 11) | 20) & 0xFu;
    if (threadIdx.x == 0) __hip_atomic_fetch_add((unsigned*)(a.ws + WS_BAR) + 64 * (80 + xcc), 1u, __ATOMIC_RELAXED, __HIP_MEMORY_SCOPE_AGENT);
#define SEAM2() do { ++seam2_no; asm volatile("s_waitcnt vmcnt(0)" ::: "memory"); __syncthreads(); \
        if (threadIdx.x == 0) { unsigned* w_ = (unsigned*)(a.ws + WS_BAR); \
            const unsigned old_ = __hip_atomic_fetch_add(w_ + 64 * (32 + xcc), 1u, __ATOMIC_RELAXED, __HIP_MEMORY_SCOPE_AGENT); \
            if (old_ + 1u == seam2_no * xc_nloc) { \
                __builtin_amdgcn_fence(__ATOMIC_RELEASE, "agent"); asm volatile("s_waitcnt vmcnt(0)" ::: "memory"); \
                __hip_atomic_fetch_add(w_ + 64 * 64, 1u, __ATOMIC_RELAXED, __HIP_MEMORY_SCOPE_AGENT); \
                while (__hip_atomic_load(w_ + 64 * 64, __ATOMIC_RELAXED, __HIP_MEMORY_SCOPE_AGENT) < seam2_no * xc_ngroups) __builtin_amdgcn_s_sleep(1); \
                __hip_atomic_store(w_ + 64 * (48 + xcc), seam2_no, __ATOMIC_RELAXED, __HIP_MEMORY_SCOPE_AGENT); \
            } else { while (__hip_atomic_load(w_ + 64 * (48 + xcc), __ATOMIC_RELAXED, __HIP_MEMORY_SCOPE_AGENT) < seam2_no) __builtin_amdgcn_s_sleep(1); } \
            __builtin_amdgcn_fence(__ATOMIC_ACQUIRE, "agent"); asm volatile("s_waitcnt vmcnt(0)" ::: "memory"); } \
        __syncthreads(); } while (0)
#define SEAM() do { ++seam_no; asm volatile("s_waitcnt vmcnt(0)" ::: "memory"); __syncthreads(); \
        if (threadIdx.x == 0) { unsigned* w_ = (unsigned*)(a.ws + WS_BAR); const unsigned g_ = (unsigned)bx & 7u, ng_ = ((unsigned)G - g_ + 7u) / 8u, ngroups_ = (unsigned)G < 8u ? (unsigned)G : 8u; \
            __builtin_amdgcn_fence(__ATOMIC_RELEASE, "agent"); asm volatile("s_waitcnt vmcnt(0)" ::: "memory");     \
            const unsigned old_ = __hip_atomic_fetch_add(w_ + 64 * g_, 1u, __ATOMIC_RELAXED, __HIP_MEMORY_SCOPE_AGENT); \
            if (old_ + 1u == seam_no * ng_) { \
                __hip_atomic_fetch_add(w_ + 64 * 16, 1u, __ATOMIC_RELAXED, __HIP_MEMORY_SCOPE_AGENT); \
                while (__hip_atomic_load(w_ + 64 * 16, __ATOMIC_RELAXED, __HIP_MEMORY_SCOPE_AGENT) < seam_no * ngroups_) __builtin_amdgcn_s_sleep(1); \
                __hip_atomic_store(w_ + 64 * (8 + g_), seam_no, __ATOMIC_RELAXED, __HIP_MEMORY_SCOPE_AGENT); \
            } else { while (__hip_atomic_load(w_ + 64 * (8 + g_), __ATOMIC_RELAXED, __HIP_MEMORY_SCOPE_AGENT) < seam_no) __builtin_amdgcn_s_sleep(1); } \
            __builtin_amdgcn_fence(__ATOMIC_ACQUIRE, "agent"); asm volatile("s_waitcnt vmcnt(0)" ::: "memory"); } \
        __syncthreads(); } while (0)

    for (int rep_ = 0; rep_ < REP_P0; ++rep_) {
        PHASE_IDS;
        LAS float* scr = (LAS float*)(lds + wave * 16384);
        constexpr int I_IN = (D / 64) * (INW / 32), I_OUT = (D / 64) * (D / 32), I_UP = (D / 64) * (FF / 32), I_DOWN = (FF / 64) * (D / 32), I_POOL1 = (128 / 64) * (256 / 32);
        constexpr int NITEMS = I_IN + I_OUT + I_UP + I_DOWN + 4 * I_POOL1;
        for (int it = gw; it < NITEMS; it += NGW) {
            int r = it;
            if (r < I_IN) { p0_transpose_item<true>(a.w_in, D, INW, Win_t, 0, nullptr, scr, r, lane); continue; } r -= I_IN;
            if (r < I_OUT) { p0_transpose_item(a.w_out, D, D, Wout_t, 0, nullptr, scr, r, lane); continue; } r -= I_OUT;
            if (r < I_UP) { p0_transpose_item(a.w_up, D, FF, Wup_t, 0, a.g_mlp, scr, r, lane); continue; } r -= I_UP;
            if (r < I_DOWN) { p0_transpose_item(a.w_down, FF, D, Wdown_t, 0, nullptr, scr, r, lane); continue; } r -= I_DOWN;
            { const int g = r / I_POOL1; p0_transpose_item(a.w_pool + (size_t)g * 128 * 256, 128, 256, Wpool_t, g * 256, nullptr, scr, r % I_POOL1, lane); }
        }
        for (int e = bx * (NWAVES * 64) + tid; e < M * 8; e += G * NWAVES * 64) {
            const int row = e >> 3, i = e & 7;
            const float invf = (i == 0) ? 1.0f : (i == 1) ? 0.19392274474868576f : (i == 2) ? 0.03760603093086393f : (i == 3) ? 0.007292664737217109f :
                               (i == 4) ? 0.001414213562373095f : (i == 5) ? 0.0002742481756762073f : (i == 6) ? 5.318295896944988e-05f : 1.031338537721246e-05f;
            const float ang = (float)a.pos[row] * invf;
            double rev = (double)ang * 0.15915494309189535; rev -= __builtin_rint(rev);
            const float rf = (float)rev;
            rope[(size_t)e * 2] = __builtin_amdgcn_cosf(rf); rope[(size_t)e * 2 + 1] = __builtin_amdgcn_sinf(rf);
        }
        {
            const f32x4* gr = (const f32x4*)a.g_attn + lane; f32x4 gg[4];
#pragma unroll
            for (int j = 0; j < 4; ++j) gg[j] = gr[64 * j];
            for (int m0 = gw * 4; m0 < M; m0 += NGW * 4) {
                f32x4 v[4][4]; float s2[4];
#pragma unroll
                for (int q = 0; q < 4; ++q) { const f32x4* xr = (const f32x4*)(a.x + (size_t)(m0 + q) * D) + lane;
#pragma unroll
                    for (int j = 0; j < 4; ++j) v[q][j] = __builtin_nontemporal_load(xr + 64 * j); }
#pragma unroll
                for (int q = 0; q < 4; ++q) { s2[q] = 0.f;
#pragma unroll
                    for (int j = 0; j < 4; ++j) s2[q] += (v[q][j].x * v[q][j].x + v[q][j].y * v[q][j].y) + (v[q][j].z * v[q][j].z + v[q][j].w * v[q][j].w); }
#pragma unroll
                for (int q = 0; q < 4; ++q) { const float rstd = __builtin_amdgcn_rsqf(wave_sum(s2[q]) * (1.f / D) + RMS_EPS);
                    unsigned long long* o8 = (unsigned long long*)(XN + (size_t)(m0 + q) * D) + lane;
#pragma unroll
                    for (int j = 0; j < 4; ++j) { const f32x4 y = v[q][j] * rstd * gg[j];
                        o8[64 * j] = (unsigned long long)pk2(y.x, y.y) | ((unsigned long long)pk2(y.z, y.w) << 32); } }
            }
        }
    SEAM(); }
    if (threadIdx.x == 0) { unsigned ng_ = 0u;
        for (unsigned j = 0; j < 16u; ++j) { const unsigned c_ = __hip_atomic_load((unsigned*)(a.ws + WS_BAR) + 64 * (80 + j), __ATOMIC_RELAXED, __HIP_MEMORY_SCOPE_AGENT); ng_ += (c_ != 0u); if (j == xcc) xc_nloc = c_; }
        xc_ngroups = ng_; }
    for (int rep_ = 0; rep_ < REP_P1; ++rep_) {
        pg8::Gemm g{XN, Win_t, M, INW, D, 0}; pg8::StaticOrder S; S.init(M, INW, G, bx);
        pg8::EpiIn E{Qb, Kb, Vb, Ub, Gb, rope};
        pg8::gemm_phase<pg8::EpiIn, pg8::StaticOrder, true, true>(lds, g, S, E);
    SEAM2(); }


    for (int rep_ = 0; rep_ < REP_P2; ++rep_) {
        PHASE_IDS;
        for (int wi = gw; wi < M; wi += NGW) {
            const int rq = wi >> 2, gp = ((wi & 3) + (wi >> 11)) & 3;
            const int row = 4 * rq + (lane >> 4), t = row & (SEQ - 1);
            const bf16* up = Ub + (size_t)row * 512 + gp * 128 + (lane & 15) * 8;
            v4u o;
            if (gp == 0) o = pool_window<2>(up, t); else if (gp == 1) o = pool_window<4>(up, t); else if (gp == 2) o = pool_window<8>(up, t); else o = pool_window<16>(up, t);
            *(v4u*)(Dp + ((size_t)gp * M + row) * 128 + (lane & 15) * 8) = o;
        }
        const float sa = wave_sum(a.lq1[lane] * a.lk1[lane]), sb = wave_sum(a.lq2[lane] * a.lk2[lane]);
        const float lam = expf(sa) - expf(sb) + 0.2f;
        for (int pu = vcu; pu < BATCH * NH * 8; pu += G) {
            const int bh = pu >> 3, s = pu & 7, b = bh >> 3, head = bh & 7;
            for (int k = 0; k < 2; ++k) att::attn_unit(lds, Qb, Kb, Vb, Ab, b, head, k ? s : 15 - s, lam, a.subln_g);
        }
    SEAM2(); }

    for (int rep_ = 0; rep_ < REP_P3; ++rep_) {
        pg8::Gemm g{Dp, Wpool_t, M, D, 128, (size_t)M * 128 * 2}; pg8::StaticOrder S; S.init(M, D, G, bx);
        pg8::EpiMerge E{Ab, Gb, a.pool_scale, Mg};
        pg8::gemm_phase<pg8::EpiMerge, pg8::StaticOrder, true, true>(lds, g, S, E);
    SEAM2(); }

    for (int rep_ = 0; rep_ < REP_P4; ++rep_) {
        pg8::Gemm g{Mg, Wout_t, M, D, D, 0}; pg8::StaticOrder S; S.init(M, D, G, bx);
        pg8::EpiResA E{a.x, XN, ssq1};
        pg8::gemm_phase<pg8::EpiResA, pg8::StaticOrder, true, true>(lds, g, S, E);
    SEAM2(); }

    for (int rep_ = 0; rep_ < REP_P5; ++rep_) {
        pg8::Gemm g{XN, Wup_t, M, FF, D, 0}; pg8::StaticOrder S; S.init(M, FF, G, bx);
        pg8::EpiUp E{ssq1, Zb};
        pg8::gemm_phase<pg8::EpiUp, pg8::StaticOrder, true, true>(lds, g, S, E);
    SEAM2(); }

    {
        pg8::Gemm g{Zb, Wdown_t, M, D, FF, 0}; pg8::StaticOrder S; S.init(M, D, G, bx);
        pg8::EpiResB E{XN, ssq2};
        pg8::gemm_phase<pg8::EpiResB, pg8::StaticOrder, true, true>(lds, g, S, E);
    }
    SEAM2();

    { PHASE_IDS;
    const f32x4* gr = (const f32x4*)a.g_final + lane; f32x4 gg[4];
#pragma unroll
    for (int j = 0; j < 4; ++j) gg[j] = gr[64 * j];
    for (int m0 = gw * 4; m0 < M; m0 += NGW * 4) {
        unsigned long long v[4][4]; float s[4];
#pragma unroll
        for (int q = 0; q < 4; ++q) { const unsigned long long* xr = (const unsigned long long*)(XN + (size_t)(m0 + q) * D) + lane; s[q] = ssq2[(size_t)(m0 + q) * 16 + (lane & 15)];
#pragma unroll
            for (int j = 0; j < 4; ++j) v[q][j] = __builtin_nontemporal_load(xr + 64 * j); }
#pragma unroll
        for (int q = 0; q < 4; ++q) { float t = s[q]; t += xor_swz<1>(t); t += xor_swz<2>(t); t += xor_swz<4>(t); t += xor_swz<8>(t);
            const float rstd = __builtin_amdgcn_rsqf(t * (1.f / D) + RMS_EPS);
            f32x4* xr = (f32x4*)(a.out + (size_t)(m0 + q) * D) + lane;
#pragma unroll
            for (int j = 0; j < 4; ++j) { const unsigned lo = (unsigned)v[q][j], hi = (unsigned)(v[q][j] >> 32);
                const f32x4 x = (f32x4){pg8::bf_lo(lo), pg8::bf_hi(lo), pg8::bf_lo(hi), pg8::bf_hi(hi)};
                __builtin_nontemporal_store(x * rstd * gg[j], xr + 64 * j); } }
    } }
}

extern "C" void kernel_launch(void* const* d_in, const int* in_sizes, int n_in, void* d_out, int out_size, void* d_ws, size_t ws_size, hipStream_t stream) {
    static int grid = 0;
    if (grid == 0) {
        if (n_in != 16 || in_sizes[0] != M * D || out_size != M * D || ws_size < WS_END) { fprintf(stderr, "kernel_launch: unexpected shapes (n_in %d, in0 %d, out %d, ws %zu); nothing launched\n", n_in, n_in > 0 ? in_sizes[0] : -1, out_size, ws_size); grid = -1; return; }
        int dev = 0, cus = 0, per_cu = 0;
        if (hipGetDevice(&dev) != hipSuccess || hipDeviceGetAttribute(&cus, hipDeviceAttributeMultiprocessorCount, dev) != hipSuccess) { grid = -1; return; }
        if (hipFuncSetAttribute((const void*)hybrid_fwd, hipFuncAttributeMaxDynamicSharedMemorySize, LDS_BYTES) != hipSuccess) { fprintf(stderr, "kernel_launch: hipFuncSetAttribute failed\n"); grid = -1; return; }
        if (hipOccupancyMaxActiveBlocksPerMultiprocessor(&per_cu, (const void*)hybrid_fwd, NWAVES * 64, LDS_BYTES) != hipSuccess || per_cu < 1) per_cu = 1;
        (void)hipGetLastError();
        grid = cus * per_cu;
    }
    if (grid < 0) return;
    Args a{};
    a.x = (const float*)d_in[0]; a.pos = (const int*)d_in[1]; a.g_attn = (const float*)d_in[2]; a.w_in = (const float*)d_in[3];
    a.lq1 = (const float*)d_in[4]; a.lk1 = (const float*)d_in[5]; a.lq2 = (const float*)d_in[6]; a.lk2 = (const float*)d_in[7];
    a.subln_g = (const float*)d_in[8]; a.w_pool = (const float*)d_in[9]; a.pool_scale = (const float*)d_in[10]; a.w_out = (const float*)d_in[11];
    a.g_mlp = (const float*)d_in[12]; a.w_up = (const float*)d_in[13]; a.w_down = (const float*)d_in[14]; a.g_final = (const float*)d_in[15];
    a.out = (float*)d_out; a.ws = (unsigned char*)d_ws;
    void* args[] = {&a};
    const hipError_t e = hipLaunchCooperativeKernel((const void*)hybrid_fwd, dim3(grid), dim3(NWAVES * 64), args, LDS_BYTES, stream);
    if (e != hipSuccess) fprintf(stderr, "kernel_launch: cooperative launch failed: %s (grid %d)\n", hipGetErrorString(e), grid);
}
```

```cpp
#include <hip/hip_runtime.h>
#include <hip/hip_cooperative_groups.h>
#include <cstdio>
#include <cstdint>
#include <cmath>
namespace cg = cooperative_groups;
template <int K> __device__ __forceinline__ float xor_swz(float v) { return __int_as_float(__builtin_amdgcn_ds_swizzle(__float_as_int(v), (K << 10) | 0x1f)); }
__device__ __forceinline__ float half_sum(float v) { auto rr = __builtin_amdgcn_permlane32_swap(__float_as_uint(v), __float_as_uint(v), false, false); return __uint_as_float(rr[0]) + __uint_as_float(rr[1]); }
__device__ __forceinline__ float half_max(float v) { auto rr = __builtin_amdgcn_permlane32_swap(__float_as_uint(v), __float_as_uint(v), false, false); return fmaxf(__uint_as_float(rr[0]), __uint_as_float(rr[1])); }
namespace pg8 {
#define PG8_LAS __attribute__((address_space(3)))
typedef unsigned short bf16_t;
typedef short bf16x8 __attribute__((ext_vector_type(8)));
typedef float f32x4 __attribute__((ext_vector_type(4)));
typedef unsigned u32x4 __attribute__((ext_vector_type(4)));
constexpr int BM = 256, BK = 64, HALF = 128, HTB = HALF * BK * 2  , STAGE_BYTES = 8 * HTB, NXCD = 8, WGM = 8;

__host__ __device__ __forceinline__ int lds_byte(int r, int c) { const int st = (r >> 4) * 2 + (c >> 5), rr = r & 15, cc = c & 31, ob = rr * 64 + cc * 2; return st * 1024 + (ob ^ (((ob >> 9) & 1) << 5)); }
__host__ __device__ __forceinline__ void stage_rc(int b, int& R, int& C) { const int st = b / 1024, sb = b % 1024, swz = sb ^ (((sb >> 9) & 1) << 5); R = (st >> 1) * 16 + swz / 64; C = (st & 1) * 32 + (swz % 64) / 2; }
__host__ __device__ __forceinline__ int perm32(int rho) { const int n = rho >> 4, i = rho & 15; return 8 * (i >> 2) + 4 * n + (i & 3); }

struct Unit { int pm, pn; };
struct Gemm { const bf16_t* A; const bf16_t* Bt; int M, N, K; size_t a_pn_off; };

struct StaticOrder {
    int nM, nN, nwg, G, c;
    __host__ __device__ void init(int M, int N, int G_, int c_) { nM = M / BM; nN = N / BM; nwg = nM * nN; G = G_; c = c_; }
    __host__ __device__ bool next(int i, Unit& u) const {
        const long L = (long)i * G + c; if (L >= nwg) return false;
        int wgid = (int)L; { const int q = nwg / NXCD, r = nwg % NXCD, xcd = wgid % NXCD, off = wgid / NXCD; wgid = (xcd < r ? xcd * (q + 1) : r * (q + 1) + (xcd - r) * q) + off; }
        const int nig = WGM * nN, gid = wgid / nig, fm = gid * WGM, gsz = (nM - fm) < WGM ? (nM - fm) : WGM;
        u.pm = fm + ((wgid % nig) % gsz); u.pn = (wgid % nig) / gsz; return true;
    }
    __device__ __forceinline__ void a_ready(const Unit&) const {}
    __device__ __forceinline__ void done(const Unit&) const {}
};

__device__ __forceinline__ unsigned cvt_pk_bf16(float lo, float hi) { unsigned r; asm volatile("v_cvt_pk_bf16_f32 %0, %1, %2" : "=v"(r) : "v"(lo), "v"(hi)); return r; }
typedef float f32x2 __attribute__((ext_vector_type(2)));
template <class Epi, class Sched, bool ALIGN_EPI = false, bool SP2 = false>
__device__ __forceinline__ void gemm_phase(PG8_LAS unsigned char* lds, const Gemm g, const Sched& S, const Epi& E) {
    int tid = threadIdx.x; asm volatile("" : "+v"(tid));
    const int wid = __builtin_amdgcn_readfirstlane(tid >> 6), lane = tid & 63, wr = wid >> 2, wc = wid & 3, fr = lane & 15, fq = lane >> 4;
    const int K = g.K, nt = K / BK;
    unsigned voffA[2], voffB[2];
#pragma unroll
    for (int i = 0; i < 2; ++i) { int R, C; stage_rc(tid * 16 + i * 8192, R, C); const int Rb = Epi::PERM ? ((R & ~31) + perm32(R & 31)) : R;
        voffA[i] = (unsigned)(R * K + C) * 2u; voffB[i] = (unsigned)(Rb * K + C) * 2u; }
    const size_t kstep = (size_t)(BK * 2);
    const size_t hstep = (size_t)HALF * K * 2;
    const size_t tstep = 2 * hstep;
    const unsigned ldsw = (unsigned)wid * 1024u;
    const int aoff = lds_byte(wr * 64 + fr, fq * 8), boff = lds_byte(wc * 32 + fr, fq * 8);
#define PG8_SA(b, h) (((b) * 2 + (h)) * HTB)
#define PG8_SB(b, h) ((4 + (b) * 2 + (h)) * HTB)
#define PG8_STAGE(bufoff, gbase, voff) do { _Pragma("unroll") for (int _i = 0; _i < 2; ++_i) \
        __builtin_amdgcn_global_load_lds((const unsigned*)((const char*)(gbase) + (voff)[_i]), (PG8_LAS unsigned*)(lds + (bufoff) + ldsw + _i * 8192), 16, 0, 0); } while (0)
#define PG8_LDA(dst, b, h) do { _Pragma("unroll") for (int m = 0; m < 4; ++m) _Pragma("unroll") for (int k = 0; k < 2; ++k) dst[m][k] = *(const PG8_LAS bf16x8*)(lds + PG8_SA(b, h) + aoff + m * 2048 + k * 1024); } while (0)
#define PG8_LDB(dst, b, h) do { _Pragma("unroll") for (int n = 0; n < 2; ++n) _Pragma("unroll") for (int k = 0; k < 2; ++k) dst[n][k] = *(const PG8_LAS bf16x8*)(lds + PG8_SB(b, h) + boff + n * 2048 + k * 1024); } while (0)
#define PG8_MMA(ai, bj, At, Bt) do { __builtin_amdgcn_s_setprio(1); _Pragma("unroll") for (int m = 0; m < 4; ++m) _Pragma("unroll") for (int n = 0; n < 2; ++n) _Pragma("unroll") for (int k = 0; k < 2; ++k) \
        acc[ai][bj][m][n] = __builtin_amdgcn_mfma_f32_16x16x32_bf16(Bt[n][k], At[m][k], acc[ai][bj][m][n], 0, 0, 0); __builtin_amdgcn_s_setprio(0); } while (0)
#define PG8_WAIT_V(n) asm volatile("s_waitcnt vmcnt(" #n ")" ::: "memory")
#define PG8_WAIT_L(n) asm volatile("s_waitcnt lgkmcnt(" #n ")" ::: "memory")
#define PG8_BAR __builtin_amdgcn_s_barrier()
#define PG8_SCHED __builtin_amdgcn_sched_barrier(0)
    Unit cur, nxt; int ui = 0;
    if (!S.next(0, cur)) return;
    f32x4 acc[2][2][4][2];
#pragma unroll
    for (int a = 0; a < 2; ++a)
#pragma unroll
        for (int b = 0; b < 2; ++b)
#pragma unroll
            for (int m = 0; m < 4; ++m)
#pragma unroll
                for (int n = 0; n < 2; ++n) acc[a][b][m][n] = (f32x4){0.f, 0.f, 0.f, 0.f};
    bf16x8 At[4][2], B0[2][2], B1[2][2];
    const char* cA = (const char*)g.A + (size_t)cur.pm * tstep + (size_t)cur.pn * g.a_pn_off; const char* cB = (const char*)g.Bt + (size_t)cur.pn * tstep;
    S.a_ready(cur);
    if constexpr (SP2) {
        PG8_STAGE(PG8_SB(0, 0), cB, voffB); PG8_STAGE(PG8_SB(0, 1), cB + hstep, voffB); PG8_STAGE(PG8_SA(0, 0), cA, voffA); PG8_STAGE(PG8_SA(0, 1), cA + hstep, voffA);
        if (wr == 1) PG8_BAR;
        PG8_WAIT_V(2); PG8_BAR;
        PG8_STAGE(PG8_SB(1, 0), cB + kstep, voffB); PG8_STAGE(PG8_SA(1, 0), cA + kstep, voffA); PG8_STAGE(PG8_SB(1, 1), cB + hstep + kstep, voffB);
        PG8_WAIT_V(6); PG8_BAR;
    } else {
        PG8_STAGE(PG8_SB(0, 0), cB, voffB); PG8_STAGE(PG8_SA(0, 0), cA, voffA); PG8_STAGE(PG8_SB(0, 1), cB + hstep, voffB); PG8_STAGE(PG8_SA(0, 1), cA + hstep, voffA);
        if (wr == 1) PG8_BAR;
        PG8_WAIT_V(4); PG8_BAR;
        PG8_STAGE(PG8_SB(1, 0), cB + kstep, voffB); PG8_STAGE(PG8_SA(1, 0), cA + kstep, voffA); PG8_STAGE(PG8_SB(1, 1), cB + hstep + kstep, voffB);
        PG8_WAIT_V(6); PG8_BAR;
    }
    for (;;) {
        const bool has_next = S.next(ui + 1, nxt);
        const char* nA = has_next ? (const char*)g.A + (size_t)nxt.pm * tstep + (size_t)nxt.pn * g.a_pn_off : cA; const char* nB = has_next ? (const char*)g.Bt + (size_t)nxt.pn * tstep : cB;
        for (int t = 0; t < nt; t += 2) {
            const bool last = (t == nt - 2);
            const char* a1 = cA + (size_t)(t + 1) * kstep;
            const char* a2 = last ? nA : cA + (size_t)(t + 2) * kstep; const char* b2 = last ? nB : cB + (size_t)(t + 2) * kstep;
            const char* a3 = a2 + kstep; const char* b3 = b2 + kstep;
            if (last && has_next) S.a_ready(nxt);
            if constexpr (SP2) {
            PG8_LDB(B0, 0, 0); PG8_LDB(B1, 0, 1); PG8_SCHED; PG8_LDA(At, 0, 0); PG8_STAGE(PG8_SA(1, 1), a1 + hstep, voffA);
            PG8_WAIT_V(8); PG8_WAIT_L(0); PG8_BAR; PG8_MMA(0, 0, At, B0); PG8_MMA(0, 1, At, B1); PG8_BAR; PG8_SCHED;
            PG8_LDA(At, 0, 1); PG8_STAGE(PG8_SB(0, 0), b2, voffB); PG8_STAGE(PG8_SB(0, 1), b2 + hstep, voffB); PG8_STAGE(PG8_SA(0, 0), a2, voffA);
            PG8_WAIT_V(8); PG8_WAIT_L(0); PG8_BAR; PG8_MMA(1, 0, At, B0); PG8_MMA(1, 1, At, B1); PG8_BAR; PG8_SCHED;
            PG8_LDB(B0, 1, 0); PG8_LDB(B1, 1, 1); PG8_SCHED; PG8_LDA(At, 1, 0); PG8_STAGE(PG8_SA(0, 1), a2 + hstep, voffA);
            PG8_WAIT_V(8); PG8_WAIT_L(0); PG8_BAR; PG8_MMA(0, 0, At, B0); PG8_MMA(0, 1, At, B1); PG8_BAR; PG8_SCHED;
            PG8_LDA(At, 1, 1); PG8_STAGE(PG8_SB(1, 0), b3, voffB); PG8_STAGE(PG8_SB(1, 1), b3 + hstep, voffB); PG8_STAGE(PG8_SA(1, 0), a3, voffA);
            PG8_WAIT_V(8); PG8_WAIT_L(0); PG8_BAR; PG8_MMA(1, 0, At, B0); PG8_MMA(1, 1, At, B1); PG8_BAR; PG8_SCHED;
            } else {
            PG8_LDB(B0, 0, 0); PG8_SCHED; PG8_LDA(At, 0, 0); PG8_STAGE(PG8_SA(1, 1), a1 + hstep, voffA);
            PG8_WAIT_L(8); PG8_BAR; PG8_WAIT_L(0); PG8_MMA(0, 0, At, B0); PG8_BAR; PG8_SCHED;
            PG8_LDB(B1, 0, 1); PG8_STAGE(PG8_SB(0, 0), b2, voffB);
            PG8_BAR; PG8_WAIT_L(0); PG8_MMA(0, 1, At, B1); PG8_BAR;
            PG8_LDA(At, 0, 1); PG8_STAGE(PG8_SA(0, 0), a2, voffA);
            PG8_BAR; PG8_WAIT_L(0); PG8_MMA(1, 0, At, B0); PG8_BAR; PG8_SCHED;
            PG8_STAGE(PG8_SB(0, 1), b2 + hstep, voffB);
            PG8_WAIT_V(6); PG8_BAR; PG8_MMA(1, 1, At, B1); PG8_BAR;
            PG8_LDB(B0, 1, 0); PG8_SCHED; PG8_LDA(At, 1, 0); PG8_STAGE(PG8_SA(0, 1), a2 + hstep, voffA);
            PG8_WAIT_L(8); PG8_BAR; PG8_WAIT_L(0); PG8_MMA(0, 0, At, B0); PG8_BAR; PG8_SCHED;
            PG8_LDB(B1, 1, 1); PG8_STAGE(PG8_SB(1, 0), b3, voffB);
            PG8_BAR; PG8_WAIT_L(0); PG8_MMA(0, 1, At, B1); PG8_BAR;
            PG8_LDA(At, 1, 1); PG8_STAGE(PG8_SA(1, 0), a3, voffA);
            PG8_BAR; PG8_WAIT_L(0); PG8_MMA(1, 0, At, B0); PG8_BAR; PG8_SCHED;
            PG8_STAGE(PG8_SB(1, 1), b3 + hstep, voffB);
            PG8_WAIT_V(6); PG8_BAR; PG8_MMA(1, 1, At, B1); PG8_BAR;
            }
        }
        if constexpr (ALIGN_EPI) { if (wr == 0) PG8_BAR; }
        if constexpr (!Epi::AFTER_DRAIN) { E(acc, cur, wr, wc, fr, fq); S.done(cur); }
        if (!has_next) break;
#pragma unroll
        for (int a = 0; a < 2; ++a)
#pragma unroll
            for (int b = 0; b < 2; ++b)
#pragma unroll
                for (int m = 0; m < 4; ++m)
#pragma unroll
                    for (int n = 0; n < 2; ++n) acc[a][b][m][n] = (f32x4){0.f, 0.f, 0.f, 0.f};
        cur = nxt; cA = nA; cB = nB; ++ui;
        if constexpr (ALIGN_EPI) { if (wr == 1) PG8_BAR; }
    }
    PG8_WAIT_V(0);
    if constexpr (!ALIGN_EPI) { if (wr == 0) PG8_BAR; }
    PG8_BAR;
    if constexpr (Epi::AFTER_DRAIN) { E.fused(acc, cur, wr, wc, fr, fq, lds, wid, lane); S.done(cur); }
#undef PG8_SA
#undef PG8_SB
#undef PG8_STAGE
#undef PG8_LDA
#undef PG8_LDB
#undef PG8_MMA
#undef PG8_WAIT_V
#undef PG8_WAIT_L
#undef PG8_BAR
#undef PG8_SCHED
}
}
namespace pg8 {
typedef unsigned u32x2 __attribute__((ext_vector_type(2)));
__device__ __forceinline__ float bf_lo(unsigned w) { return __uint_as_float(w << 16); }
__device__ __forceinline__ float bf_hi(unsigned w) { return __uint_as_float(w & 0xffff0000u); }
__device__ __forceinline__ u32x4 pack8(const f32x4 a, const f32x4 b) { u32x4 w; w.x = cvt_pk_bf16(a[0], a[1]); w.y = cvt_pk_bf16(a[2], a[3]); w.z = cvt_pk_bf16(b[0], b[1]); w.w = cvt_pk_bf16(b[2], b[3]); return w; }
constexpr float QSCALE = 0.125f * 1.4426950408889634f;

struct EpiIn {
    static constexpr bool PERM = true, AFTER_DRAIN = false;
    bf16_t *Q, *K, *V, *U, *G; const float* rope;
    __device__ __forceinline__ void operator()(const f32x4 (&acc)[2][2][4][2], const Unit& u, int wr, int wc, int fr, int fq) const {
        const int pn = u.pn; int kind, ldc, colt; bf16_t* base;
        if (pn < 4)       { kind = 0; base = Q; ldc = 1024; colt = pn * 256; }
        else if (pn < 8)  { kind = 1; base = K; ldc = 1024; colt = (pn - 4) * 256; }
        else if (pn < 12) { kind = 2; base = V; ldc = 1024; colt = (pn - 8) * 256; }
        else if (pn < 14) { kind = 2; base = U; ldc = 512;  colt = (pn - 12) * 256; }
        else              { kind = 3; base = G; ldc = 2048; colt = (pn - 14) * 256; }
        const int row0 = u.pm * BM + wr * 64 + fr, col0 = colt + wc * 32 + 8 * fq;
        const bool rl = ((wc & 1) == 0) && (fq < 2);
        const float sgn = (fq == 0) ? -1.f : 1.f;
#pragma unroll
        for (int ai = 0; ai < 2; ++ai)
#pragma unroll
            for (int m = 0; m < 4; ++m) {
                const int row = row0 + ai * HALF + m * 16;
                bf16_t* rowp = base + (size_t)row * ldc + col0;
                if (kind <= 1) {
                    const f32x4* rp = (const f32x4*)(rope + (size_t)row * 16);
                    const f32x4 c0 = rp[0], c1 = rp[1], c2 = rp[2], c3 = rp[3];
#pragma unroll
                    for (int bj = 0; bj < 2; ++bj) {
                        f32x4 v0 = acc[ai][bj][m][0], v1 = acc[ai][bj][m][1], p0, p1;
#pragma unroll
                        for (int e = 0; e < 4; ++e) { p0[e] = xor_swz<16>(v0[e]); p1[e] = xor_swz<16>(v1[e]); }
                        if (rl) {
                            v0[0] = v0[0] * c0[0] + sgn * p0[0] * c0[1]; v0[1] = v0[1] * c0[2] + sgn * p0[1] * c0[3];
                            v0[2] = v0[2] * c1[0] + sgn * p0[2] * c1[1]; v0[3] = v0[3] * c1[2] + sgn * p0[3] * c1[3];
                            v1[0] = v1[0] * c2[0] + sgn * p1[0] * c2[1]; v1[1] = v1[1] * c2[2] + sgn * p1[1] * c2[3];
                            v1[2] = v1[2] * c3[0] + sgn * p1[2] * c3[1]; v1[3] = v1[3] * c3[2] + sgn * p1[3] * c3[3];
                        }
                        if (kind == 0) { v0 = v0 * QSCALE; v1 = v1 * QSCALE; }
                        __builtin_nontemporal_store(pack8(v0, v1), (u32x4*)(rowp + bj * HALF));
                    }
                } else {
#pragma unroll
                    for (int bj = 0; bj < 2; ++bj) {
                        f32x4 v0 = acc[ai][bj][m][0], v1 = acc[ai][bj][m][1];
                        if (kind == 3) {
#pragma unroll
                            for (int e = 0; e < 4; ++e) { v0[e] = __builtin_amdgcn_rcpf(1.f + __builtin_amdgcn_exp2f(-1.4426950408889634f * v0[e])); v1[e] = __builtin_amdgcn_rcpf(1.f + __builtin_amdgcn_exp2f(-1.4426950408889634f * v1[e])); }
                        }
                        __builtin_nontemporal_store(pack8(v0, v1), (u32x4*)(rowp + bj * HALF));
                    }
                }
            }
    }
};

struct EpiMerge {
    static constexpr bool PERM = true, AFTER_DRAIN = false;
    const bf16_t* A; const bf16_t* G; const float* pscale; bf16_t* Mg;
    __device__ __forceinline__ void operator()(const f32x4 (&acc)[2][2][4][2], const Unit& u, int wr, int wc, int fr, int fq) const {
        const int row0 = u.pm * BM + wr * 64 + fr, col0 = u.pn * BM + wc * 32 + 8 * fq;
        f32x4 ps[2][2];
#pragma unroll
        for (int bj = 0; bj < 2; ++bj) { ps[bj][0] = *(const f32x4*)(pscale + col0 + bj * HALF); ps[bj][1] = *(const f32x4*)(pscale + col0 + bj * HALF + 4); }
#pragma unroll
        for (int ai = 0; ai < 2; ++ai)
#pragma unroll
            for (int m = 0; m < 4; ++m) {
                const size_t row = (size_t)(row0 + ai * HALF + m * 16);
#pragma unroll
                for (int bj = 0; bj < 2; ++bj) {
                    const int c = col0 + bj * HALF;
                    const u32x4 a8 = __builtin_nontemporal_load((const u32x4*)(A + row * 1024 + c)), ga = __builtin_nontemporal_load((const u32x4*)(G + row * 2048 + c)), gp = __builtin_nontemporal_load((const u32x4*)(G + row * 2048 + 1024 + c));
                    const f32x4 y0 = acc[ai][bj][m][0] * ps[bj][0], y1 = acc[ai][bj][m][1] * ps[bj][1];
                    f32x4 o0, o1;
                    o0[0] = bf_lo(ga.x) * bf_lo(a8.x) + bf_lo(gp.x) * y0[0]; o0[1] = bf_hi(ga.x) * bf_hi(a8.x) + bf_hi(gp.x) * y0[1];
                    o0[2] = bf_lo(ga.y) * bf_lo(a8.y) + bf_lo(gp.y) * y0[2]; o0[3] = bf_hi(ga.y) * bf_hi(a8.y) + bf_hi(gp.y) * y0[3];
                    o1[0] = bf_lo(ga.z) * bf_lo(a8.z) + bf_lo(gp.z) * y1[0]; o1[1] = bf_hi(ga.z) * bf_hi(a8.z) + bf_hi(gp.z) * y1[1];
                    o1[2] = bf_lo(ga.w) * bf_lo(a8.w) + bf_lo(gp.w) * y1[2]; o1[3] = bf_hi(ga.w) * bf_hi(a8.w) + bf_hi(gp.w) * y1[3];
                    __builtin_nontemporal_store(pack8(o0, o1), (u32x4*)(Mg + row * 1024 + c));
                }
                asm volatile("" ::: "memory");
            }
    }
};

struct EpiResA {
    static constexpr bool PERM = true, AFTER_DRAIN = false;
    const float* xi; bf16_t* xb; float* ssq;
    __device__ __forceinline__ void operator()(const f32x4 (&acc)[2][2][4][2], const Unit& u, int wr, int wc, int fr, int fq) const {
        const int row0 = u.pm * BM + wr * 64 + fr, col0 = u.pn * BM + wc * 32 + 8 * fq;
#pragma unroll
        for (int ai = 0; ai < 2; ++ai)
#pragma unroll
            for (int m = 0; m < 4; ++m) {
                const size_t row = (size_t)(row0 + ai * HALF + m * 16); float s = 0.f;
#pragma unroll
                for (int bj = 0; bj < 2; ++bj) {
                    const size_t off = row * 1024 + col0 + bj * HALF;
                    const f32x4 r0 = __builtin_nontemporal_load((const f32x4*)(xi + off)) + acc[ai][bj][m][0], r1 = __builtin_nontemporal_load((const f32x4*)(xi + off + 4)) + acc[ai][bj][m][1];
                    *(u32x4*)(xb + off) = pack8(r0, r1);
                    s += (r0[0] * r0[0] + r0[1] * r0[1]) + (r0[2] * r0[2] + r0[3] * r0[3]) + (r1[0] * r1[0] + r1[1] * r1[1]) + (r1[2] * r1[2] + r1[3] * r1[3]);
                }
                s += xor_swz<16>(s); s = half_sum(s);
                if (fq == 0) ssq[row * 16 + u.pn * 4 + wc] = s;
            }
    }
};
struct EpiResB {
    static constexpr bool PERM = true, AFTER_DRAIN = false;
    bf16_t* xb; float* ssq;
    __device__ __forceinline__ void operator()(const f32x4 (&acc)[2][2][4][2], const Unit& u, int wr, int wc, int fr, int fq) const {
        const int row0 = u.pm * BM + wr * 64 + fr, col0 = u.pn * BM + wc * 32 + 8 * fq;
#pragma unroll
        for (int ai = 0; ai < 2; ++ai)
#pragma unroll
            for (int m = 0; m < 4; ++m) {
                const size_t row = (size_t)(row0 + ai * HALF + m * 16); float s = 0.f;
#pragma unroll
                for (int bj = 0; bj < 2; ++bj) {
                    const size_t off = row * 1024 + col0 + bj * HALF;
                    const u32x4 w = __builtin_nontemporal_load((const u32x4*)(xb + off));
                    const f32x4 r0 = (f32x4){bf_lo(w.x), bf_hi(w.x), bf_lo(w.y), bf_hi(w.y)} + acc[ai][bj][m][0], r1 = (f32x4){bf_lo(w.z), bf_hi(w.z), bf_lo(w.w), bf_hi(w.w)} + acc[ai][bj][m][1];
                    __builtin_nontemporal_store(pack8(r0, r1), (u32x4*)(xb + off));
                    s += (r0[0] * r0[0] + r0[1] * r0[1]) + (r0[2] * r0[2] + r0[3] * r0[3]) + (r1[0] * r1[0] + r1[1] * r1[1]) + (r1[2] * r1[2] + r1[3] * r1[3]);
                }
                s += xor_swz<16>(s); s = half_sum(s);
                if (fq == 0) ssq[row * 16 + u.pn * 4 + wc] = s;
            }
    }
};

struct EpiUp {
    static constexpr bool PERM = true, AFTER_DRAIN = false;
    const float* ssq; bf16_t* Z;
    __device__ __forceinline__ void operator()(const f32x4 (&acc)[2][2][4][2], const Unit& u, int wr, int wc, int fr, int fq) const {
        const int row0 = u.pm * BM + wr * 64 + fr, col0 = u.pn * BM + wc * 32 + 8 * fq;
#pragma unroll
        for (int ai = 0; ai < 2; ++ai)
#pragma unroll
            for (int m = 0; m < 4; ++m) {
                const size_t row = (size_t)(row0 + ai * HALF + m * 16);
                const f32x4 pq = *(const f32x4*)(ssq + row * 16 + 4 * fq);
                float s = (pq[0] + pq[1]) + (pq[2] + pq[3]); s += xor_swz<16>(s); s = half_sum(s);
                const float rstd = 1.0f / sqrtf(s * (1.0f / 1024.0f) + 1e-6f);
#pragma unroll
                for (int bj = 0; bj < 2; ++bj) {
                    f32x4 v0 = acc[ai][bj][m][0] * rstd, v1 = acc[ai][bj][m][1] * rstd;
#pragma unroll
                    for (int e = 0; e < 4; ++e) { const float a = fmaxf(v0[e], 0.f), b = fmaxf(v1[e], 0.f); v0[e] = a * a; v1[e] = b * b; }
                    __builtin_nontemporal_store(pack8(v0, v1), (u32x4*)(Z + row * 4096 + col0 + bj * HALF));
                }
            }
    }
};
}
namespace att {
#define ATT_LAS __attribute__((address_space(3)))
typedef unsigned short bf16_t;
typedef short bf16x8 __attribute__((ext_vector_type(8)));
typedef short s16x4 __attribute__((ext_vector_type(4)));
typedef float f32x16 __attribute__((ext_vector_type(16)));
typedef unsigned u32x4 __attribute__((ext_vector_type(4)));
constexpr int SEQ = 4096, PITCH = 1024;
constexpr int KBUF = 0, VBUF = 32768, WSF = 65536, QBUF = 65536 + 4096, ATT_LDS_BYTES = QBUF + 8 * 8192;
constexpr float THR = 8.0f;
__device__ __forceinline__ int crow(int r, int hi) { return (r & 3) + 8 * (r >> 2) + 4 * hi; }
__device__ __forceinline__ int koffs(int row, int ch) { return row * 256 + ((ch ^ (row & 15)) << 4); }
__device__ __forceinline__ int voffs(int row, int ch) { return 2048 * (row >> 3) + 512 * (ch >> 2) + 64 * (row & 7) + 16 * ((ch & 3) ^ ((row >> 2) & 3)); }
__device__ __forceinline__ unsigned cvtpk(float lo, float hi) { unsigned r; asm volatile("v_cvt_pk_bf16_f32 %0, %1, %2" : "=v"(r) : "v"(lo), "v"(hi)); return r; }
__device__ __forceinline__ s16x4 vtr(const ATT_LAS unsigned char* p) { return __builtin_bit_cast(s16x4, __builtin_amdgcn_ds_read_tr16_b64_v4i16((ATT_LAS s16x4*)p)); }
__device__ __forceinline__ int sub1(int a) { int v = a ^ 128; asm volatile("" : "+v"(v)); return v; }
__device__ __forceinline__ void glds16(const char* sbase, unsigned voff, unsigned lds_dst) { unsigned keep;
    asm volatile("s_mov_b32 %0, m0\n\ts_mov_b32 m0, %3\n\ts_nop 0\n\tglobal_load_lds_dwordx4 %1, %2\n\ts_mov_b32 m0, %0" : "=&s"(keep) : "v"(voff), "s"(sbase), "s"(lds_dst) : "memory"); }
#define ATT_MFMA(a, b, c) __builtin_amdgcn_mfma_f32_32x32x16_bf16((a), (b), (c), 0, 0, 0)

template <bool C1> __device__ __forceinline__ void qk_issue(f32x16& s0, const ATT_LAS unsigned char* kb, const ATT_LAS unsigned char* qb_, const int (&kaddr)[4]) {
#pragma unroll
    for (int i = 0; i < 16; ++i) s0[i] = 0.f;
#pragma unroll
    for (int ds = 0; ds < 4; ++ds) {
        const int ad = C1 ? sub1(kaddr[ds]) : kaddr[ds];
        const bf16x8 a0 = *(const ATT_LAS bf16x8*)(kb + ad);
        const bf16x8 qv = *(const ATT_LAS bf16x8*)(qb_ + ad);
        s0 = ATT_MFMA(a0, qv, s0);
    }
}
__device__ __forceinline__ void rowmax_rescale(bool MASK, f32x16& s0, f32x16 (&O)[4], float& m, float& l, int kvr, int r, int h, ATT_LAS float* wsf) {
    if (MASK) {
        asm volatile("" ::: "memory");
        const int d = r - 4 * h - kvr;
#pragma unroll
        for (int i = 0; i < 16; ++i) { if (((i & 3) + 8 * (i >> 2)) > d) s0[i] = -INFINITY; }
    }
    float ra = __builtin_fmaxf(__builtin_fmaxf(s0[0], s0[1]), s0[2]), rb = __builtin_fmaxf(__builtin_fmaxf(s0[3], s0[4]), s0[5]);
    ra = __builtin_fmaxf(__builtin_fmaxf(ra, s0[6]), s0[7]); rb = __builtin_fmaxf(__builtin_fmaxf(rb, s0[8]), s0[9]);
    ra = __builtin_fmaxf(__builtin_fmaxf(ra, s0[10]), s0[11]); rb = __builtin_fmaxf(__builtin_fmaxf(rb, s0[12]), s0[13]);
    ra = __builtin_fmaxf(__builtin_fmaxf(ra, s0[14]), s0[15]);
    const float rm = half_max(__builtin_fmaxf(ra, rb));
    if (__any(rm > m + THR)) {
        const float mn = fmaxf(m, rm), al = __builtin_amdgcn_exp2f(m - mn);
        l *= al; m = mn;
        if (h == 0) wsf[r] = al;
#pragma unroll
        for (int i = 0; i < 16; ++i) { const float a = wsf[crow(i, h)];
#pragma unroll
            for (int db = 0; db < 4; ++db) O[db][i] *= a; }
    }
}
template <bool HAS_PV, bool HAS_QK, bool C1>
__device__ __forceinline__ float step_fused(f32x16& Scur, float m, float& l, u32x4 (&pkout)[2],
                                           f32x16 (&Opv)[4], const u32x4 (&pkin)[2], const ATT_LAS unsigned char* vb, const int (&vaddr)[2],
                                           f32x16& Snext, const ATT_LAS unsigned char* kb, const ATT_LAS unsigned char* qb_, const int (&kaddr)[4]) {
    s16x4 vlo[2], vhi[2]; bf16x8 ka, qa;
    if (HAS_PV) {
#pragma unroll
        for (int u = 0; u < 2; ++u) { vlo[u] = vtr(vb + vaddr[0] + u * 512); vhi[u] = vtr(vb + vaddr[1] + u * 512); } }
    if (HAS_QK) { const int ad = C1 ? sub1(kaddr[0]) : kaddr[0]; ka = *(const ATT_LAS bf16x8*)(kb + ad); qa = *(const ATT_LAS bf16x8*)(qb_ + ad);
#pragma unroll
        for (int i = 0; i < 16; ++i) Snext[i] = 0.f; }
    float sa = 0.f, sb = 0.f;
#pragma unroll
    for (int g = 0; g < 4; ++g) {
        s16x4 nlo[2], nhi[2]; bf16x8 nk, nq;
        if (g < 3) {
            if (HAS_PV) {
#pragma unroll
                for (int u = 0; u < 2; ++u) { const int off = (2 * ((g + 1) & 1) + u) * 512 + ((g + 1) >> 1) * 4096; nlo[u] = vtr(vb + vaddr[0] + off); nhi[u] = vtr(vb + vaddr[1] + off); } }
            if (HAS_QK) { const int ad = C1 ? sub1(kaddr[g + 1]) : kaddr[g + 1]; nk = *(const ATT_LAS bf16x8*)(kb + ad); nq = *(const ATT_LAS bf16x8*)(qb_ + ad); }
        }
        if (HAS_PV) { const bf16x8 pa = __builtin_bit_cast(bf16x8, pkin[g >> 1]);
#pragma unroll
            for (int u = 0; u < 2; ++u) { const bf16x8 vf = __builtin_shufflevector(vlo[u], vhi[u], 0, 1, 2, 3, 4, 5, 6, 7); Opv[2 * (g & 1) + u] = ATT_MFMA(pa, vf, Opv[2 * (g & 1) + u]); } }
        if (HAS_QK) Snext = ATT_MFMA(ka, qa, Snext);
#pragma unroll
        for (int e = 4 * g; e < 4 * g + 4; e += 2) { Scur[e] = __builtin_amdgcn_exp2f(Scur[e] - m); Scur[e + 1] = __builtin_amdgcn_exp2f(Scur[e + 1] - m); sa += Scur[e]; sb += Scur[e + 1]; }
        if (g & 1) pkout[g >> 1] = (u32x4){cvtpk(Scur[4 * g - 4], Scur[4 * g - 3]), cvtpk(Scur[4 * g - 2], Scur[4 * g - 1]), cvtpk(Scur[4 * g], Scur[4 * g + 1]), cvtpk(Scur[4 * g + 2], Scur[4 * g + 3])};
        if (g < 3) {
            if (HAS_PV) {
#pragma unroll
                for (int u = 0; u < 2; ++u) { vlo[u] = nlo[u]; vhi[u] = nhi[u]; } }
            if (HAS_QK) { ka = nk; qa = nq; }
        }
        __builtin_amdgcn_sched_barrier(0);
    }
    l += sa + sb;
    return sa + sb;
}
__device__ __forceinline__ void pv_issue(f32x16 (&O)[4], const u32x4 (&pk)[2], const ATT_LAS unsigned char* vb, const int (&vaddr)[2]) {
#pragma unroll
    for (int s_ = 0; s_ < 2; ++s_) { const bf16x8 pa = __builtin_bit_cast(bf16x8, pk[s_]);
#pragma unroll
        for (int db = 0; db < 4; ++db) {
            const s16x4 lo = vtr(vb + vaddr[0] + db * 512 + s_ * 4096), hi = vtr(vb + vaddr[1] + db * 512 + s_ * 4096);
            const bf16x8 vf = __builtin_shufflevector(lo, hi, 0, 1, 2, 3, 4, 5, 6, 7);
            O[db] = ATT_MFMA(pa, vf, O[db]); } }
}

__device__ __forceinline__ void apply_mask(bool MASK, f32x16& s0, int kvr, int r, int h) {
    if (MASK) {
        asm volatile("" ::: "memory");
        const int d = r - 4 * h - kvr;
#pragma unroll
        for (int i = 0; i < 16; ++i) { if (((i & 3) + 8 * (i >> 2)) > d) s0[i] = -INFINITY; }
    }
}
constexpr float GUARD = 65536.0f;
template <bool C1> __device__ __forceinline__ void slow_step(bool MASK, f32x16& S, const ATT_LAS unsigned char* kb, const ATT_LAS unsigned char* qbase, const int (&kaddr)[4], const int (&vaddr)[2],
                                                             f32x16 (&O)[4], float& m, float& l, float l_saved, int kvr, int r, int h, ATT_LAS float* wsf, u32x4 (&pk)[2]) {
    l = l_saved;
    qk_issue<C1>(S, kb, qbase, kaddr);
    rowmax_rescale(MASK, S, O, m, l, kvr, r, h, wsf);
    f32x16 dummy;
    step_fused<false, false, false>(S, m, l, pk, O, pk, kb, vaddr, dummy, kb, qbase, kaddr);
}
__device__ __forceinline__ void tile_body(bool MASK, const ATT_LAS unsigned char* kb, const ATT_LAS unsigned char* vb, const ATT_LAS unsigned char* qbase, const int (&kaddr)[4], const int (&vaddr)[2],
                                                               f32x16 (&O1)[4], f32x16 (&O2)[4], float& m1, float& m2, float& l1, float& l2, int kvrel, int r, int h, ATT_LAS float* wsf) {
    f32x16 Sa, Sb; u32x4 pkA[2], pkB[2]; float ls, sm;
    qk_issue<false>(Sa, kb, qbase, kaddr);
    apply_mask(MASK, Sa, kvrel, r, h); ls = l1;
    sm = step_fused<false, true, true>(Sa, m1, l1, pkA, O1, pkA, vb, vaddr, Sb, kb, qbase, kaddr);
    if (__any(!(sm <= GUARD))) slow_step<false>(MASK, Sa, kb, qbase, kaddr, vaddr, O1, m1, l1, ls, kvrel, r, h, wsf, pkA);
    apply_mask(MASK, Sb, kvrel, r, h); ls = l2;
    sm = step_fused<true, true, false>(Sb, m2, l2, pkB, O1, pkA, vb, vaddr, Sa, kb + 8192, qbase, kaddr);
    if (__any(!(sm <= GUARD))) slow_step<true>(MASK, Sb, kb, qbase, kaddr, vaddr, O2, m2, l2, ls, kvrel, r, h, wsf, pkB);
    apply_mask(MASK, Sa, kvrel + 32, r, h); ls = l1;
    sm = step_fused<true, true, true>(Sa, m1, l1, pkA, O2, pkB, vb, vaddr, Sb, kb + 8192, qbase, kaddr);
    if (__any(!(sm <= GUARD))) slow_step<false>(MASK, Sa, kb + 8192, qbase, kaddr, vaddr, O1, m1, l1, ls, kvrel + 32, r, h, wsf, pkA);
    apply_mask(MASK, Sb, kvrel + 32, r, h); ls = l2;
    sm = step_fused<true, false, false>(Sb, m2, l2, pkB, O1, pkA, vb + 8192, vaddr, Sa, kb, qbase, kaddr);
    if (__any(!(sm <= GUARD))) slow_step<true>(MASK, Sb, kb + 8192, qbase, kaddr, vaddr, O2, m2, l2, ls, kvrel + 32, r, h, wsf, pkB);
    pv_issue(O2, pkB, vb + 8192, vaddr);
}

__device__ __forceinline__ void attn_unit(ATT_LAS unsigned char* lds, const bf16_t* Qg, const bf16_t* Kg, const bf16_t* Vg, bf16_t* Og, int b, int head, int qb, float lam, const float* subg) {
    int tid = threadIdx.x; asm volatile("" : "+v"(tid));
    const int lane = tid & 63, r = lane & 31, h = lane >> 5;
    const int w = __builtin_amdgcn_readfirstlane(tid >> 6);
    const size_t rowbase = (size_t)b * SEQ; const int q0 = qb * 256, NT = (q0 + 256) >> 6;
    const char* Kt = (const char*)(Kg + rowbase * PITCH + head * 128);
    const char* Vt = (const char*)(Vg + rowbase * PITCH + head * 128);
    unsigned ksrc[2], vsrc[2];
#pragma unroll
    for (int i = 0; i < 2; ++i) { const int ii = w * 2 + i;
        { const int row = 4 * ii + (lane >> 4), pc = lane & 15; ksrc[i] = (unsigned)(row * 2048 + ((pc ^ (row & 15)) << 4)); }
        { const int row = 8 * (ii >> 1) + ((lane >> 2) & 7), ch = 4 * (2 * (ii & 1) + (lane >> 5)) + ((lane & 3) ^ ((row >> 2) & 3)); vsrc[i] = (unsigned)(row * 2048 + ch * 16); } }
    const unsigned ldsb = (unsigned)(uintptr_t)lds;
#define ATT_STAGE(t, buf) do { _Pragma("unroll") for (int i_ = 0; i_ < 2; ++i_) { \
        glds16(Kt + (size_t)(t) * 131072, ksrc[i_], (unsigned)__builtin_amdgcn_readfirstlane(ldsb + KBUF + (buf) * 16384 + (w * 2 + i_) * 1024)); \
        glds16(Vt + (size_t)(t) * 131072, vsrc[i_], (unsigned)__builtin_amdgcn_readfirstlane(ldsb + VBUF + (buf) * 16384 + (w * 2 + i_) * 1024)); } } while (0)
    ATT_STAGE(0, 0);
    { const char* Qw = (const char*)(Qg + (rowbase + q0 + w * 32) * PITCH + head * 128);
#pragma unroll
      for (int i = 0; i < 8; ++i) { const int row = 4 * i + (lane >> 4), pc = lane & 15;
          glds16(Qw, (unsigned)(row * 2048 + ((pc ^ (row & 15)) << 4)), (unsigned)__builtin_amdgcn_readfirstlane(ldsb + QBUF + w * 8192 + i * 1024)); } }
    const ATT_LAS unsigned char* qbase = lds + QBUF + w * 8192;
    int kaddr[4], vaddr[2];
#pragma unroll
    for (int ds = 0; ds < 4; ++ds) kaddr[ds] = koffs(r, 2 * ds + h);
    { const int q = (lane & 15) >> 2, p = lane & 3, blk = (lane >> 4) & 1;
#pragma unroll
      for (int sub = 0; sub < 2; ++sub) vaddr[sub] = voffs(8 * sub + 4 * h + q, 2 * blk + (p >> 1)) + 8 * (p & 1); }
    ATT_LAS float* wsf = (ATT_LAS float*)(lds + WSF + w * 512);
    f32x16 O1[4], O2[4];
#pragma unroll
    for (int db = 0; db < 4; ++db)
#pragma unroll
        for (int i = 0; i < 16; ++i) { O1[db][i] = 0.f; O2[db][i] = 0.f; }
    float m1 = -1e30f, m2 = -1e30f, l1 = 0.f, l2 = 0.f;
    asm volatile("s_waitcnt vmcnt(0)" ::: "memory"); __syncthreads();
    for (int t = 0; t < NT; ++t) {
        const int buf = t & 1;
        if (t + 1 < NT) ATT_STAGE(t + 1, buf ^ 1);
        const int kvrel = 64 * t - q0 - 32 * w;
        if (kvrel <= 31) {
            const ATT_LAS unsigned char* kb = lds + KBUF + buf * 16384;
            const ATT_LAS unsigned char* vb = lds + VBUF + buf * 16384;
            tile_body(kvrel + 63 > 0, kb, vb, qbase, kaddr, vaddr, O1, O2, m1, m2, l1, l2, kvrel, r, h, wsf);
        }
        asm volatile("s_waitcnt vmcnt(0)" ::: "memory"); __syncthreads();
    }
    l1 = half_sum(l1); l2 = half_sum(l2);
    if (h == 0) { wsf[r] = 1.0f / l1; wsf[32 + r] = lam / l2; }
    float sg[4];
#pragma unroll
    for (int db = 0; db < 4; ++db) sg[db] = subg[32 * db + r] * 0.8f;
    bf16_t* Ow = Og + (rowbase + q0 + w * 32) * PITCH + head * 128 + r;
#pragma unroll
    for (int i = 0; i < 16; ++i) {
        const int qr = crow(i, h); const float a1 = wsf[qr], a2 = wsf[32 + qr];
        float o[4], ss = 0.f;
#pragma unroll
        for (int db = 0; db < 4; ++db) { o[db] = O1[db][i] * a1 - O2[db][i] * a2; ss += o[db] * o[db]; }
        ss += xor_swz<1>(ss); ss += xor_swz<2>(ss); ss += xor_swz<4>(ss); ss += xor_swz<8>(ss); ss += xor_swz<16>(ss);
        const float rs = 1.0f / sqrtf(ss * (1.0f / 128.0f) + 1e-6f);
#pragma unroll
        for (int db = 0; db < 4; ++db) Ow[(size_t)qr * PITCH + 32 * db] = (bf16_t)(cvtpk(o[db] * rs * sg[db], 0.f) & 0xffffu);
    }
#undef ATT_STAGE
}
}
constexpr int NWAVES = 8;
constexpr int BATCH = 16, SEQ = 4096, D = 1024, NH = 8, FF = 4096, INW = 5632, M = BATCH * SEQ;
constexpr float RMS_EPS = 1e-6f;
constexpr size_t MiB = 1u << 20;
constexpr size_t WS_WIN = 0, WS_WOUT = 11 * MiB, WS_WUP = 13 * MiB, WS_WDOWN = 21 * MiB, WS_WPOOL = 29 * MiB;
constexpr size_t WS_ROPE = 30 * MiB;
constexpr size_t WS_SSQ1 = 34 * MiB, WS_SSQ2 = 38 * MiB;
constexpr size_t WS_BAR = 42 * MiB, BAR_ZERO_BYTES = 32768;
constexpr size_t WS_XN = 48 * MiB;
constexpr size_t WS_Q = 176 * MiB;
constexpr size_t WS_K = 304 * MiB;
constexpr size_t WS_V = 432 * MiB;
constexpr size_t WS_U = 560 * MiB;
constexpr size_t WS_G = 624 * MiB;
constexpr size_t WS_DP = 880 * MiB;
constexpr size_t WS_Z = 176 * MiB;
constexpr size_t WS_END = 944 * MiB;
static_assert(WS_Z + (size_t)M * FF * 2 <= WS_DP && WS_DP + (size_t)M * 512 * 2 <= WS_END, "d_ws map");
constexpr int LDS_MISC_OFF = 147456 - 256;
constexpr int LDS_BYTES = 147456;

#define LAS __attribute__((address_space(3)))
typedef unsigned short bf16;
typedef unsigned v4u __attribute__((ext_vector_type(4)));
typedef float f32x4 __attribute__((ext_vector_type(4)));
__device__ __forceinline__ unsigned f2bf(float f) { unsigned u = __builtin_bit_cast(unsigned, f); return (u + 0x7fffu + ((u >> 16) & 1u)) >> 16; }
__device__ __forceinline__ unsigned pk2(float lo, float hi) { return f2bf(lo) | (f2bf(hi) << 16); }
__device__ __forceinline__ float wave_sum(float v) {
    v += xor_swz<1>(v); v += xor_swz<2>(v); v += xor_swz<4>(v); v += xor_swz<8>(v); v += xor_swz<16>(v);
    return half_sum(v);
}
__device__ __forceinline__ void p0_transpose_item(const float* W, int K, int N, bf16* WT, int row_off, const float* kscale, LAS float* scr, int item, int lane) {
    const int nblk = N / 32, kb = item / nblk, nb = item % nblk, k0 = 64 * kb, n0 = 32 * nb;
#pragma unroll 8
    for (int i = 0; i < 32; ++i) { const int kk = 2 * i + (lane >> 5); float v = W[(size_t)(k0 + kk) * N + n0 + (lane & 31)]; if (kscale) v *= kscale[k0 + kk]; scr[kk * 33 + (lane & 31)] = v; }
    asm volatile("s_waitcnt lgkmcnt(0)" ::: "memory");
    const int c = lane & 7;
#pragma unroll
    for (int j = 0; j < 4; ++j) { const int n = (lane >> 3) + 8 * j; const LAS float* s = scr + (8 * c) * 33 + n;
        v4u o; o.x = pk2(s[0 * 33], s[1 * 33]); o.y = pk2(s[2 * 33], s[3 * 33]); o.z = pk2(s[4 * 33], s[5 * 33]); o.w = pk2(s[6 * 33], s[7 * 33]);
        *(v4u*)(WT + (size_t)(row_off + n0 + n) * K + k0 + 8 * c) = o; }
    asm volatile("s_waitcnt lgkmcnt(0)" ::: "memory");
}

#define XB_TMO      128
#define XB_XCNT(j)  (256  + 64 * (j))
#define XB_XSUB(j)  (1280 + 64 * (j))
#define XB_XGEN(j)  (2304 + 64 * (j))
#define XB_TOP      3328
#define XB_TOPGEN   3392
#define XCD_BAR_WORDS 3456
#define XB_SPIN_CAP (1u << 18)

__device__ __forceinline__ unsigned xb_ld(unsigned* p)              { return __hip_atomic_load(p, __ATOMIC_RELAXED, __HIP_MEMORY_SCOPE_AGENT); }
__device__ __forceinline__ unsigned xb_add(unsigned* p, unsigned v) { return __hip_atomic_fetch_add(p, v, __ATOMIC_RELAXED, __HIP_MEMORY_SCOPE_AGENT); }
__device__ __forceinline__ unsigned xb_xcc_id() { return (unsigned)__builtin_amdgcn_s_getreg((3 << 11) | 20) & 0xFu; }
#define XB_SPIN(cond, bar) do { unsigned _sp = 0; while (cond) { __builtin_amdgcn_s_sleep(1); \
    if ((++_sp & 255u) == 0u) { if (xb_ld(&(bar)[XB_TMO])) break; if (_sp > XB_SPIN_CAP) { atomicAdd(&(bar)[XB_TMO], 1u); break; } } } } while (0)

struct XcdBarrier {
    unsigned* bar; unsigned x;
    volatile LAS unsigned* st;
};

__device__ __forceinline__ XcdBarrier xcd_barrier_post(unsigned* bar, volatile LAS unsigned* st) {
    XcdBarrier b; b.bar = bar; b.x = xb_xcc_id(); b.st = st;
    if (threadIdx.x == 0) (void)xb_add(&bar[XB_XCNT(b.x)], 1u);
    return b;
}
__device__ __forceinline__ void xcd_barrier_complete(unsigned* bar, unsigned x, unsigned& nloc, unsigned& nx) {
    const unsigned G = gridDim.x * gridDim.y * gridDim.z;
    unsigned sum, cnt, mine, sp = 0u;
    for (;;) {
        sum = 0u; cnt = 0u; mine = 0u;
#pragma unroll
        for (unsigned j = 0; j < 16; ++j) { const unsigned c = xb_ld(&bar[XB_XCNT(j)]); sum += c; cnt += (c > 0u) ? 1u : 0u; mine = (j == x) ? c : mine; }
        if (sum == G) break;
        __builtin_amdgcn_s_sleep(1);
        if ((++sp & 255u) == 0u) { if (xb_ld(&bar[XB_TMO])) break; if (sp > XB_SPIN_CAP) { atomicAdd(&bar[XB_TMO], 1u); break; } }
    }
    nloc = mine > 0u ? mine : 1u; nx = cnt > 0u ? cnt : 1u;
}

__device__ __forceinline__ void xcd_barrier(const XcdBarrier& b) {
    asm volatile("s_waitcnt vmcnt(0)" ::: "memory");
    __syncthreads();
    if (threadIdx.x == 0) {
        unsigned* bar = b.bar;
        __builtin_amdgcn_s_waitcnt(0);
        unsigned nloc = b.st[0], nx = b.st[1];
        if (nloc == 0u) { xcd_barrier_complete(bar, b.x, nloc, nx); b.st[0] = nloc; b.st[1] = nx; }
        const unsigned old = xb_add(&bar[XB_XSUB(b.x)], 1u);
        const unsigned gen = old / nloc;
        if (old + 1u == (gen + 1u) * nloc) {
            __builtin_amdgcn_fence(__ATOMIC_RELEASE, "agent");
            asm volatile("s_waitcnt vmcnt(0)" ::: "memory");
            const unsigned og = xb_add(&bar[XB_TOP], 1u);
            const unsigned tg = og / nx;
            if (og + 1u == (tg + 1u) * nx) xb_add(&bar[XB_TOPGEN], 1u);
            else XB_SPIN(xb_ld(&bar[XB_TOPGEN]) == tg, bar);
            __builtin_amdgcn_fence(__ATOMIC_ACQUIRE, "agent");
            xb_add(&bar[XB_XGEN(b.x)], 1u);
            asm volatile("s_waitcnt vmcnt(0)" ::: "memory");
        } else {
            XB_SPIN(xb_ld(&bar[XB_XGEN(b.x)]) == gen, bar);
            __builtin_amdgcn_fence(__ATOMIC_ACQUIRE, "agent");
            asm volatile("s_waitcnt vmcnt(0)" ::: "memory");
        }
    }
    __syncthreads();
}

#ifndef REP_P0
#define REP_P0 1
#endif
#ifndef REP_P1
#define REP_P1 1
#endif
#ifndef REP_P2
#define REP_P2 1
#endif
#ifndef REP_P3
#define REP_P3 1
#endif
#ifndef REP_P4
#define REP_P4 1
#endif
#ifndef REP_P5
#define REP_P5 1
#endif
template <int W> __device__ __forceinline__ v4u pool_window(const bf16* up, int t) {
    v4u q[W];
#pragma unroll
    for (int j = 0; j < W; ++j) q[j] = *(const v4u*)(up - (size_t)((j <= t) ? j : 0) * 512);
    float acc[8];
#pragma unroll
    for (int e = 0; e < 8; ++e) acc[e] = 0.f;
#pragma unroll
    for (int j = 0; j < W; ++j) { const float wgt = (j <= t) ? 1.f : 0.f;
        acc[0] += wgt * pg8::bf_lo(q[j].x); acc[1] += wgt * pg8::bf_hi(q[j].x); acc[2] += wgt * pg8::bf_lo(q[j].y); acc[3] += wgt * pg8::bf_hi(q[j].y);
        acc[4] += wgt * pg8::bf_lo(q[j].z); acc[5] += wgt * pg8::bf_hi(q[j].z); acc[6] += wgt * pg8::bf_lo(q[j].w); acc[7] += wgt * pg8::bf_hi(q[j].w); }
    const float inv = 1.0f / (float)((t + 1 < W) ? (t + 1) : W);
    v4u o;
    o.x = pk2(acc[0] * inv - pg8::bf_lo(q[0].x), acc[1] * inv - pg8::bf_hi(q[0].x)); o.y = pk2(acc[2] * inv - pg8::bf_lo(q[0].y), acc[3] * inv - pg8::bf_hi(q[0].y));
    o.z = pk2(acc[4] * inv - pg8::bf_lo(q[0].z), acc[5] * inv - pg8::bf_hi(q[0].z)); o.w = pk2(acc[6] * inv - pg8::bf_lo(q[0].w), acc[7] * inv - pg8::bf_hi(q[0].w));
    return o;
}

struct Args {
    const float* x; const int* pos; const float* g_attn; const float* w_in; const float* lq1; const float* lk1; const float* lq2; const float* lk2;
    const float* subln_g; const float* w_pool; const float* pool_scale; const float* w_out; const float* g_mlp; const float* w_up; const float* w_down; const float* g_final;
    float* out; unsigned char* ws;
};

__global__ void __launch_bounds__(NWAVES * 64, 2) hybrid_fwd(Args a) {
    extern __shared__ __attribute__((aligned(16))) unsigned char lds_raw[];
    LAS unsigned char* lds = (LAS unsigned char*)lds_raw;
    cg::grid_group grid = cg::this_grid();
    if (threadIdx.x < 2) ((volatile LAS unsigned*)(lds + LDS_MISC_OFF))[threadIdx.x] = 0u;
    __syncthreads();
    const int G = gridDim.x, bx = blockIdx.x;
#define PHASE_IDS int tid = threadIdx.x; asm volatile("" : "+v"(tid)); const int lane = tid & 63, wave = __builtin_amdgcn_readfirstlane(tid >> 6); const int gw = vcu * NWAVES + wave, NGW = G * NWAVES; (void)lane; (void)gw; (void)NGW
    const int vcu = (G % 8 == 0) ? (bx % 8) * (G / 8) + bx / 8 : bx;
    unsigned char* ws = a.ws;
    bf16* Win_t = (bf16*)(ws + WS_WIN); bf16* Wout_t = (bf16*)(ws + WS_WOUT); bf16* Wup_t = (bf16*)(ws + WS_WUP); bf16* Wdown_t = (bf16*)(ws + WS_WDOWN); bf16* Wpool_t = (bf16*)(ws + WS_WPOOL);
    float* rope = (float*)(ws + WS_ROPE); float* ssq1 = (float*)(ws + WS_SSQ1); float* ssq2 = (float*)(ws + WS_SSQ2);
    bf16* XN = (bf16*)(ws + WS_XN); bf16* Qb = (bf16*)(ws + WS_Q); bf16* Kb = (bf16*)(ws + WS_K); bf16* Vb = (bf16*)(ws + WS_V);
    bf16* Ub = (bf16*)(ws + WS_U); bf16* Gb = (bf16*)(ws + WS_G); bf16* Dp = (bf16*)(ws + WS_DP); bf16* Zb = (bf16*)(ws + WS_Z); bf16* Mg = Kb; bf16* Ab = XN;

    for (int rep_ = 0; rep_ < REP_P0; ++rep_) {
        PHASE_IDS;
        LAS float* scr = (LAS float*)(lds + wave * 16384);
        constexpr int I_IN = (D / 64) * (INW / 32), I_OUT = (D / 64) * (D / 32), I_UP = (D / 64) * (FF / 32), I_DOWN = (FF / 64) * (D / 32), I_POOL1 = (128 / 64) * (256 / 32);
        constexpr int NITEMS = I_IN + I_OUT + I_UP + I_DOWN + 4 * I_POOL1;
        for (int it = gw; it < NITEMS; it += NGW) {
            int r = it;
            if (r < I_IN) { p0_transpose_item(a.w_in, D, INW, Win_t, 0, nullptr, scr, r, lane); continue; } r -= I_IN;
            if (r < I_OUT) { p0_transpose_item(a.w_out, D, D, Wout_t, 0, nullptr, scr, r, lane); continue; } r -= I_OUT;
            if (r < I_UP) { p0_transpose_item(a.w_up, D, FF, Wup_t, 0, a.g_mlp, scr, r, lane); continue; } r -= I_UP;
            if (r < I_DOWN) { p0_transpose_item(a.w_down, FF, D, Wdown_t, 0, nullptr, scr, r, lane); continue; } r -= I_DOWN;
            { const int g = r / I_POOL1; p0_transpose_item(a.w_pool + (size_t)g * 128 * 256, 128, 256, Wpool_t, g * 256, nullptr, scr, r % I_POOL1, lane); }
        }
        for (int e = bx * (NWAVES * 64) + tid; e < M * 8; e += G * NWAVES * 64) {
            const int row = e >> 3, i = e & 7;
            const float invf = (i == 0) ? 1.0f : (i == 1) ? 0.19392274474868576f : (i == 2) ? 0.03760603093086393f : (i == 3) ? 0.007292664737217109f :
                               (i == 4) ? 0.001414213562373095f : (i == 5) ? 0.0002742481756762073f : (i == 6) ? 5.318295896944988e-05f : 1.031338537721246e-05f;
            const float ang = (float)a.pos[row] * invf;
            double rev = (double)ang * 0.15915494309189535; rev -= __builtin_rint(rev);
            const float rf = (float)rev;
            rope[(size_t)e * 2] = __builtin_amdgcn_cosf(rf); rope[(size_t)e * 2 + 1] = __builtin_amdgcn_sinf(rf);
        }
        {
            const f32x4* gr = (const f32x4*)a.g_attn + lane; f32x4 gg[4];
#pragma unroll
            for (int j = 0; j < 4; ++j) gg[j] = gr[64 * j];
            for (int m0 = gw * 4; m0 < M; m0 += NGW * 4) {
                f32x4 v[4][4]; float s2[4];
#pragma unroll
                for (int q = 0; q < 4; ++q) { const f32x4* xr = (const f32x4*)(a.x + (size_t)(m0 + q) * D) + lane;
#pragma unroll
                    for (int j = 0; j < 4; ++j) v[q][j] = __builtin_nontemporal_load(xr + 64 * j); }
#pragma unroll
                for (int q = 0; q < 4; ++q) { s2[q] = 0.f;
#pragma unroll
                    for (int j = 0; j < 4; ++j) s2[q] += (v[q][j].x * v[q][j].x + v[q][j].y * v[q][j].y) + (v[q][j].z * v[q][j].z + v[q][j].w * v[q][j].w); }
#pragma unroll
                for (int q = 0; q < 4; ++q) { const float rstd = 1.0f / sqrtf(wave_sum(s2[q]) * (1.f / D) + RMS_EPS);
                    unsigned long long* o8 = (unsigned long long*)(XN + (size_t)(m0 + q) * D) + lane;
#pragma unroll
                    for (int j = 0; j < 4; ++j) { const f32x4 y = v[q][j] * rstd * gg[j];
                        o8[64 * j] = (unsigned long long)pk2(y.x, y.y) | ((unsigned long long)pk2(y.z, y.w) << 32); } }
            }
        }
    if (bx == 0) { for (int i = threadIdx.x; i < (int)(BAR_ZERO_BYTES / 4); i += NWAVES * 64) ((unsigned*)(a.ws + WS_BAR))[i] = 0u; }
    grid.sync(); }
    unsigned seam_no = 0, seam2_no = 0, xc_nloc = 1, xc_ngroups = 1;
    const unsigned xcc = (unsigned)__builtin_amdgcn_s_getreg((3 << 11) | 20) & 0xFu;
    if (threadIdx.x == 0) __hip_atomic_fetch_add((unsigned*)(a.ws + WS_BAR) + 64 * (80 + xcc), 1u, __ATOMIC_RELAXED, __HIP_MEMORY_SCOPE_AGENT);
#define SEAM2() do { ++seam2_no; asm volatile("s_waitcnt vmcnt(0)" ::: "memory"); __syncthreads(); \
        if (threadIdx.x == 0) { unsigned* w_ = (unsigned*)(a.ws + WS_BAR); \
            const unsigned old_ = __hip_atomic_fetch_add(w_ + 64 * (32 + xcc), 1u, __ATOMIC_RELAXED, __HIP_MEMORY_SCOPE_AGENT); \
            if (old_ + 1u == seam2_no * xc_nloc) { \
                __builtin_amdgcn_fence(__ATOMIC_RELEASE, "agent"); asm volatile("s_waitcnt vmcnt(0)" ::: "memory"); \
                __hip_atomic_fetch_add(w_ + 64 * 64, 1u, __ATOMIC_RELAXED, __HIP_MEMORY_SCOPE_AGENT); \
                while (__hip_atomic_load(w_ + 64 * 64, __ATOMIC_RELAXED, __HIP_MEMORY_SCOPE_AGENT) < seam2_no * xc_ngroups) __builtin_amdgcn_s_sleep(1); \
                __hip_atomic_store(w_ + 64 * (48 + xcc), seam2_no, __ATOMIC_RELAXED, __HIP_MEMORY_SCOPE_AGENT); \
            } else { while (__hip_atomic_load(w_ + 64 * (48 + xcc), __ATOMIC_RELAXED, __HIP_MEMORY_SCOPE_AGENT) < seam2_no) __builtin_amdgcn_s_sleep(1); } \
            __builtin_amdgcn_fence(__ATOMIC_ACQUIRE, "agent"); asm volatile("s_waitcnt vmcnt(0)" ::: "memory"); } \
        __syncthreads(); } while (0)
#define SEAM() do { ++seam_no; asm volatile("s_waitcnt vmcnt(0)" ::: "memory"); __syncthreads(); \
        if (threadIdx.x == 0) { unsigned* w_ = (unsigned*)(a.ws + WS_BAR); const unsigned g_ = (unsigned)bx & 7u, ng_ = ((unsigned)G - g_ + 7u) / 8u, ngroups_ = (unsigned)G < 8u ? (unsigned)G : 8u; \
            __builtin_amdgcn_fence(__ATOMIC_RELEASE, "agent"); asm volatile("s_waitcnt vmcnt(0)" ::: "memory");     \
            const unsigned old_ = __hip_atomic_fetch_add(w_ + 64 * g_, 1u, __ATOMIC_RELAXED, __HIP_MEMORY_SCOPE_AGENT); \
            if (old_ + 1u == seam_no * ng_) { \
                __hip_atomic_fetch_add(w_ + 64 * 16, 1u, __ATOMIC_RELAXED, __HIP_MEMORY_SCOPE_AGENT); \
                while (__hip_atomic_load(w_ + 64 * 16, __ATOMIC_RELAXED, __HIP_MEMORY_SCOPE_AGENT) < seam_no * ngroups_) __builtin_amdgcn_s_sleep(1); \
                __hip_atomic_store(w_ + 64 * (8 + g_), seam_no, __ATOMIC_RELAXED, __HIP_MEMORY_SCOPE_AGENT); \
            } else { while (__hip_atomic_load(w_ + 64 * (8 + g_), __ATOMIC_RELAXED, __HIP_MEMORY_SCOPE_AGENT) < seam_no) __builtin_amdgcn_s_sleep(1); } \
            __builtin_amdgcn_fence(__ATOMIC_ACQUIRE, "agent"); asm volatile("s_waitcnt vmcnt(0)" ::: "memory"); } \
        __syncthreads(); } while (0)

    for (int rep_ = 0; rep_ < REP_P1; ++rep_) {
        pg8::Gemm g{XN, Win_t, M, INW, D, 0}; pg8::StaticOrder S; S.init(M, INW, G, bx);
        pg8::EpiIn E{Qb, Kb, Vb, Ub, Gb, rope};
        pg8::gemm_phase<pg8::EpiIn, pg8::StaticOrder, true, true>(lds, g, S, E);
    SEAM(); }
    if (threadIdx.x == 0) { unsigned ng_ = 0u;
        for (unsigned j = 0; j < 16u; ++j) { const unsigned c_ = __hip_atomic_load((unsigned*)(a.ws + WS_BAR) + 64 * (80 + j), __ATOMIC_RELAXED, __HIP_MEMORY_SCOPE_AGENT); ng_ += (c_ != 0u); if (j == xcc) xc_nloc = c_; }
        xc_ngroups = ng_; }


    for (int rep_ = 0; rep_ < REP_P2; ++rep_) {
        PHASE_IDS;
        for (int wi = gw; wi < M; wi += NGW) {
            const int rq = wi >> 2, gp = ((wi & 3) + (wi >> 11)) & 3;
            const int row = 4 * rq + (lane >> 4), t = row & (SEQ - 1);
            const bf16* up = Ub + (size_t)row * 512 + gp * 128 + (lane & 15) * 8;
            v4u o;
            if (gp == 0) o = pool_window<2>(up, t); else if (gp == 1) o = pool_window<4>(up, t); else if (gp == 2) o = pool_window<8>(up, t); else o = pool_window<16>(up, t);
            *(v4u*)(Dp + ((size_t)gp * M + row) * 128 + (lane & 15) * 8) = o;
        }
        const float sa = wave_sum(a.lq1[lane] * a.lk1[lane]), sb = wave_sum(a.lq2[lane] * a.lk2[lane]);
        const float lam = expf(sa) - expf(sb) + 0.2f;
        for (int pu = vcu; pu < BATCH * NH * 8; pu += G) {
            const int bh = pu >> 3, s = pu & 7, b = bh >> 3, head = bh & 7;
            for (int k = 0; k < 2; ++k) att::attn_unit(lds, Qb, Kb, Vb, Ab, b, head, k ? s : 15 - s, lam, a.subln_g);
        }
    SEAM2(); }

    for (int rep_ = 0; rep_ < REP_P3; ++rep_) {
        pg8::Gemm g{Dp, Wpool_t, M, D, 128, (size_t)M * 128 * 2}; pg8::StaticOrder S; S.init(M, D, G, bx);
        pg8::EpiMerge E{Ab, Gb, a.pool_scale, Mg};
        pg8::gemm_phase<pg8::EpiMerge, pg8::StaticOrder, true, true>(lds, g, S, E);
    SEAM2(); }

    for (int rep_ = 0; rep_ < REP_P4; ++rep_) {
        pg8::Gemm g{Mg, Wout_t, M, D, D, 0}; pg8::StaticOrder S; S.init(M, D, G, bx);
        pg8::EpiResA E{a.x, XN, ssq1};
        pg8::gemm_phase<pg8::EpiResA, pg8::StaticOrder, true, true>(lds, g, S, E);
    SEAM2(); }

    for (int rep_ = 0; rep_ < REP_P5; ++rep_) {
        pg8::Gemm g{XN, Wup_t, M, FF, D, 0}; pg8::StaticOrder S; S.init(M, FF, G, bx);
        pg8::EpiUp E{ssq1, Zb};
        pg8::gemm_phase<pg8::EpiUp, pg8::StaticOrder, true, true>(lds, g, S, E);
    SEAM2(); }

    {
        pg8::Gemm g{Zb, Wdown_t, M, D, FF, 0}; pg8::StaticOrder S; S.init(M, D, G, bx);
        pg8::EpiResB E{XN, ssq2};
        pg8::gemm_phase<pg8::EpiResB, pg8::StaticOrder, true, true>(lds, g, S, E);
    }
    SEAM2();

    { PHASE_IDS;
    const f32x4* gr = (const f32x4*)a.g_final + lane; f32x4 gg[4];
#pragma unroll
    for (int j = 0; j < 4; ++j) gg[j] = gr[64 * j];
    for (int m0 = gw * 4; m0 < M; m0 += NGW * 4) {
        unsigned long long v[4][4]; float s[4];
#pragma unroll
        for (int q = 0; q < 4; ++q) { const unsigned long long* xr = (const unsigned long long*)(XN + (size_t)(m0 + q) * D) + lane; s[q] = ssq2[(size_t)(m0 + q) * 16 + (lane & 15)];
#pragma unroll
            for (int j = 0; j < 4; ++j) v[q][j] = __builtin_nontemporal_load(xr + 64 * j); }
#pragma unroll
        for (int q = 0; q < 4; ++q) { float t = s[q]; t += xor_swz<1>(t); t += xor_swz<2>(t); t += xor_swz<4>(t); t += xor_swz<8>(t);
            const float rstd = 1.0f / sqrtf(t * (1.f / D) + RMS_EPS);
            f32x4* xr = (f32x4*)(a.out + (size_t)(m0 + q) * D) + lane;
#pragma unroll
            for (int j = 0; j < 4; ++j) { const unsigned lo = (unsigned)v[q][j], hi = (unsigned)(v[q][j] >> 32);
                const f32x4 x = (f32x4){pg8::bf_lo(lo), pg8::bf_hi(lo), pg8::bf_lo(hi), pg8::bf_hi(hi)};
                __builtin_nontemporal_store(x * rstd * gg[j], xr + 64 * j); } }
    } }
}

extern "C" void kernel_launch(void* const* d_in, const int* in_sizes, int n_in, void* d_out, int out_size, void* d_ws, size_t ws_size, hipStream_t stream) {
    static int grid = 0;
    if (grid == 0) {
        if (n_in != 16 || in_sizes[0] != M * D || out_size != M * D || ws_size < WS_END) { fprintf(stderr, "kernel_launch: unexpected shapes (n_in %d, in0 %d, out %d, ws %zu); nothing launched\n", n_in, n_in > 0 ? in_sizes[0] : -1, out_size, ws_size); grid = -1; return; }
        int dev = 0, cus = 0, per_cu = 0;
        if (hipGetDevice(&dev) != hipSuccess || hipDeviceGetAttribute(&cus, hipDeviceAttributeMultiprocessorCount, dev) != hipSuccess) { grid = -1; return; }
        if (hipFuncSetAttribute((const void*)hybrid_fwd, hipFuncAttributeMaxDynamicSharedMemorySize, LDS_BYTES) != hipSuccess) { fprintf(stderr, "kernel_launch: hipFuncSetAttribute failed\n"); grid = -1; return; }
        if (hipOccupancyMaxActiveBlocksPerMultiprocessor(&per_cu, (const void*)hybrid_fwd, NWAVES * 64, LDS_BYTES) != hipSuccess || per_cu < 1) per_cu = 1;
        (void)hipGetLastError();
        grid = cus * per_cu;
    }
    if (grid < 0) return;
    Args a{};
    a.x = (const float*)d_in[0]; a.pos = (const int*)d_in[1]; a.g_attn = (const float*)d_in[2]; a.w_in = (const float*)d_in[3];
    a.lq1 = (const float*)d_in[4]; a.lk1 = (const float*)d_in[5]; a.lq2 = (const float*)d_in[6]; a.lk2 = (const float*)d_in[7];
    a.subln_g = (const float*)d_in[8]; a.w_pool = (const float*)d_in[9]; a.pool_scale = (const float*)d_in[10]; a.w_out = (const float*)d_in[11];
    a.g_mlp = (const float*)d_in[12]; a.w_up = (const float*)d_in[13]; a.w_down = (const float*)d_in[14]; a.g_final = (const float*)d_in[15];
    a.out = (float*)d_out; a.ws = (unsigned char*)d_ws;
    void* args[] = {&a};
    const hipError_t e = hipLaunchCooperativeKernel((const void*)hybrid_fwd, dim3(grid), dim3(NWAVES * 64), args, LDS_BYTES, stream);
    if (e != hipSuccess) fprintf(stderr, "kernel_launch: cooperative launch failed: %s (grid %d)\n", hipGetErrorString(e), grid);
}
```

```cpp
#include <hip/hip_runtime.h>
#include <hip/hip_cooperative_groups.h>
#include <cstdio>
#include <cstdint>
#include <cmath>
namespace cg = cooperative_groups;
template <int K> __device__ __forceinline__ float xor_swz(float v) { return __int_as_float(__builtin_amdgcn_ds_swizzle(__float_as_int(v), (K << 10) | 0x1f)); }
__device__ __forceinline__ float half_sum(float v) { auto rr = __builtin_amdgcn_permlane32_swap(__float_as_uint(v), __float_as_uint(v), false, false); return __uint_as_float(rr[0]) + __uint_as_float(rr[1]); }
__device__ __forceinline__ float half_max(float v) { auto rr = __builtin_amdgcn_permlane32_swap(__float_as_uint(v), __float_as_uint(v), false, false); return fmaxf(__uint_as_float(rr[0]), __uint_as_float(rr[1])); }
namespace pg8 {
#define PG8_LAS __attribute__((address_space(3)))
typedef unsigned short bf16_t;
typedef short bf16x8 __attribute__((ext_vector_type(8)));
typedef float f32x4 __attribute__((ext_vector_type(4)));
typedef unsigned u32x4 __attribute__((ext_vector_type(4)));
constexpr int BM = 256, BK = 64, HALF = 128, HTB = HALF * BK * 2  , STAGE_BYTES = 8 * HTB, NXCD = 8, WGM = 8;

__host__ __device__ __forceinline__ int lds_byte(int r, int c) { const int st = (r >> 4) * 2 + (c >> 5), rr = r & 15, cc = c & 31, ob = rr * 64 + cc * 2; return st * 1024 + (ob ^ (((ob >> 9) & 1) << 5)); }
__host__ __device__ __forceinline__ void stage_rc(int b, int& R, int& C) { const int st = b / 1024, sb = b % 1024, swz = sb ^ (((sb >> 9) & 1) << 5); R = (st >> 1) * 16 + swz / 64; C = (st & 1) * 32 + (swz % 64) / 2; }
__host__ __device__ __forceinline__ int perm32(int rho) { const int n = rho >> 4, i = rho & 15; return 8 * (i >> 2) + 4 * n + (i & 3); }

struct Unit { int pm, pn; };
struct Gemm { const bf16_t* A; const bf16_t* Bt; int M, N, K; size_t a_pn_off; };

struct StaticOrder {
    int nM, nN, nwg, G, c;
    __host__ __device__ void init(int M, int N, int G_, int c_) { nM = M / BM; nN = N / BM; nwg = nM * nN; G = G_; c = c_; }
    __host__ __device__ bool next(int i, Unit& u) const {
        const long L = (long)i * G + c; if (L >= nwg) return false;
        int wgid = (int)L; { const int q = nwg / NXCD, r = nwg % NXCD, xcd = wgid % NXCD, off = wgid / NXCD; wgid = (xcd < r ? xcd * (q + 1) : r * (q + 1) + (xcd - r) * q) + off; }
        const int nig = WGM * nN, gid = wgid / nig, fm = gid * WGM, gsz = (nM - fm) < WGM ? (nM - fm) : WGM;
        u.pm = fm + ((wgid % nig) % gsz); u.pn = (wgid % nig) / gsz; return true;
    }
    __device__ __forceinline__ void a_ready(const Unit&) const {}
    __device__ __forceinline__ void done(const Unit&) const {}
};

__device__ __forceinline__ unsigned cvt_pk_bf16(float lo, float hi) { unsigned r; asm volatile("v_cvt_pk_bf16_f32 %0, %1, %2" : "=v"(r) : "v"(lo), "v"(hi)); return r; }
typedef float f32x2 __attribute__((ext_vector_type(2)));
template <class Epi, class Sched, bool ALIGN_EPI = false, bool SP2 = false>
__device__ __forceinline__ void gemm_phase(PG8_LAS unsigned char* lds, const Gemm g, const Sched& S, const Epi& E) {
    int tid = threadIdx.x; asm volatile("" : "+v"(tid));
    const int wid = __builtin_amdgcn_readfirstlane(tid >> 6), lane = tid & 63, wr = wid >> 2, wc = wid & 3, fr = lane & 15, fq = lane >> 4;
    const int K = g.K, nt = K / BK;
    unsigned voffA[2], voffB[2];
#pragma unroll
    for (int i = 0; i < 2; ++i) { int R, C; stage_rc(tid * 16 + i * 8192, R, C); const int Rb = Epi::PERM ? ((R & ~31) + perm32(R & 31)) : R;
        voffA[i] = (unsigned)(R * K + C) * 2u; voffB[i] = (unsigned)(Rb * K + C) * 2u; }
    const size_t kstep = (size_t)(BK * 2);
    const size_t hstep = (size_t)HALF * K * 2;
    const size_t tstep = 2 * hstep;
    const unsigned ldsw = (unsigned)wid * 1024u;
    const int aoff = lds_byte(wr * 64 + fr, fq * 8), boff = lds_byte(wc * 32 + fr, fq * 8);
#define PG8_SA(b, h) (((b) * 2 + (h)) * HTB)
#define PG8_SB(b, h) ((4 + (b) * 2 + (h)) * HTB)
#define PG8_STAGE(bufoff, gbase, voff) do { _Pragma("unroll") for (int _i = 0; _i < 2; ++_i) \
        __builtin_amdgcn_global_load_lds((const unsigned*)((const char*)(gbase) + (voff)[_i]), (PG8_LAS unsigned*)(lds + (bufoff) + ldsw + _i * 8192), 16, 0, 0); } while (0)
#define PG8_LDA(dst, b, h) do { _Pragma("unroll") for (int m = 0; m < 4; ++m) _Pragma("unroll") for (int k = 0; k < 2; ++k) dst[m][k] = *(const PG8_LAS bf16x8*)(lds + PG8_SA(b, h) + aoff + m * 2048 + k * 1024); } while (0)
#define PG8_LDB(dst, b, h) do { _Pragma("unroll") for (int n = 0; n < 2; ++n) _Pragma("unroll") for (int k = 0; k < 2; ++k) dst[n][k] = *(const PG8_LAS bf16x8*)(lds + PG8_SB(b, h) + boff + n * 2048 + k * 1024); } while (0)
#define PG8_MMA(ai, bj, At, Bt) do { __builtin_amdgcn_s_setprio(1); _Pragma("unroll") for (int m = 0; m < 4; ++m) _Pragma("unroll") for (int n = 0; n < 2; ++n) _Pragma("unroll") for (int k = 0; k < 2; ++k) \
        acc[ai][bj][m][n] = __builtin_amdgcn_mfma_f32_16x16x32_bf16(Bt[n][k], At[m][k], acc[ai][bj][m][n], 0, 0, 0); __builtin_amdgcn_s_setprio(0); } while (0)
#define PG8_WAIT_V(n) asm volatile("s_waitcnt vmcnt(" #n ")" ::: "memory")
#define PG8_WAIT_L(n) asm volatile("s_waitcnt lgkmcnt(" #n ")" ::: "memory")
#define PG8_BAR __builtin_amdgcn_s_barrier()
#define PG8_SCHED __builtin_amdgcn_sched_barrier(0)
    Unit cur, nxt; int ui = 0;
    if (!S.next(0, cur)) return;
    f32x4 acc[2][2][4][2];
#pragma unroll
    for (int a = 0; a < 2; ++a)
#pragma unroll
        for (int b = 0; b < 2; ++b)
#pragma unroll
            for (int m = 0; m < 4; ++m)
#pragma unroll
                for (int n = 0; n < 2; ++n) acc[a][b][m][n] = (f32x4){0.f, 0.f, 0.f, 0.f};
    bf16x8 At[4][2], B0[2][2], B1[2][2];
    const char* cA = (const char*)g.A + (size_t)cur.pm * tstep + (size_t)cur.pn * g.a_pn_off; const char* cB = (const char*)g.Bt + (size_t)cur.pn * tstep;
    S.a_ready(cur);
    if constexpr (SP2) {
        PG8_STAGE(PG8_SB(0, 0), cB, voffB); PG8_STAGE(PG8_SB(0, 1), cB + hstep, voffB); PG8_STAGE(PG8_SA(0, 0), cA, voffA); PG8_STAGE(PG8_SA(0, 1), cA + hstep, voffA);
        if (wr == 1) PG8_BAR;
        PG8_WAIT_V(2); PG8_BAR;
        PG8_STAGE(PG8_SB(1, 0), cB + kstep, voffB); PG8_STAGE(PG8_SA(1, 0), cA + kstep, voffA); PG8_STAGE(PG8_SB(1, 1), cB + hstep + kstep, voffB);
        PG8_WAIT_V(6); PG8_BAR;
    } else {
        PG8_STAGE(PG8_SB(0, 0), cB, voffB); PG8_STAGE(PG8_SA(0, 0), cA, voffA); PG8_STAGE(PG8_SB(0, 1), cB + hstep, voffB); PG8_STAGE(PG8_SA(0, 1), cA + hstep, voffA);
        if (wr == 1) PG8_BAR;
        PG8_WAIT_V(4); PG8_BAR;
        PG8_STAGE(PG8_SB(1, 0), cB + kstep, voffB); PG8_STAGE(PG8_SA(1, 0), cA + kstep, voffA); PG8_STAGE(PG8_SB(1, 1), cB + hstep + kstep, voffB);
        PG8_WAIT_V(6); PG8_BAR;
    }
    for (;;) {
        const bool has_next = S.next(ui + 1, nxt);
        const char* nA = has_next ? (const char*)g.A + (size_t)nxt.pm * tstep + (size_t)nxt.pn * g.a_pn_off : cA; const char* nB = has_next ? (const char*)g.Bt + (size_t)nxt.pn * tstep : cB;
        for (int t = 0; t < nt; t += 2) {
            const bool last = (t == nt - 2);
            const char* a1 = cA + (size_t)(t + 1) * kstep;
            const char* a2 = last ? nA : cA + (size_t)(t + 2) * kstep; const char* b2 = last ? nB : cB + (size_t)(t + 2) * kstep;
            const char* a3 = a2 + kstep; const char* b3 = b2 + kstep;
            if (last && has_next) S.a_ready(nxt);
            if constexpr (SP2) {
            PG8_LDB(B0, 0, 0); PG8_LDB(B1, 0, 1); PG8_SCHED; PG8_LDA(At, 0, 0); PG8_STAGE(PG8_SA(1, 1), a1 + hstep, voffA);
            PG8_WAIT_V(8); PG8_WAIT_L(0); PG8_BAR; PG8_MMA(0, 0, At, B0); PG8_MMA(0, 1, At, B1); PG8_BAR; PG8_SCHED;
            PG8_LDA(At, 0, 1); PG8_STAGE(PG8_SB(0, 0), b2, voffB); PG8_STAGE(PG8_SB(0, 1), b2 + hstep, voffB); PG8_STAGE(PG8_SA(0, 0), a2, voffA);
            PG8_WAIT_V(8); PG8_WAIT_L(0); PG8_BAR; PG8_MMA(1, 0, At, B0); PG8_MMA(1, 1, At, B1); PG8_BAR; PG8_SCHED;
            PG8_LDB(B0, 1, 0); PG8_LDB(B1, 1, 1); PG8_SCHED; PG8_LDA(At, 1, 0); PG8_STAGE(PG8_SA(0, 1), a2 + hstep, voffA);
            PG8_WAIT_V(8); PG8_WAIT_L(0); PG8_BAR; PG8_MMA(0, 0, At, B0); PG8_MMA(0, 1, At, B1); PG8_BAR; PG8_SCHED;
            PG8_LDA(At, 1, 1); PG8_STAGE(PG8_SB(1, 0), b3, voffB); PG8_STAGE(PG8_SB(1, 1), b3 + hstep, voffB); PG8_STAGE(PG8_SA(1, 0), a3, voffA);
            PG8_WAIT_V(8); PG8_WAIT_L(0); PG8_BAR; PG8_MMA(1, 0, At, B0); PG8_MMA(1, 1, At, B1); PG8_BAR; PG8_SCHED;
            } else {
            PG8_LDB(B0, 0, 0); PG8_SCHED; PG8_LDA(At, 0, 0); PG8_STAGE(PG8_SA(1, 1), a1 + hstep, voffA);
            PG8_WAIT_L(8); PG8_BAR; PG8_WAIT_L(0); PG8_MMA(0, 0, At, B0); PG8_BAR; PG8_SCHED;
            PG8_LDB(B1, 0, 1); PG8_STAGE(PG8_SB(0, 0), b2, voffB);
            PG8_BAR; PG8_WAIT_L(0); PG8_MMA(0, 1, At, B1); PG8_BAR;
            PG8_LDA(At, 0, 1); PG8_STAGE(PG8_SA(0, 0), a2, voffA);
            PG8_BAR; PG8_WAIT_L(0); PG8_MMA(1, 0, At, B0); PG8_BAR; PG8_SCHED;
            PG8_STAGE(PG8_SB(0, 1), b2 + hstep, voffB);
            PG8_WAIT_V(6); PG8_BAR; PG8_MMA(1, 1, At, B1); PG8_BAR;
            PG8_LDB(B0, 1, 0); PG8_SCHED; PG8_LDA(At, 1, 0); PG8_STAGE(PG8_SA(0, 1), a2 + hstep, voffA);
            PG8_WAIT_L(8); PG8_BAR; PG8_WAIT_L(0); PG8_MMA(0, 0, At, B0); PG8_BAR; PG8_SCHED;
            PG8_LDB(B1, 1, 1); PG8_STAGE(PG8_SB(1, 0), b3, voffB);
            PG8_BAR; PG8_WAIT_L(0); PG8_MMA(0, 1, At, B1); PG8_BAR;
            PG8_LDA(At, 1, 1); PG8_STAGE(PG8_SA(1, 0), a3, voffA);
            PG8_BAR; PG8_WAIT_L(0); PG8_MMA(1, 0, At, B0); PG8_BAR; PG8_SCHED;
            PG8_STAGE(PG8_SB(1, 1), b3 + hstep, voffB);
            PG8_WAIT_V(6); PG8_BAR; PG8_MMA(1, 1, At, B1); PG8_BAR;
            }
        }
        if constexpr (ALIGN_EPI) { if (wr == 0) PG8_BAR; }
        if constexpr (!Epi::AFTER_DRAIN) { E(acc, cur, wr, wc, fr, fq); S.done(cur); }
        if (!has_next) break;
#pragma unroll
        for (int a = 0; a < 2; ++a)
#pragma unroll
            for (int b = 0; b < 2; ++b)
#pragma unroll
                for (int m = 0; m < 4; ++m)
#pragma unroll
                    for (int n = 0; n < 2; ++n) acc[a][b][m][n] = (f32x4){0.f, 0.f, 0.f, 0.f};
        cur = nxt; cA = nA; cB = nB; ++ui;
        if constexpr (ALIGN_EPI) { if (wr == 1) PG8_BAR; }
    }
    PG8_WAIT_V(0);
    if constexpr (!ALIGN_EPI) { if (wr == 0) PG8_BAR; }
    PG8_BAR;
    if constexpr (Epi::AFTER_DRAIN) { E.fused(acc, cur, wr, wc, fr, fq, lds, wid, lane); S.done(cur); }
#undef PG8_SA
#undef PG8_SB
#undef PG8_STAGE
#undef PG8_LDA
#undef PG8_LDB
#undef PG8_MMA
#undef PG8_WAIT_V
#undef PG8_WAIT_L
#undef PG8_BAR
#undef PG8_SCHED
}
}
namespace pg8 {
typedef unsigned u32x2 __attribute__((ext_vector_type(2)));
__device__ __forceinline__ float bf_lo(unsigned w) { return __uint_as_float(w << 16); }
__device__ __forceinline__ float bf_hi(unsigned w) { return __uint_as_float(w & 0xffff0000u); }
__device__ __forceinline__ u32x4 pack8(const f32x4 a, const f32x4 b) { u32x4 w; w.x = cvt_pk_bf16(a[0], a[1]); w.y = cvt_pk_bf16(a[2], a[3]); w.z = cvt_pk_bf16(b[0], b[1]); w.w = cvt_pk_bf16(b[2], b[3]); return w; }
constexpr float QSCALE = 0.125f * 1.4426950408889634f;

struct EpiIn {
    static constexpr bool PERM = true, AFTER_DRAIN = false;
    bf16_t *Q, *K, *V, *U, *G; const float* rope;
    __device__ __forceinline__ void operator()(const f32x4 (&acc)[2][2][4][2], const Unit& u, int wr, int wc, int fr, int fq) const {
        const int pn = u.pn; int kind, ldc, colt; bf16_t* base;
        if (pn < 4)       { kind = 0; base = Q; ldc = 1024; colt = pn * 256; }
        else if (pn < 8)  { kind = 1; base = K; ldc = 1024; colt = (pn - 4) * 256; }
        else if (pn < 12) { kind = 2; base = V; ldc = 1024; colt = (pn - 8) * 256; }
        else if (pn < 14) { kind = 2; base = U; ldc = 512;  colt = (pn - 12) * 256; }
        else              { kind = 3; base = G; ldc = 2048; colt = (pn - 14) * 256; }
        const int row0 = u.pm * BM + wr * 64 + fr, col0 = colt + wc * 32 + 8 * fq;
        const bool rl = ((wc & 1) == 0) && (fq < 2);
        const float sgn = (fq == 0) ? -1.f : 1.f;
#pragma unroll
        for (int ai = 0; ai < 2; ++ai)
#pragma unroll
            for (int m = 0; m < 4; ++m) {
                const int row = row0 + ai * HALF + m * 16;
                bf16_t* rowp = base + (size_t)row * ldc + col0;
                if (kind <= 1) {
                    const f32x4* rp = (const f32x4*)(rope + (size_t)row * 16);
                    const f32x4 c0 = rp[0], c1 = rp[1], c2 = rp[2], c3 = rp[3];
#pragma unroll
                    for (int bj = 0; bj < 2; ++bj) {
                        f32x4 v0 = acc[ai][bj][m][0], v1 = acc[ai][bj][m][1], p0, p1;
#pragma unroll
                        for (int e = 0; e < 4; ++e) { p0[e] = xor_swz<16>(v0[e]); p1[e] = xor_swz<16>(v1[e]); }
                        if (rl) {
                            v0[0] = v0[0] * c0[0] + sgn * p0[0] * c0[1]; v0[1] = v0[1] * c0[2] + sgn * p0[1] * c0[3];
                            v0[2] = v0[2] * c1[0] + sgn * p0[2] * c1[1]; v0[3] = v0[3] * c1[2] + sgn * p0[3] * c1[3];
                            v1[0] = v1[0] * c2[0] + sgn * p1[0] * c2[1]; v1[1] = v1[1] * c2[2] + sgn * p1[1] * c2[3];
                            v1[2] = v1[2] * c3[0] + sgn * p1[2] * c3[1]; v1[3] = v1[3] * c3[2] + sgn * p1[3] * c3[3];
                        }
                        if (kind == 0) { v0 = v0 * QSCALE; v1 = v1 * QSCALE; }
                        __builtin_nontemporal_store(pack8(v0, v1), (u32x4*)(rowp + bj * HALF));
                    }
                } else {
#pragma unroll
                    for (int bj = 0; bj < 2; ++bj) {
                        f32x4 v0 = acc[ai][bj][m][0], v1 = acc[ai][bj][m][1];
                        if (kind == 3) {
#pragma unroll
                            for (int e = 0; e < 4; ++e) { v0[e] = __builtin_amdgcn_rcpf(1.f + __builtin_amdgcn_exp2f(-1.4426950408889634f * v0[e])); v1[e] = __builtin_amdgcn_rcpf(1.f + __builtin_amdgcn_exp2f(-1.4426950408889634f * v1[e])); }
                        }
                        __builtin_nontemporal_store(pack8(v0, v1), (u32x4*)(rowp + bj * HALF));
                    }
                }
            }
    }
};

struct EpiMerge {
    static constexpr bool PERM = true, AFTER_DRAIN = false;
    const bf16_t* A; const bf16_t* G; const float* pscale; bf16_t* Mg;
    __device__ __forceinline__ void operator()(const f32x4 (&acc)[2][2][4][2], const Unit& u, int wr, int wc, int fr, int fq) const {
        const int row0 = u.pm * BM + wr * 64 + fr, col0 = u.pn * BM + wc * 32 + 8 * fq;
        f32x4 ps[2][2];
#pragma unroll
        for (int bj = 0; bj < 2; ++bj) { ps[bj][0] = *(const f32x4*)(pscale + col0 + bj * HALF); ps[bj][1] = *(const f32x4*)(pscale + col0 + bj * HALF + 4); }
#pragma unroll
        for (int ai = 0; ai < 2; ++ai)
#pragma unroll
            for (int m = 0; m < 4; ++m) {
                const size_t row = (size_t)(row0 + ai * HALF + m * 16);
#pragma unroll
                for (int bj = 0; bj < 2; ++bj) {
                    const int c = col0 + bj * HALF;
                    const u32x4 a8 = __builtin_nontemporal_load((const u32x4*)(A + row * 1024 + c)), ga = __builtin_nontemporal_load((const u32x4*)(G + row * 2048 + c)), gp = __builtin_nontemporal_load((const u32x4*)(G + row * 2048 + 1024 + c));
                    const f32x4 y0 = acc[ai][bj][m][0] * ps[bj][0], y1 = acc[ai][bj][m][1] * ps[bj][1];
                    f32x4 o0, o1;
                    o0[0] = bf_lo(ga.x) * bf_lo(a8.x) + bf_lo(gp.x) * y0[0]; o0[1] = bf_hi(ga.x) * bf_hi(a8.x) + bf_hi(gp.x) * y0[1];
                    o0[2] = bf_lo(ga.y) * bf_lo(a8.y) + bf_lo(gp.y) * y0[2]; o0[3] = bf_hi(ga.y) * bf_hi(a8.y) + bf_hi(gp.y) * y0[3];
                    o1[0] = bf_lo(ga.z) * bf_lo(a8.z) + bf_lo(gp.z) * y1[0]; o1[1] = bf_hi(ga.z) * bf_hi(a8.z) + bf_hi(gp.z) * y1[1];
                    o1[2] = bf_lo(ga.w) * bf_lo(a8.w) + bf_lo(gp.w) * y1[2]; o1[3] = bf_hi(ga.w) * bf_hi(a8.w) + bf_hi(gp.w) * y1[3];
                    __builtin_nontemporal_store(pack8(o0, o1), (u32x4*)(Mg + row * 1024 + c));
                }
                asm volatile("" ::: "memory");
            }
    }
};

struct EpiResA {
    static constexpr bool PERM = true, AFTER_DRAIN = false;
    const float* xi; bf16_t* xb; float* ssq;
    __device__ __forceinline__ void operator()(const f32x4 (&acc)[2][2][4][2], const Unit& u, int wr, int wc, int fr, int fq) const {
        const int row0 = u.pm * BM + wr * 64 + fr, col0 = u.pn * BM + wc * 32 + 8 * fq;
#pragma unroll
        for (int ai = 0; ai < 2; ++ai)
#pragma unroll
            for (int m = 0; m < 4; ++m) {
                const size_t row = (size_t)(row0 + ai * HALF + m * 16); float s = 0.f;
#pragma unroll
                for (int bj = 0; bj < 2; ++bj) {
                    const size_t off = row * 1024 + col0 + bj * HALF;
                    const f32x4 r0 = __builtin_nontemporal_load((const f32x4*)(xi + off)) + acc[ai][bj][m][0], r1 = __builtin_nontemporal_load((const f32x4*)(xi + off + 4)) + acc[ai][bj][m][1];
                    *(u32x4*)(xb + off) = pack8(r0, r1);
                    s += (r0[0] * r0[0] + r0[1] * r0[1]) + (r0[2] * r0[2] + r0[3] * r0[3]) + (r1[0] * r1[0] + r1[1] * r1[1]) + (r1[2] * r1[2] + r1[3] * r1[3]);
                }
                s += xor_swz<16>(s); s = half_sum(s);
                if (fq == 0) ssq[row * 16 + u.pn * 4 + wc] = s;
            }
    }
};
struct EpiResB {
    static constexpr bool PERM = true, AFTER_DRAIN = false;
    bf16_t* xb; float* ssq;
    __device__ __forceinline__ void operator()(const f32x4 (&acc)[2][2][4][2], const Unit& u, int wr, int wc, int fr, int fq) const {
        const int row0 = u.pm * BM + wr * 64 + fr, col0 = u.pn * BM + wc * 32 + 8 * fq;
#pragma unroll
        for (int ai = 0; ai < 2; ++ai)
#pragma unroll
            for (int m = 0; m < 4; ++m) {
                const size_t row = (size_t)(row0 + ai * HALF + m * 16); float s = 0.f;
#pragma unroll
                for (int bj = 0; bj < 2; ++bj) {
                    const size_t off = row * 1024 + col0 + bj * HALF;
                    const u32x4 w = __builtin_nontemporal_load((const u32x4*)(xb + off));
                    const f32x4 r0 = (f32x4){bf_lo(w.x), bf_hi(w.x), bf_lo(w.y), bf_hi(w.y)} + acc[ai][bj][m][0], r1 = (f32x4){bf_lo(w.z), bf_hi(w.z), bf_lo(w.w), bf_hi(w.w)} + acc[ai][bj][m][1];
                    __builtin_nontemporal_store(pack8(r0, r1), (u32x4*)(xb + off));
                    s += (r0[0] * r0[0] + r0[1] * r0[1]) + (r0[2] * r0[2] + r0[3] * r0[3]) + (r1[0] * r1[0] + r1[1] * r1[1]) + (r1[2] * r1[2] + r1[3] * r1[3]);
                }
                s += xor_swz<16>(s); s = half_sum(s);
                if (fq == 0) ssq[row * 16 + u.pn * 4 + wc] = s;
            }
    }
};

struct EpiUp {
    static constexpr bool PERM = true, AFTER_DRAIN = false;
    const float* ssq; bf16_t* Z;
    __device__ __forceinline__ void operator()(const f32x4 (&acc)[2][2][4][2], const Unit& u, int wr, int wc, int fr, int fq) const {
        typedef float f32x2v __attribute__((ext_vector_type(2)));
        const int row0 = u.pm * BM + wr * 64 + fr, col0 = u.pn * BM + wc * 32 + 8 * fq;
#pragma unroll
        for (int ai = 0; ai < 2; ++ai)
#pragma unroll
            for (int m = 0; m < 4; ++m) {
                const size_t row = (size_t)(row0 + ai * HALF + m * 16);
                const f32x4 pq = *(const f32x4*)(ssq + row * 16 + 4 * fq);
                float s = (pq[0] + pq[1]) + (pq[2] + pq[3]); s += xor_swz<16>(s); s = half_sum(s);
                const float r2 = __builtin_amdgcn_rcpf(s * (1.0f / 1024.0f) + 1e-6f);
                const f32x2v r2v = {r2, r2};
#pragma unroll
                for (int bj = 0; bj < 2; ++bj) {
                    f32x4 v0 = acc[ai][bj][m][0], v1 = acc[ai][bj][m][1];
#pragma unroll
                    for (int e = 0; e < 4; ++e) { v0[e] = fmaxf(v0[e], 0.f); v1[e] = fmaxf(v1[e], 0.f); }
                    f32x2v a = {v0[0], v0[1]}, b = {v0[2], v0[3]}, c = {v1[0], v1[1]}, d = {v1[2], v1[3]};
                    a = (a * a) * r2v; b = (b * b) * r2v; c = (c * c) * r2v; d = (d * d) * r2v;
                    u32x4 w; w.x = cvt_pk_bf16(a.x, a.y); w.y = cvt_pk_bf16(b.x, b.y); w.z = cvt_pk_bf16(c.x, c.y); w.w = cvt_pk_bf16(d.x, d.y);
                    __builtin_nontemporal_store(w, (u32x4*)(Z + row * 4096 + col0 + bj * HALF));
                }
            }
    }
};
}
namespace att {
#define ATT_LAS __attribute__((address_space(3)))
typedef unsigned short bf16_t;
typedef short bf16x8 __attribute__((ext_vector_type(8)));
typedef short s16x4 __attribute__((ext_vector_type(4)));
typedef float f32x16 __attribute__((ext_vector_type(16)));
typedef unsigned u32x4 __attribute__((ext_vector_type(4)));
constexpr int SEQ = 4096, PITCH = 1024;
constexpr int KBUF = 0, VBUF = 32768, WSF = 65536, QBUF = 65536 + 4096, ATT_LDS_BYTES = QBUF + 8 * 8192;
constexpr float THR = 8.0f;
__device__ __forceinline__ int crow(int r, int hi) { return (r & 3) + 8 * (r >> 2) + 4 * hi; }
__device__ __forceinline__ int koffs(int row, int ch) { return row * 256 + ((ch ^ (row & 15)) << 4); }
__device__ __forceinline__ int voffs(int row, int ch) { return 2048 * (row >> 3) + 512 * (ch >> 2) + 64 * (row & 7) + 16 * ((ch & 3) ^ ((row >> 2) & 3)); }
__device__ __forceinline__ unsigned cvtpk(float lo, float hi) { unsigned r; asm volatile("v_cvt_pk_bf16_f32 %0, %1, %2" : "=v"(r) : "v"(lo), "v"(hi)); return r; }
__device__ __forceinline__ s16x4 vtr(const ATT_LAS unsigned char* p) { return __builtin_bit_cast(s16x4, __builtin_amdgcn_ds_read_tr16_b64_v4i16((ATT_LAS s16x4*)p)); }
__device__ __forceinline__ int sub1(int a) { int v = a ^ 128; asm volatile("" : "+v"(v)); return v; }
__device__ __forceinline__ void glds16(const char* sbase, unsigned voff, unsigned lds_dst) { unsigned keep;
    asm volatile("s_mov_b32 %0, m0\n\ts_mov_b32 m0, %3\n\ts_nop 0\n\tglobal_load_lds_dwordx4 %1, %2\n\ts_mov_b32 m0, %0" : "=&s"(keep) : "v"(voff), "s"(sbase), "s"(lds_dst) : "memory"); }
#define ATT_MFMA(a, b, c) __builtin_amdgcn_mfma_f32_32x32x16_bf16((a), (b), (c), 0, 0, 0)

template <bool C1> __device__ __forceinline__ void qk_issue(f32x16& s0, const ATT_LAS unsigned char* kb, const ATT_LAS unsigned char* qb_, const int (&kaddr)[4]) {
#pragma unroll
    for (int i = 0; i < 16; ++i) s0[i] = 0.f;
#pragma unroll
    for (int ds = 0; ds < 4; ++ds) {
        const int ad = C1 ? sub1(kaddr[ds]) : kaddr[ds];
        const bf16x8 a0 = *(const ATT_LAS bf16x8*)(kb + ad);
        const bf16x8 qv = *(const ATT_LAS bf16x8*)(qb_ + ad);
        s0 = ATT_MFMA(a0, qv, s0);
    }
}
__device__ __forceinline__ void rowmax_rescale(bool MASK, f32x16& s0, f32x16 (&O)[4], float& m, float& l, int kvr, int r, int h, ATT_LAS float* wsf) {
    if (MASK) {
        asm volatile("" ::: "memory");
        const int d = r - 4 * h - kvr;
#pragma unroll
        for (int i = 0; i < 16; ++i) { if (((i & 3) + 8 * (i >> 2)) > d) s0[i] = -INFINITY; }
    }
    float ra = __builtin_fmaxf(__builtin_fmaxf(s0[0], s0[1]), s0[2]), rb = __builtin_fmaxf(__builtin_fmaxf(s0[3], s0[4]), s0[5]);
    ra = __builtin_fmaxf(__builtin_fmaxf(ra, s0[6]), s0[7]); rb = __builtin_fmaxf(__builtin_fmaxf(rb, s0[8]), s0[9]);
    ra = __builtin_fmaxf(__builtin_fmaxf(ra, s0[10]), s0[11]); rb = __builtin_fmaxf(__builtin_fmaxf(rb, s0[12]), s0[13]);
    ra = __builtin_fmaxf(__builtin_fmaxf(ra, s0[14]), s0[15]);
    const float rm = half_max(__builtin_fmaxf(ra, rb));
    if (__any(rm > m + THR)) {
        const float mn = fmaxf(m, rm), al = __builtin_amdgcn_exp2f(m - mn);
        l *= al; m = mn;
        if (h == 0) wsf[r] = al;
#pragma unroll
        for (int i = 0; i < 16; ++i) { const float a = wsf[crow(i, h)];
#pragma unroll
            for (int db = 0; db < 4; ++db) O[db][i] *= a; }
    }
}
template <bool HAS_PV, bool HAS_QK, bool C1>
__device__ __forceinline__ float step_fused(f32x16& Scur, float m, float& l, u32x4 (&pkout)[2],
                                           f32x16 (&Opv)[4], const u32x4 (&pkin)[2], const ATT_LAS unsigned char* vb, const int (&vaddr)[2],
                                           f32x16& Snext, const ATT_LAS unsigned char* kb, const ATT_LAS unsigned char* qb_, const int (&kaddr)[4]) {
    s16x4 vlo[2], vhi[2]; bf16x8 ka, qa;
    if (HAS_PV) {
#pragma unroll
        for (int u = 0; u < 2; ++u) { vlo[u] = vtr(vb + vaddr[0] + u * 512); vhi[u] = vtr(vb + vaddr[1] + u * 512); } }
    if (HAS_QK) { const int ad = C1 ? sub1(kaddr[0]) : kaddr[0]; ka = *(const ATT_LAS bf16x8*)(kb + ad); qa = *(const ATT_LAS bf16x8*)(qb_ + ad);
#pragma unroll
        for (int i = 0; i < 16; ++i) Snext[i] = 0.f; }
    float sa = 0.f, sb = 0.f;
#pragma unroll
    for (int g = 0; g < 4; ++g) {
        s16x4 nlo[2], nhi[2]; bf16x8 nk, nq;
        if (g < 3) {
            if (HAS_PV) {
#pragma unroll
                for (int u = 0; u < 2; ++u) { const int off = (2 * ((g + 1) & 1) + u) * 512 + ((g + 1) >> 1) * 4096; nlo[u] = vtr(vb + vaddr[0] + off); nhi[u] = vtr(vb + vaddr[1] + off); } }
            if (HAS_QK) { const int ad = C1 ? sub1(kaddr[g + 1]) : kaddr[g + 1]; nk = *(const ATT_LAS bf16x8*)(kb + ad); nq = *(const ATT_LAS bf16x8*)(qb_ + ad); }
        }
        if (HAS_PV) { const bf16x8 pa = __builtin_bit_cast(bf16x8, pkin[g >> 1]);
#pragma unroll
            for (int u = 0; u < 2; ++u) { const bf16x8 vf = __builtin_shufflevector(vlo[u], vhi[u], 0, 1, 2, 3, 4, 5, 6, 7); Opv[2 * (g & 1) + u] = ATT_MFMA(pa, vf, Opv[2 * (g & 1) + u]); } }
        if (HAS_QK) Snext = ATT_MFMA(ka, qa, Snext);
#pragma unroll
        for (int e = 4 * g; e < 4 * g + 4; e += 2) { Scur[e] = __builtin_amdgcn_exp2f(Scur[e] - m); Scur[e + 1] = __builtin_amdgcn_exp2f(Scur[e + 1] - m); sa += Scur[e]; sb += Scur[e + 1]; }
        if (g & 1) pkout[g >> 1] = (u32x4){cvtpk(Scur[4 * g - 4], Scur[4 * g - 3]), cvtpk(Scur[4 * g - 2], Scur[4 * g - 1]), cvtpk(Scur[4 * g], Scur[4 * g + 1]), cvtpk(Scur[4 * g + 2], Scur[4 * g + 3])};
        if (g < 3) {
            if (HAS_PV) {
#pragma unroll
                for (int u = 0; u < 2; ++u) { vlo[u] = nlo[u]; vhi[u] = nhi[u]; } }
            if (HAS_QK) { ka = nk; qa = nq; }
        }
        __builtin_amdgcn_sched_barrier(0);
    }
    l += sa + sb;
    return sa + sb;
}
__device__ __forceinline__ void pv_issue(f32x16 (&O)[4], const u32x4 (&pk)[2], const ATT_LAS unsigned char* vb, const int (&vaddr)[2]) {
#pragma unroll
    for (int s_ = 0; s_ < 2; ++s_) { const bf16x8 pa = __builtin_bit_cast(bf16x8, pk[s_]);
#pragma unroll
        for (int db = 0; db < 4; ++db) {
            const s16x4 lo = vtr(vb + vaddr[0] + db * 512 + s_ * 4096), hi = vtr(vb + vaddr[1] + db * 512 + s_ * 4096);
            const bf16x8 vf = __builtin_shufflevector(lo, hi, 0, 1, 2, 3, 4, 5, 6, 7);
            O[db] = ATT_MFMA(pa, vf, O[db]); } }
}

__device__ __forceinline__ void apply_mask(bool MASK, f32x16& s0, int kvr, int r, int h) {
    if (MASK) {
        asm volatile("" ::: "memory");
        const int d = r - 4 * h - kvr;
#pragma unroll
        for (int i = 0; i < 16; ++i) { if (((i & 3) + 8 * (i >> 2)) > d) s0[i] = -INFINITY; }
    }
}
constexpr float GUARD = 65536.0f;
template <bool C1> __device__ __forceinline__ void slow_step(bool MASK, f32x16& S, const ATT_LAS unsigned char* kb, const ATT_LAS unsigned char* qbase, const int (&kaddr)[4], const int (&vaddr)[2],
                                                             f32x16 (&O)[4], float& m, float& l, float l_saved, int kvr, int r, int h, ATT_LAS float* wsf, u32x4 (&pk)[2]) {
    l = l_saved;
    qk_issue<C1>(S, kb, qbase, kaddr);
    rowmax_rescale(MASK, S, O, m, l, kvr, r, h, wsf);
    f32x16 dummy;
    step_fused<false, false, false>(S, m, l, pk, O, pk, kb, vaddr, dummy, kb, qbase, kaddr);
}
__device__ __forceinline__ void tile_body(bool MASK, const ATT_LAS unsigned char* kb, const ATT_LAS unsigned char* vb, const ATT_LAS unsigned char* qbase, const int (&kaddr)[4], const int (&vaddr)[2],
                                                               f32x16 (&O1)[4], f32x16 (&O2)[4], float& m1, float& m2, float& l1, float& l2, int kvrel, int r, int h, ATT_LAS float* wsf) {
    f32x16 Sa, Sb; u32x4 pkA[2], pkB[2]; float ls, sm;
    qk_issue<false>(Sa, kb, qbase, kaddr);
    apply_mask(MASK, Sa, kvrel, r, h); ls = l1;
    sm = step_fused<false, true, true>(Sa, m1, l1, pkA, O1, pkA, vb, vaddr, Sb, kb, qbase, kaddr);
    if (__any(!(sm <= GUARD))) slow_step<false>(MASK, Sa, kb, qbase, kaddr, vaddr, O1, m1, l1, ls, kvrel, r, h, wsf, pkA);
    apply_mask(MASK, Sb, kvrel, r, h); ls = l2;
    sm = step_fused<true, true, false>(Sb, m2, l2, pkB, O1, pkA, vb, vaddr, Sa, kb + 8192, qbase, kaddr);
    if (__any(!(sm <= GUARD))) slow_step<true>(MASK, Sb, kb, qbase, kaddr, vaddr, O2, m2, l2, ls, kvrel, r, h, wsf, pkB);
    apply_mask(MASK, Sa, kvrel + 32, r, h); ls = l1;
    sm = step_fused<true, true, true>(Sa, m1, l1, pkA, O2, pkB, vb, vaddr, Sb, kb + 8192, qbase, kaddr);
    if (__any(!(sm <= GUARD))) slow_step<false>(MASK, Sa, kb + 8192, qbase, kaddr, vaddr, O1, m1, l1, ls, kvrel + 32, r, h, wsf, pkA);
    apply_mask(MASK, Sb, kvrel + 32, r, h); ls = l2;
    sm = step_fused<true, false, false>(Sb, m2, l2, pkB, O1, pkA, vb + 8192, vaddr, Sa, kb, qbase, kaddr);
    if (__any(!(sm <= GUARD))) slow_step<true>(MASK, Sb, kb + 8192, qbase, kaddr, vaddr, O2, m2, l2, ls, kvrel + 32, r, h, wsf, pkB);
    pv_issue(O2, pkB, vb + 8192, vaddr);
}

__device__ __forceinline__ void attn_unit(ATT_LAS unsigned char* lds, const bf16_t* Qg, const bf16_t* Kg, const bf16_t* Vg, bf16_t* Og, int b, int head, int qb, float lam, const float* subg) {
    int tid = threadIdx.x; asm volatile("" : "+v"(tid));
    const int lane = tid & 63, r = lane & 31, h = lane >> 5;
    const int w = __builtin_amdgcn_readfirstlane(tid >> 6);
    const size_t rowbase = (size_t)b * SEQ; const int q0 = qb * 256, NT = (q0 + 256) >> 6;
    const char* Kt = (const char*)(Kg + rowbase * PITCH + head * 128);
    const char* Vt = (const char*)(Vg + rowbase * PITCH + head * 128);
    unsigned ksrc[2], vsrc[2];
#pragma unroll
    for (int i = 0; i < 2; ++i) { const int ii = w * 2 + i;
        { const int row = 4 * ii + (lane >> 4), pc = lane & 15; ksrc[i] = (unsigned)(row * 2048 + ((pc ^ (row & 15)) << 4)); }
        { const int row = 8 * (ii >> 1) + ((lane >> 2) & 7), ch = 4 * (2 * (ii & 1) + (lane >> 5)) + ((lane & 3) ^ ((row >> 2) & 3)); vsrc[i] = (unsigned)(row * 2048 + ch * 16); } }
    const unsigned ldsb = (unsigned)(uintptr_t)lds;
#define ATT_STAGE(t, buf) do { _Pragma("unroll") for (int i_ = 0; i_ < 2; ++i_) { \
        glds16(Kt + (size_t)(t) * 131072, ksrc[i_], (unsigned)__builtin_amdgcn_readfirstlane(ldsb + KBUF + (buf) * 16384 + (w * 2 + i_) * 1024)); \
        glds16(Vt + (size_t)(t) * 131072, vsrc[i_], (unsigned)__builtin_amdgcn_readfirstlane(ldsb + VBUF + (buf) * 16384 + (w * 2 + i_) * 1024)); } } while (0)
    ATT_STAGE(0, 0);
    { const char* Qw = (const char*)(Qg + (rowbase + q0 + w * 32) * PITCH + head * 128);
#pragma unroll
      for (int i = 0; i < 8; ++i) { const int row = 4 * i + (lane >> 4), pc = lane & 15;
          glds16(Qw, (unsigned)(row * 2048 + ((pc ^ (row & 15)) << 4)), (unsigned)__builtin_amdgcn_readfirstlane(ldsb + QBUF + w * 8192 + i * 1024)); } }
    const ATT_LAS unsigned char* qbase = lds + QBUF + w * 8192;
    int kaddr[4], vaddr[2];
#pragma unroll
    for (int ds = 0; ds < 4; ++ds) kaddr[ds] = koffs(r, 2 * ds + h);
    { const int q = (lane & 15) >> 2, p = lane & 3, blk = (lane >> 4) & 1;
#pragma unroll
      for (int sub = 0; sub < 2; ++sub) vaddr[sub] = voffs(8 * sub + 4 * h + q, 2 * blk + (p >> 1)) + 8 * (p & 1); }
    ATT_LAS float* wsf = (ATT_LAS float*)(lds + WSF + w * 512);
    f32x16 O1[4], O2[4];
#pragma unroll
    for (int db = 0; db < 4; ++db)
#pragma unroll
        for (int i = 0; i < 16; ++i) { O1[db][i] = 0.f; O2[db][i] = 0.f; }
    float m1 = -1e30f, m2 = -1e30f, l1 = 0.f, l2 = 0.f;
    asm volatile("s_waitcnt vmcnt(0)" ::: "memory"); __syncthreads();
    for (int t = 0; t < NT; ++t) {
        const int buf = t & 1;
        if (t + 1 < NT) ATT_STAGE(t + 1, buf ^ 1);
        const int kvrel = 64 * t - q0 - 32 * w;
        if (kvrel <= 31) {
            const ATT_LAS unsigned char* kb = lds + KBUF + buf * 16384;
            const ATT_LAS unsigned char* vb = lds + VBUF + buf * 16384;
            tile_body(kvrel + 63 > 0, kb, vb, qbase, kaddr, vaddr, O1, O2, m1, m2, l1, l2, kvrel, r, h, wsf);
        }
        asm volatile("s_waitcnt vmcnt(0)" ::: "memory"); __syncthreads();
    }
    l1 = half_sum(l1); l2 = half_sum(l2);
    if (h == 0) { wsf[r] = 1.0f / l1; wsf[32 + r] = lam / l2; }
    float sg[4];
#pragma unroll
    for (int db = 0; db < 4; ++db) sg[db] = subg[32 * db + r] * 0.8f;
    bf16_t* Ow = Og + (rowbase + q0 + w * 32) * PITCH + head * 128 + r;
#pragma unroll
    for (int i = 0; i < 16; ++i) {
        const int qr = crow(i, h); const float a1 = wsf[qr], a2 = wsf[32 + qr];
        float o[4], ss = 0.f;
#pragma unroll
        for (int db = 0; db < 4; ++db) { o[db] = O1[db][i] * a1 - O2[db][i] * a2; ss += o[db] * o[db]; }
        ss += xor_swz<1>(ss); ss += xor_swz<2>(ss); ss += xor_swz<4>(ss); ss += xor_swz<8>(ss); ss += xor_swz<16>(ss);
        const float rs = 1.0f / sqrtf(ss * (1.0f / 128.0f) + 1e-6f);
#pragma unroll
        for (int db = 0; db < 4; ++db) Ow[(size_t)qr * PITCH + 32 * db] = (bf16_t)(cvtpk(o[db] * rs * sg[db], 0.f) & 0xffffu);
    }
#undef ATT_STAGE
}
}
constexpr int NWAVES = 8;
constexpr int BATCH = 16, SEQ = 4096, D = 1024, NH = 8, FF = 4096, INW = 5632, M = BATCH * SEQ;
constexpr float RMS_EPS = 1e-6f;
constexpr size_t MiB = 1u << 20;
constexpr size_t WS_WIN = 0, WS_WOUT = 11 * MiB, WS_WUP = 13 * MiB, WS_WDOWN = 21 * MiB, WS_WPOOL = 29 * MiB;
constexpr size_t WS_ROPE = 30 * MiB;
constexpr size_t WS_SSQ1 = 34 * MiB, WS_SSQ2 = 38 * MiB;
constexpr size_t WS_BAR = 42 * MiB, BAR_ZERO_BYTES = 32768;
constexpr size_t WS_XN = 48 * MiB;
constexpr size_t WS_Q = 176 * MiB;
constexpr size_t WS_K = 304 * MiB;
constexpr size_t WS_V = 432 * MiB;
constexpr size_t WS_U = 560 * MiB;
constexpr size_t WS_G = 624 * MiB;
constexpr size_t WS_DP = 880 * MiB;
constexpr size_t WS_Z = 176 * MiB;
constexpr size_t WS_END = 944 * MiB;
static_assert(WS_Z + (size_t)M * FF * 2 <= WS_DP && WS_DP + (size_t)M * 512 * 2 <= WS_END, "d_ws map");
constexpr int LDS_MISC_OFF = 147456 - 256;
constexpr int LDS_BYTES = 147456;

#define LAS __attribute__((address_space(3)))
typedef unsigned short bf16;
typedef unsigned v4u __attribute__((ext_vector_type(4)));
typedef float f32x4 __attribute__((ext_vector_type(4)));
__device__ __forceinline__ unsigned f2bf(float f) { unsigned u = __builtin_bit_cast(unsigned, f); return (u + 0x7fffu + ((u >> 16) & 1u)) >> 16; }
__device__ __forceinline__ unsigned pk2(float lo, float hi) { return f2bf(lo) | (f2bf(hi) << 16); }
__device__ __forceinline__ float wave_sum(float v) {
    v += xor_swz<1>(v); v += xor_swz<2>(v); v += xor_swz<4>(v); v += xor_swz<8>(v); v += xor_swz<16>(v);
    return half_sum(v);
}
__device__ __forceinline__ void p0_transpose_item(const float* W, int K, int N, bf16* WT, int row_off, const float* kscale, LAS float* scr, int item, int lane) {
    const int nblk = N / 32, kb = item / nblk, nb = item % nblk, k0 = 64 * kb, n0 = 32 * nb;
#pragma unroll 8
    for (int i = 0; i < 32; ++i) { const int kk = 2 * i + (lane >> 5); float v = W[(size_t)(k0 + kk) * N + n0 + (lane & 31)]; if (kscale) v *= kscale[k0 + kk]; scr[kk * 33 + (lane & 31)] = v; }
    asm volatile("s_waitcnt lgkmcnt(0)" ::: "memory");
    const int c = lane & 7;
#pragma unroll
    for (int j = 0; j < 4; ++j) { const int n = (lane >> 3) + 8 * j; const LAS float* s = scr + (8 * c) * 33 + n;
        v4u o; o.x = pk2(s[0 * 33], s[1 * 33]); o.y = pk2(s[2 * 33], s[3 * 33]); o.z = pk2(s[4 * 33], s[5 * 33]); o.w = pk2(s[6 * 33], s[7 * 33]);
        *(v4u*)(WT + (size_t)(row_off + n0 + n) * K + k0 + 8 * c) = o; }
    asm volatile("s_waitcnt lgkmcnt(0)" ::: "memory");
}

#define XB_TMO      128
#define XB_XCNT(j)  (256  + 64 * (j))
#define XB_XSUB(j)  (1280 + 64 * (j))
#define XB_XGEN(j)  (2304 + 64 * (j))
#define XB_TOP      3328
#define XB_TOPGEN   3392
#define XCD_BAR_WORDS 3456
#define XB_SPIN_CAP (1u << 18)

__device__ __forceinline__ unsigned xb_ld(unsigned* p)              { return __hip_atomic_load(p, __ATOMIC_RELAXED, __HIP_MEMORY_SCOPE_AGENT); }
__device__ __forceinline__ unsigned xb_add(unsigned* p, unsigned v) { return __hip_atomic_fetch_add(p, v, __ATOMIC_RELAXED, __HIP_MEMORY_SCOPE_AGENT); }
__device__ __forceinline__ unsigned xb_xcc_id() { return (unsigned)__builtin_amdgcn_s_getreg((3 << 11) | 20) & 0xFu; }
#define XB_SPIN(cond, bar) do { unsigned _sp = 0; while (cond) { __builtin_amdgcn_s_sleep(1); \
    if ((++_sp & 255u) == 0u) { if (xb_ld(&(bar)[XB_TMO])) break; if (_sp > XB_SPIN_CAP) { atomicAdd(&(bar)[XB_TMO], 1u); break; } } } } while (0)

struct XcdBarrier {
    unsigned* bar; unsigned x;
    volatile LAS unsigned* st;
};

__device__ __forceinline__ XcdBarrier xcd_barrier_post(unsigned* bar, volatile LAS unsigned* st) {
    XcdBarrier b; b.bar = bar; b.x = xb_xcc_id(); b.st = st;
    if (threadIdx.x == 0) (void)xb_add(&bar[XB_XCNT(b.x)], 1u);
    return b;
}
__device__ __forceinline__ void xcd_barrier_complete(unsigned* bar, unsigned x, unsigned& nloc, unsigned& nx) {
    const unsigned G = gridDim.x * gridDim.y * gridDim.z;
    unsigned sum, cnt, mine, sp = 0u;
    for (;;) {
        sum = 0u; cnt = 0u; mine = 0u;
#pragma unroll
        for (unsigned j = 0; j < 16; ++j) { const unsigned c = xb_ld(&bar[XB_XCNT(j)]); sum += c; cnt += (c > 0u) ? 1u : 0u; mine = (j == x) ? c : mine; }
        if (sum == G) break;
        __builtin_amdgcn_s_sleep(1);
        if ((++sp & 255u) == 0u) { if (xb_ld(&bar[XB_TMO])) break; if (sp > XB_SPIN_CAP) { atomicAdd(&bar[XB_TMO], 1u); break; } }
    }
    nloc = mine > 0u ? mine : 1u; nx = cnt > 0u ? cnt : 1u;
}

__device__ __forceinline__ void xcd_barrier(const XcdBarrier& b) {
    asm volatile("s_waitcnt vmcnt(0)" ::: "memory");
    __syncthreads();
    if (threadIdx.x == 0) {
        unsigned* bar = b.bar;
        __builtin_amdgcn_s_waitcnt(0);
        unsigned nloc = b.st[0], nx = b.st[1];
        if (nloc == 0u) { xcd_barrier_complete(bar, b.x, nloc, nx); b.st[0] = nloc; b.st[1] = nx; }
        const unsigned old = xb_add(&bar[XB_XSUB(b.x)], 1u);
        const unsigned gen = old / nloc;
        if (old + 1u == (gen + 1u) * nloc) {
            __builtin_amdgcn_fence(__ATOMIC_RELEASE, "agent");
            asm volatile("s_waitcnt vmcnt(0)" ::: "memory");
            const unsigned og = xb_add(&bar[XB_TOP], 1u);
            const unsigned tg = og / nx;
            if (og + 1u == (tg + 1u) * nx) xb_add(&bar[XB_TOPGEN], 1u);
            else XB_SPIN(xb_ld(&bar[XB_TOPGEN]) == tg, bar);
            __builtin_amdgcn_fence(__ATOMIC_ACQUIRE, "agent");
            xb_add(&bar[XB_XGEN(b.x)], 1u);
            asm volatile("s_waitcnt vmcnt(0)" ::: "memory");
        } else {
            XB_SPIN(xb_ld(&bar[XB_XGEN(b.x)]) == gen, bar);
            __builtin_amdgcn_fence(__ATOMIC_ACQUIRE, "agent");
            asm volatile("s_waitcnt vmcnt(0)" ::: "memory");
        }
    }
    __syncthreads();
}

#ifndef REP_P0
#define REP_P0 1
#endif
#ifndef REP_P1
#define REP_P1 1
#endif
#ifndef REP_P2
#define REP_P2 1
#endif
#ifndef REP_P3
#define REP_P3 1
#endif
#ifndef REP_P4
#define REP_P4 1
#endif
#ifndef REP_P5
#define REP_P5 1
#endif
template <int W> __device__ __forceinline__ v4u pool_window(const bf16* up, int t) {
    v4u q[W];
#pragma unroll
    for (int j = 0; j < W; ++j) q[j] = *(const v4u*)(up - (size_t)((j <= t) ? j : 0) * 512);
    float acc[8];
#pragma unroll
    for (int e = 0; e < 8; ++e) acc[e] = 0.f;
#pragma unroll
    for (int j = 0; j < W; ++j) { const float wgt = (j <= t) ? 1.f : 0.f;
        acc[0] += wgt * pg8::bf_lo(q[j].x); acc[1] += wgt * pg8::bf_hi(q[j].x); acc[2] += wgt * pg8::bf_lo(q[j].y); acc[3] += wgt * pg8::bf_hi(q[j].y);
        acc[4] += wgt * pg8::bf_lo(q[j].z); acc[5] += wgt * pg8::bf_hi(q[j].z); acc[6] += wgt * pg8::bf_lo(q[j].w); acc[7] += wgt * pg8::bf_hi(q[j].w); }
    const float inv = 1.0f / (float)((t + 1 < W) ? (t + 1) : W);
    v4u o;
    o.x = pk2(acc[0] * inv - pg8::bf_lo(q[0].x), acc[1] * inv - pg8::bf_hi(q[0].x)); o.y = pk2(acc[2] * inv - pg8::bf_lo(q[0].y), acc[3] * inv - pg8::bf_hi(q[0].y));
    o.z = pk2(acc[4] * inv - pg8::bf_lo(q[0].z), acc[5] * inv - pg8::bf_hi(q[0].z)); o.w = pk2(acc[6] * inv - pg8::bf_lo(q[0].w), acc[7] * inv - pg8::bf_hi(q[0].w));
    return o;
}

struct Args {
    const float* x; const int* pos; const float* g_attn; const float* w_in; const float* lq1; const float* lk1; const float* lq2; const float* lk2;
    const float* subln_g; const float* w_pool; const float* pool_scale; const float* w_out; const float* g_mlp; const float* w_up; const float* w_down; const float* g_final;
    float* out; unsigned char* ws;
};

__global__ void __launch_bounds__(NWAVES * 64, 2) hybrid_fwd(Args a) {
    extern __shared__ __attribute__((aligned(16))) unsigned char lds_raw[];
    LAS unsigned char* lds = (LAS unsigned char*)lds_raw;
    cg::grid_group grid = cg::this_grid();
    if (threadIdx.x < 2) ((volatile LAS unsigned*)(lds + LDS_MISC_OFF))[threadIdx.x] = 0u;
    __syncthreads();
    const int G = gridDim.x, bx = blockIdx.x;
#define PHASE_IDS int tid = threadIdx.x; asm volatile("" : "+v"(tid)); const int lane = tid & 63, wave = __builtin_amdgcn_readfirstlane(tid >> 6); const int gw = vcu * NWAVES + wave, NGW = G * NWAVES; (void)lane; (void)gw; (void)NGW
    const int vcu = (G % 8 == 0) ? (bx % 8) * (G / 8) + bx / 8 : bx;
    unsigned char* ws = a.ws;
    bf16* Win_t = (bf16*)(ws + WS_WIN); bf16* Wout_t = (bf16*)(ws + WS_WOUT); bf16* Wup_t = (bf16*)(ws + WS_WUP); bf16* Wdown_t = (bf16*)(ws + WS_WDOWN); bf16* Wpool_t = (bf16*)(ws + WS_WPOOL);
    float* rope = (float*)(ws + WS_ROPE); float* ssq1 = (float*)(ws + WS_SSQ1); float* ssq2 = (float*)(ws + WS_SSQ2);
    bf16* XN = (bf16*)(ws + WS_XN); bf16* Qb = (bf16*)(ws + WS_Q); bf16* Kb = (bf16*)(ws + WS_K); bf16* Vb = (bf16*)(ws + WS_V);
    bf16* Ub = (bf16*)(ws + WS_U); bf16* Gb = (bf16*)(ws + WS_G); bf16* Dp = (bf16*)(ws + WS_DP); bf16* Zb = (bf16*)(ws + WS_Z); bf16* Mg = Kb; bf16* Ab = XN;

    for (int rep_ = 0; rep_ < REP_P0; ++rep_) {
        PHASE_IDS;
        LAS float* scr = (LAS float*)(lds + wave * 16384);
        constexpr int I_IN = (D / 64) * (INW / 32), I_OUT = (D / 64) * (D / 32), I_UP = (D / 64) * (FF / 32), I_DOWN = (FF / 64) * (D / 32), I_POOL1 = (128 / 64) * (256 / 32);
        constexpr int NITEMS = I_IN + I_OUT + I_UP + I_DOWN + 4 * I_POOL1;
        for (int it = gw; it < NITEMS; it += NGW) {
            int r = it;
            if (r < I_IN) { p0_transpose_item(a.w_in, D, INW, Win_t, 0, nullptr, scr, r, lane); continue; } r -= I_IN;
            if (r < I_OUT) { p0_transpose_item(a.w_out, D, D, Wout_t, 0, nullptr, scr, r, lane); continue; } r -= I_OUT;
            if (r < I_UP) { p0_transpose_item(a.w_up, D, FF, Wup_t, 0, a.g_mlp, scr, r, lane); continue; } r -= I_UP;
            if (r < I_DOWN) { p0_transpose_item(a.w_down, FF, D, Wdown_t, 0, nullptr, scr, r, lane); continue; } r -= I_DOWN;
            { const int g = r / I_POOL1; p0_transpose_item(a.w_pool + (size_t)g * 128 * 256, 128, 256, Wpool_t, g * 256, nullptr, scr, r % I_POOL1, lane); }
        }
        for (int e = bx * (NWAVES * 64) + tid; e < M * 8; e += G * NWAVES * 64) {
            const int row = e >> 3, i = e & 7;
            const float invf = (i == 0) ? 1.0f : (i == 1) ? 0.19392274474868576f : (i == 2) ? 0.03760603093086393f : (i == 3) ? 0.007292664737217109f :
                               (i == 4) ? 0.001414213562373095f : (i == 5) ? 0.0002742481756762073f : (i == 6) ? 5.318295896944988e-05f : 1.031338537721246e-05f;
            const float ang = (float)a.pos[row] * invf;
            double rev = (double)ang * 0.15915494309189535; rev -= __builtin_rint(rev);
            const float rf = (float)rev;
            rope[(size_t)e * 2] = __builtin_amdgcn_cosf(rf); rope[(size_t)e * 2 + 1] = __builtin_amdgcn_sinf(rf);
        }
        {
            const f32x4* gr = (const f32x4*)a.g_attn + lane; f32x4 gg[4];
#pragma unroll
            for (int j = 0; j < 4; ++j) gg[j] = gr[64 * j];
            for (int m0 = gw * 4; m0 < M; m0 += NGW * 4) {
                f32x4 v[4][4]; float s2[4];
#pragma unroll
                for (int q = 0; q < 4; ++q) { const f32x4* xr = (const f32x4*)(a.x + (size_t)(m0 + q) * D) + lane;
#pragma unroll
                    for (int j = 0; j < 4; ++j) v[q][j] = __builtin_nontemporal_load(xr + 64 * j); }
#pragma unroll
                for (int q = 0; q < 4; ++q) { s2[q] = 0.f;
#pragma unroll
                    for (int j = 0; j < 4; ++j) s2[q] += (v[q][j].x * v[q][j].x + v[q][j].y * v[q][j].y) + (v[q][j].z * v[q][j].z + v[q][j].w * v[q][j].w); }
#pragma unroll
                for (int q = 0; q < 4; ++q) { const float rstd = 1.0f / sqrtf(wave_sum(s2[q]) * (1.f / D) + RMS_EPS);
                    unsigned long long* o8 = (unsigned long long*)(XN + (size_t)(m0 + q) * D) + lane;
#pragma unroll
                    for (int j = 0; j < 4; ++j) { const f32x4 y = v[q][j] * rstd * gg[j];
                        o8[64 * j] = (unsigned long long)pk2(y.x, y.y) | ((unsigned long long)pk2(y.z, y.w) << 32); } }
            }
        }
    if (bx == 0) { for (int i = threadIdx.x; i < (int)(BAR_ZERO_BYTES / 4); i += NWAVES * 64) ((unsigned*)(a.ws + WS_BAR))[i] = 0u; }
    grid.sync(); }
    unsigned seam_no = 0, seam2_no = 0, xc_nloc = 1, xc_ngroups = 1;
    const unsigned xcc = (unsigned)__builtin_amdgcn_s_getreg((3 << 11) | 20) & 0xFu;
    if (threadIdx.x == 0) __hip_atomic_fetch_add((unsigned*)(a.ws + WS_BAR) + 64 * (80 + xcc), 1u, __ATOMIC_RELAXED, __HIP_MEMORY_SCOPE_AGENT);
#define SEAM2() do { ++seam2_no; asm volatile("s_waitcnt vmcnt(0)" ::: "memory"); __syncthreads(); \
        if (threadIdx.x == 0) { unsigned* w_ = (unsigned*)(a.ws + WS_BAR); \
            const unsigned old_ = __hip_atomic_fetch_add(w_ + 64 * (32 + xcc), 1u, __ATOMIC_RELAXED, __HIP_MEMORY_SCOPE_AGENT); \
            if (old_ + 1u == seam2_no * xc_nloc) { \
                __builtin_amdgcn_fence(__ATOMIC_RELEASE, "agent"); asm volatile("s_waitcnt vmcnt(0)" ::: "memory"); \
                __hip_atomic_fetch_add(w_ + 64 * 64, 1u, __ATOMIC_RELAXED, __HIP_MEMORY_SCOPE_AGENT); \
                while (__hip_atomic_load(w_ + 64 * 64, __ATOMIC_RELAXED, __HIP_MEMORY_SCOPE_AGENT) < seam2_no * xc_ngroups) __builtin_amdgcn_s_sleep(1); \
                __hip_atomic_store(w_ + 64 * (48 + xcc), seam2_no, __ATOMIC_RELAXED, __HIP_MEMORY_SCOPE_AGENT); \
            } else { while (__hip_atomic_load(w_ + 64 * (48 + xcc), __ATOMIC_RELAXED, __HIP_MEMORY_SCOPE_AGENT) < seam2_no) __builtin_amdgcn_s_sleep(1); } \
            __builtin_amdgcn_fence(__ATOMIC_ACQUIRE, "agent"); asm volatile("s_waitcnt vmcnt(0)" ::: "memory"); } \
        __syncthreads(); } while (0)
#define SEAM() do { ++seam_no; asm volatile("s_waitcnt vmcnt(0)" ::: "memory"); __syncthreads(); \
        if (threadIdx.x == 0) { unsigned* w_ = (unsigned*)(a.ws + WS_BAR); const unsigned g_ = (unsigned)bx & 7u, ng_ = ((unsigned)G - g_ + 7u) / 8u, ngroups_ = (unsigned)G < 8u ? (unsigned)G : 8u; \
            __builtin_amdgcn_fence(__ATOMIC_RELEASE, "agent"); asm volatile("s_waitcnt vmcnt(0)" ::: "memory");     \
            const unsigned old_ = __hip_atomic_fetch_add(w_ + 64 * g_, 1u, __ATOMIC_RELAXED, __HIP_MEMORY_SCOPE_AGENT); \
            if (old_ + 1u == seam_no * ng_) { \
                __hip_atomic_fetch_add(w_ + 64 * 16, 1u, __ATOMIC_RELAXED, __HIP_MEMORY_SCOPE_AGENT); \
                while (__hip_atomic_load(w_ + 64 * 16, __ATOMIC_RELAXED, __HIP_MEMORY_SCOPE_AGENT) < seam_no * ngroups_) __builtin_amdgcn_s_sleep(1); \
                __hip_atomic_store(w_ + 64 * (8 + g_), seam_no, __ATOMIC_RELAXED, __HIP_MEMORY_SCOPE_AGENT); \
            } else { while (__hip_atomic_load(w_ + 64 * (8 + g_), __ATOMIC_RELAXED, __HIP_MEMORY_SCOPE_AGENT) < seam_no) __builtin_amdgcn_s_sleep(1); } \
            __builtin_amdgcn_fence(__ATOMIC_ACQUIRE, "agent"); asm volatile("s_waitcnt vmcnt(0)" ::: "memory"); } \
        __syncthreads(); } while (0)

    for (int rep_ = 0; rep_ < REP_P1; ++rep_) {
        pg8::Gemm g{XN, Win_t, M, INW, D, 0}; pg8::StaticOrder S; S.init(M, INW, G, bx);
        pg8::EpiIn E{Qb, Kb, Vb, Ub, Gb, rope};
        pg8::gemm_phase<pg8::EpiIn, pg8::StaticOrder, true, true>(lds, g, S, E);
    SEAM(); }
    if (threadIdx.x == 0) { unsigned ng_ = 0u;
        for (unsigned j = 0; j < 16u; ++j) { const unsigned c_ = __hip_atomic_load((unsigned*)(a.ws + WS_BAR) + 64 * (80 + j), __ATOMIC_RELAXED, __HIP_MEMORY_SCOPE_AGENT); ng_ += (c_ != 0u); if (j == xcc) xc_nloc = c_; }
        xc_ngroups = ng_; }


    for (int rep_ = 0; rep_ < REP_P2; ++rep_) {
        PHASE_IDS;
        for (int wi = gw; wi < M; wi += NGW) {
            const int rq = wi >> 2, gp = ((wi & 3) + (wi >> 11)) & 3;
            const int row = 4 * rq + (lane >> 4), t = row & (SEQ - 1);
            const bf16* up = Ub + (size_t)row * 512 + gp * 128 + (lane & 15) * 8;
            v4u o;
            if (gp == 0) o = pool_window<2>(up, t); else if (gp == 1) o = pool_window<4>(up, t); else if (gp == 2) o = pool_window<8>(up, t); else o = pool_window<16>(up, t);
            *(v4u*)(Dp + ((size_t)gp * M + row) * 128 + (lane & 15) * 8) = o;
        }
        const float sa = wave_sum(a.lq1[lane] * a.lk1[lane]), sb = wave_sum(a.lq2[lane] * a.lk2[lane]);
        const float lam = expf(sa) - expf(sb) + 0.2f;
        for (int pu = vcu; pu < BATCH * NH * 8; pu += G) {
            const int bh = pu >> 3, s = pu & 7, b = bh >> 3, head = bh & 7;
            for (int k = 0; k < 2; ++k) att::attn_unit(lds, Qb, Kb, Vb, Ab, b, head, k ? s : 15 - s, lam, a.subln_g);
        }
    SEAM2(); }

    for (int rep_ = 0; rep_ < REP_P3; ++rep_) {
        pg8::Gemm g{Dp, Wpool_t, M, D, 128, (size_t)M * 128 * 2}; pg8::StaticOrder S; S.init(M, D, G, bx);
        pg8::EpiMerge E{Ab, Gb, a.pool_scale, Mg};
        pg8::gemm_phase<pg8::EpiMerge, pg8::StaticOrder, true, true>(lds, g, S, E);
    SEAM2(); }

    for (int rep_ = 0; rep_ < REP_P4; ++rep_) {
        pg8::Gemm g{Mg, Wout_t, M, D, D, 0}; pg8::StaticOrder S; S.init(M, D, G, bx);
        pg8::EpiResA E{a.x, XN, ssq1};
        pg8::gemm_phase<pg8::EpiResA, pg8::StaticOrder, true, true>(lds, g, S, E);
    SEAM2(); }

    for (int rep_ = 0; rep_ < REP_P5; ++rep_) {
        pg8::Gemm g{XN, Wup_t, M, FF, D, 0}; pg8::StaticOrder S; S.init(M, FF, G, bx);
        pg8::EpiUp E{ssq1, Zb};
        pg8::gemm_phase<pg8::EpiUp, pg8::StaticOrder, true, true>(lds, g, S, E);
    SEAM2(); }

    {
        pg8::Gemm g{Zb, Wdown_t, M, D, FF, 0}; pg8::StaticOrder S; S.init(M, D, G, bx);
        pg8::EpiResB E{XN, ssq2};
        pg8::gemm_phase<pg8::EpiResB, pg8::StaticOrder, true, true>(lds, g, S, E);
    }
    SEAM2();

    { PHASE_IDS;
    const f32x4* gr = (const f32x4*)a.g_final + lane; f32x4 gg[4];
#pragma unroll
    for (int j = 0; j < 4; ++j) gg[j] = gr[64 * j];
    for (int m0 = gw * 4; m0 < M; m0 += NGW * 4) {
        unsigned long long v[4][4]; float s[4];
#pragma unroll
        for (int q = 0; q < 4; ++q) { const unsigned long long* xr = (const unsigned long long*)(XN + (size_t)(m0 + q) * D) + lane; s[q] = ssq2[(size_t)(m0 + q) * 16 + (lane & 15)];
#pragma unroll
            for (int j = 0; j < 4; ++j) v[q][j] = __builtin_nontemporal_load(xr + 64 * j); }
#pragma unroll
        for (int q = 0; q < 4; ++q) { float t = s[q]; t += xor_swz<1>(t); t += xor_swz<2>(t); t += xor_swz<4>(t); t += xor_swz<8>(t);
            const float rstd = 1.0f / sqrtf(t * (1.f / D) + RMS_EPS);
            f32x4* xr = (f32x4*)(a.out + (size_t)(m0 + q) * D) + lane;
#pragma unroll
            for (int j = 0; j < 4; ++j) { const unsigned lo = (unsigned)v[q][j], hi = (unsigned)(v[q][j] >> 32);
                const f32x4 x = (f32x4){pg8::bf_lo(lo), pg8::bf_hi(lo), pg8::bf_lo(hi), pg8::bf_hi(hi)};
                __builtin_nontemporal_store(x * rstd * gg[j], xr + 64 * j); } }
    } }
}

extern "C" void kernel_launch(void* const* d_in, const int* in_sizes, int n_in, void* d_out, int out_size, void* d_ws, size_t ws_size, hipStream_t stream) {
    static int grid = 0;
    if (grid == 0) {
        if (n_in != 16 || in_sizes[0] != M * D || out_size != M * D || ws_size < WS_END) { fprintf(stderr, "kernel_launch: unexpected shapes (n_in %d, in0 %d, out %d, ws %zu); nothing launched\n", n_in, n_in > 0 ? in_sizes[0] : -1, out_size, ws_size); grid = -1; return; }
        int dev = 0, cus = 0, per_cu = 0;
        if (hipGetDevice(&dev) != hipSuccess || hipDeviceGetAttribute(&cus, hipDeviceAttributeMultiprocessorCount, dev) != hipSuccess) { grid = -1; return; }
        if (hipFuncSetAttribute((const void*)hybrid_fwd, hipFuncAttributeMaxDynamicSharedMemorySize, LDS_BYTES) != hipSuccess) { fprintf(stderr, "kernel_launch: hipFuncSetAttribute failed\n"); grid = -1; return; }
        if (hipOccupancyMaxActiveBlocksPerMultiprocessor(&per_cu, (const void*)hybrid_fwd, NWAVES * 64, LDS_BYTES) != hipSuccess || per_cu < 1) per_cu = 1;
        (void)hipGetLastError();
        grid = cus * per_cu;
    }
    if (grid < 0) return;
    Args a{};
    a.x = (const float*)d_in[0]; a.pos = (const int*)d_in[1]; a.g_attn = (const float*)d_in[2]; a.w_in = (const float*)d_in[3];
    a.lq1 = (const float*)d_in[4]; a.lk1 = (const float*)d_in[5]; a.lq2 = (const float*)d_in[6]; a.lk2 = (const float*)d_in[7];
    a.subln_g = (const float*)d_in[8]; a.w_pool = (const float*)d_in[9]; a.pool_scale = (const float*)d_in[10]; a.w_out = (const float*)d_in[11];
    a.g_mlp = (const float*)d_in[12]; a.w_up = (const float*)d_in[13]; a.w_down = (const float*)d_in[14]; a.g_final = (const float*)d_in[15];
    a.out = (float*)d_out; a.ws = (unsigned char*)d_ws;
    void* args[] = {&a};
    const hipError_t e = hipLaunchCooperativeKernel((const void*)hybrid_fwd, dim3(grid), dim3(NWAVES * 64), args, LDS_BYTES, stream);
    if (e != hipSuccess) fprintf(stderr, "kernel_launch: cooperative launch failed: %s (grid %d)\n", hipGetErrorString(e), grid);
}
```

```cpp
#include <hip/hip_runtime.h>
#include <hip/hip_cooperative_groups.h>
#include <cstdio>
#include <cstdint>
#include <cmath>
namespace cg = cooperative_groups;
template <int K> __device__ __forceinline__ float xor_swz(float v) { return __int_as_float(__builtin_amdgcn_ds_swizzle(__float_as_int(v), (K << 10) | 0x1f)); }
__device__ __forceinline__ float half_sum(float v) { auto rr = __builtin_amdgcn_permlane32_swap(__float_as_uint(v), __float_as_uint(v), false, false); return __uint_as_float(rr[0]) + __uint_as_float(rr[1]); }
__device__ __forceinline__ float half_max(float v) { auto rr = __builtin_amdgcn_permlane32_swap(__float_as_uint(v), __float_as_uint(v), false, false); return fmaxf(__uint_as_float(rr[0]), __uint_as_float(rr[1])); }
namespace pg8 {
#define PG8_LAS __attribute__((address_space(3)))
typedef unsigned short bf16_t;
typedef short bf16x8 __attribute__((ext_vector_type(8)));
typedef float f32x4 __attribute__((ext_vector_type(4)));
typedef unsigned u32x4 __attribute__((ext_vector_type(4)));
constexpr int BM = 256, BK = 64, HALF = 128, HTB = HALF * BK * 2  , STAGE_BYTES = 8 * HTB, NXCD = 8, WGM = 8;

__host__ __device__ __forceinline__ int lds_byte(int r, int c) { const int st = (r >> 4) * 2 + (c >> 5), rr = r & 15, cc = c & 31, ob = rr * 64 + cc * 2; return st * 1024 + (ob ^ (((ob >> 9) & 1) << 5)); }
__host__ __device__ __forceinline__ void stage_rc(int b, int& R, int& C) { const int st = b / 1024, sb = b % 1024, swz = sb ^ (((sb >> 9) & 1) << 5); R = (st >> 1) * 16 + swz / 64; C = (st & 1) * 32 + (swz % 64) / 2; }
__host__ __device__ __forceinline__ int perm32(int rho) { const int n = rho >> 4, i = rho & 15; return 8 * (i >> 2) + 4 * n + (i & 3); }

struct Unit { int pm, pn; };
struct Gemm { const bf16_t* A; const bf16_t* Bt; int M, N, K; size_t a_pn_off; };

struct StaticOrder {
    int nM, nN, nwg, G, c;
    __host__ __device__ void init(int M, int N, int G_, int c_) { nM = M / BM; nN = N / BM; nwg = nM * nN; G = G_; c = c_; }
    __host__ __device__ bool next(int i, Unit& u) const {
        const long L = (long)i * G + c; if (L >= nwg) return false;
        int wgid = (int)L; { const int q = nwg / NXCD, r = nwg % NXCD, xcd = wgid % NXCD, off = wgid / NXCD; wgid = (xcd < r ? xcd * (q + 1) : r * (q + 1) + (xcd - r) * q) + off; }
        const int nig = WGM * nN, gid = wgid / nig, fm = gid * WGM, gsz = (nM - fm) < WGM ? (nM - fm) : WGM;
        u.pm = fm + ((wgid % nig) % gsz); u.pn = (wgid % nig) / gsz; return true;
    }
    __device__ __forceinline__ void a_ready(const Unit&) const {}
    __device__ __forceinline__ void done(const Unit&) const {}
};

__device__ __forceinline__ unsigned cvt_pk_bf16(float lo, float hi) { unsigned r; asm volatile("v_cvt_pk_bf16_f32 %0, %1, %2" : "=v"(r) : "v"(lo), "v"(hi)); return r; }
typedef float f32x2 __attribute__((ext_vector_type(2)));
template <class Epi, class Sched, bool ALIGN_EPI = false, bool SP2 = false>
__device__ __forceinline__ void gemm_phase(PG8_LAS unsigned char* lds, const Gemm g, const Sched& S, const Epi& E) {
    int tid = threadIdx.x; asm volatile("" : "+v"(tid));
    const int wid = __builtin_amdgcn_readfirstlane(tid >> 6), lane = tid & 63, wr = wid >> 2, wc = wid & 3, fr = lane & 15, fq = lane >> 4;
    const int K = g.K, nt = K / BK;
    unsigned voffA[2], voffB[2];
#pragma unroll
    for (int i = 0; i < 2; ++i) { int R, C; stage_rc(tid * 16 + i * 8192, R, C); const int Rb = Epi::PERM ? ((R & ~31) + perm32(R & 31)) : R;
        voffA[i] = (unsigned)(R * K + C) * 2u; voffB[i] = (unsigned)(Rb * K + C) * 2u; }
    const size_t kstep = (size_t)(BK * 2);
    const size_t hstep = (size_t)HALF * K * 2;
    const size_t tstep = 2 * hstep;
    const unsigned ldsw = (unsigned)wid * 1024u;
    const int aoff = lds_byte(wr * 64 + fr, fq * 8), boff = lds_byte(wc * 32 + fr, fq * 8);
#define PG8_SA(b, h) (((b) * 2 + (h)) * HTB)
#define PG8_SB(b, h) ((4 + (b) * 2 + (h)) * HTB)
#define PG8_STAGE(bufoff, gbase, voff) do { _Pragma("unroll") for (int _i = 0; _i < 2; ++_i) \
        __builtin_amdgcn_global_load_lds((const unsigned*)((const char*)(gbase) + (voff)[_i]), (PG8_LAS unsigned*)(lds + (bufoff) + ldsw + _i * 8192), 16, 0, 0); } while (0)
#define PG8_LDA(dst, b, h) do { _Pragma("unroll") for (int m = 0; m < 4; ++m) _Pragma("unroll") for (int k = 0; k < 2; ++k) dst[m][k] = *(const PG8_LAS bf16x8*)(lds + PG8_SA(b, h) + aoff + m * 2048 + k * 1024); } while (0)
#define PG8_LDB(dst, b, h) do { _Pragma("unroll") for (int n = 0; n < 2; ++n) _Pragma("unroll") for (int k = 0; k < 2; ++k) dst[n][k] = *(const PG8_LAS bf16x8*)(lds + PG8_SB(b, h) + boff + n * 2048 + k * 1024); } while (0)
#define PG8_MMA(ai, bj, At, Bt) do { __builtin_amdgcn_s_setprio(1); _Pragma("unroll") for (int m = 0; m < 4; ++m) _Pragma("unroll") for (int n = 0; n < 2; ++n) _Pragma("unroll") for (int k = 0; k < 2; ++k) \
        acc[ai][bj][m][n] = __builtin_amdgcn_mfma_f32_16x16x32_bf16(Bt[n][k], At[m][k], acc[ai][bj][m][n], 0, 0, 0); __builtin_amdgcn_s_setprio(0); } while (0)
#define PG8_WAIT_V(n) asm volatile("s_waitcnt vmcnt(" #n ")" ::: "memory")
#define PG8_WAIT_L(n) asm volatile("s_waitcnt lgkmcnt(" #n ")" ::: "memory")
#define PG8_BAR __builtin_amdgcn_s_barrier()
#define PG8_SCHED __builtin_amdgcn_sched_barrier(0)
    Unit cur, nxt; int ui = 0;
    if (!S.next(0, cur)) return;
    f32x4 acc[2][2][4][2];
#pragma unroll
    for (int a = 0; a < 2; ++a)
#pragma unroll
        for (int b = 0; b < 2; ++b)
#pragma unroll
            for (int m = 0; m < 4; ++m)
#pragma unroll
                for (int n = 0; n < 2; ++n) acc[a][b][m][n] = (f32x4){0.f, 0.f, 0.f, 0.f};
    bf16x8 At[4][2], B0[2][2], B1[2][2];
    const char* cA = (const char*)g.A + (size_t)cur.pm * tstep + (size_t)cur.pn * g.a_pn_off; const char* cB = (const char*)g.Bt + (size_t)cur.pn * tstep;
    S.a_ready(cur);
    if constexpr (SP2) {
        PG8_STAGE(PG8_SB(0, 0), cB, voffB); PG8_STAGE(PG8_SB(0, 1), cB + hstep, voffB); PG8_STAGE(PG8_SA(0, 0), cA, voffA); PG8_STAGE(PG8_SA(0, 1), cA + hstep, voffA);
        if (wr == 1) PG8_BAR;
        PG8_WAIT_V(2); PG8_BAR;
        PG8_STAGE(PG8_SB(1, 0), cB + kstep, voffB); PG8_STAGE(PG8_SA(1, 0), cA + kstep, voffA); PG8_STAGE(PG8_SB(1, 1), cB + hstep + kstep, voffB);
        PG8_WAIT_V(6); PG8_BAR;
    } else {
        PG8_STAGE(PG8_SB(0, 0), cB, voffB); PG8_STAGE(PG8_SA(0, 0), cA, voffA); PG8_STAGE(PG8_SB(0, 1), cB + hstep, voffB); PG8_STAGE(PG8_SA(0, 1), cA + hstep, voffA);
        if (wr == 1) PG8_BAR;
        PG8_WAIT_V(4); PG8_BAR;
        PG8_STAGE(PG8_SB(1, 0), cB + kstep, voffB); PG8_STAGE(PG8_SA(1, 0), cA + kstep, voffA); PG8_STAGE(PG8_SB(1, 1), cB + hstep + kstep, voffB);
        PG8_WAIT_V(6); PG8_BAR;
    }
    for (;;) {
        const bool has_next = S.next(ui + 1, nxt);
        const char* nA = has_next ? (const char*)g.A + (size_t)nxt.pm * tstep + (size_t)nxt.pn * g.a_pn_off : cA; const char* nB = has_next ? (const char*)g.Bt + (size_t)nxt.pn * tstep : cB;
        for (int t = 0; t < nt; t += 2) {
            const bool last = (t == nt - 2);
            const char* a1 = cA + (size_t)(t + 1) * kstep;
            const char* a2 = last ? nA : cA + (size_t)(t + 2) * kstep; const char* b2 = last ? nB : cB + (size_t)(t + 2) * kstep;
            const char* a3 = a2 + kstep; const char* b3 = b2 + kstep;
            if (last && has_next) S.a_ready(nxt);
            if constexpr (SP2) {
            PG8_LDB(B0, 0, 0); PG8_LDB(B1, 0, 1); PG8_SCHED; PG8_LDA(At, 0, 0); PG8_STAGE(PG8_SA(1, 1), a1 + hstep, voffA);
            PG8_WAIT_V(8); PG8_WAIT_L(0); PG8_BAR; PG8_MMA(0, 0, At, B0); PG8_MMA(0, 1, At, B1); PG8_BAR; PG8_SCHED;
            PG8_LDA(At, 0, 1); PG8_STAGE(PG8_SB(0, 0), b2, voffB); PG8_STAGE(PG8_SB(0, 1), b2 + hstep, voffB); PG8_STAGE(PG8_SA(0, 0), a2, voffA);
            PG8_WAIT_V(8); PG8_WAIT_L(0); PG8_BAR; PG8_MMA(1, 0, At, B0); PG8_MMA(1, 1, At, B1); PG8_BAR; PG8_SCHED;
            PG8_LDB(B0, 1, 0); PG8_LDB(B1, 1, 1); PG8_SCHED; PG8_LDA(At, 1, 0); PG8_STAGE(PG8_SA(0, 1), a2 + hstep, voffA);
            PG8_WAIT_V(8); PG8_WAIT_L(0); PG8_BAR; PG8_MMA(0, 0, At, B0); PG8_MMA(0, 1, At, B1); PG8_BAR; PG8_SCHED;
            PG8_LDA(At, 1, 1); PG8_STAGE(PG8_SB(1, 0), b3, voffB); PG8_STAGE(PG8_SB(1, 1), b3 + hstep, voffB); PG8_STAGE(PG8_SA(1, 0), a3, voffA);
            PG8_WAIT_V(8); PG8_WAIT_L(0); PG8_BAR; PG8_MMA(1, 0, At, B0); PG8_MMA(1, 1, At, B1); PG8_BAR; PG8_SCHED;
            } else {
            PG8_LDB(B0, 0, 0); PG8_SCHED; PG8_LDA(At, 0, 0); PG8_STAGE(PG8_SA(1, 1), a1 + hstep, voffA);
            PG8_WAIT_L(8); PG8_BAR; PG8_WAIT_L(0); PG8_MMA(0, 0, At, B0); PG8_BAR; PG8_SCHED;
            PG8_LDB(B1, 0, 1); PG8_STAGE(PG8_SB(0, 0), b2, voffB);
            PG8_BAR; PG8_WAIT_L(0); PG8_MMA(0, 1, At, B1); PG8_BAR;
            PG8_LDA(At, 0, 1); PG8_STAGE(PG8_SA(0, 0), a2, voffA);
            PG8_BAR; PG8_WAIT_L(0); PG8_MMA(1, 0, At, B0); PG8_BAR; PG8_SCHED;
            PG8_STAGE(PG8_SB(0, 1), b2 + hstep, voffB);
            PG8_WAIT_V(6); PG8_BAR; PG8_MMA(1, 1, At, B1); PG8_BAR;
            PG8_LDB(B0, 1, 0); PG8_SCHED; PG8_LDA(At, 1, 0); PG8_STAGE(PG8_SA(0, 1), a2 + hstep, voffA);
            PG8_WAIT_L(8); PG8_BAR; PG8_WAIT_L(0); PG8_MMA(0, 0, At, B0); PG8_BAR; PG8_SCHED;
            PG8_LDB(B1, 1, 1); PG8_STAGE(PG8_SB(1, 0), b3, voffB);
            PG8_BAR; PG8_WAIT_L(0); PG8_MMA(0, 1, At, B1); PG8_BAR;
            PG8_LDA(At, 1, 1); PG8_STAGE(PG8_SA(1, 0), a3, voffA);
            PG8_BAR; PG8_WAIT_L(0); PG8_MMA(1, 0, At, B0); PG8_BAR; PG8_SCHED;
            PG8_STAGE(PG8_SB(1, 1), b3 + hstep, voffB);
            PG8_WAIT_V(6); PG8_BAR; PG8_MMA(1, 1, At, B1); PG8_BAR;
            }
        }
        if constexpr (ALIGN_EPI) { if (wr == 0) PG8_BAR; }
        if constexpr (!Epi::AFTER_DRAIN) { E(acc, cur, wr, wc, fr, fq); S.done(cur); }
        if (!has_next) break;
#pragma unroll
        for (int a = 0; a < 2; ++a)
#pragma unroll
            for (int b = 0; b < 2; ++b)
#pragma unroll
                for (int m = 0; m < 4; ++m)
#pragma unroll
                    for (int n = 0; n < 2; ++n) acc[a][b][m][n] = (f32x4){0.f, 0.f, 0.f, 0.f};
        cur = nxt; cA = nA; cB = nB; ++ui;
        if constexpr (ALIGN_EPI) { if (wr == 1) PG8_BAR; }
    }
    PG8_WAIT_V(0);
    if constexpr (!ALIGN_EPI) { if (wr == 0) PG8_BAR; }
    PG8_BAR;
    if constexpr (Epi::AFTER_DRAIN) { E.fused(acc, cur, wr, wc, fr, fq, lds, wid, lane); S.done(cur); }
#undef PG8_SA
#undef PG8_SB
#undef PG8_STAGE
#undef PG8_LDA
#undef PG8_LDB
#undef PG8_MMA
#undef PG8_WAIT_V
#undef PG8_WAIT_L
#undef PG8_BAR
#undef PG8_SCHED
}
}
namespace pg8 {
typedef unsigned u32x2 __attribute__((ext_vector_type(2)));
__device__ __forceinline__ float bf_lo(unsigned w) { return __uint_as_float(w << 16); }
__device__ __forceinline__ float bf_hi(unsigned w) { return __uint_as_float(w & 0xffff0000u); }
__device__ __forceinline__ u32x4 pack8(const f32x4 a, const f32x4 b) { u32x4 w; w.x = cvt_pk_bf16(a[0], a[1]); w.y = cvt_pk_bf16(a[2], a[3]); w.z = cvt_pk_bf16(b[0], b[1]); w.w = cvt_pk_bf16(b[2], b[3]); return w; }
constexpr float QSCALE = 0.125f * 1.4426950408889634f;

struct EpiIn {
    static constexpr bool PERM = true, AFTER_DRAIN = false;
    bf16_t *Q, *K, *V, *U, *G; const float* rope;
    __device__ __forceinline__ void operator()(const f32x4 (&acc)[2][2][4][2], const Unit& u, int wr, int wc, int fr, int fq) const {
        const int pn = u.pn; int kind, ldc, colt; bf16_t* base;
        if (pn < 4)       { kind = 0; base = Q; ldc = 1024; colt = pn * 256; }
        else if (pn < 8)  { kind = 1; base = K; ldc = 1024; colt = (pn - 4) * 256; }
        else if (pn < 12) { kind = 2; base = V; ldc = 1024; colt = (pn - 8) * 256; }
        else if (pn < 14) { kind = 2; base = U; ldc = 512;  colt = (pn - 12) * 256; }
        else              { kind = 3; base = G; ldc = 2048; colt = (pn - 14) * 256; }
        const int row0 = u.pm * BM + wr * 64 + fr, col0 = colt + wc * 32 + 8 * fq;
        const bool rl = ((wc & 1) == 0) && (fq < 2);
        const float sgn = (fq == 0) ? -1.f : 1.f;
#pragma unroll
        for (int ai = 0; ai < 2; ++ai)
#pragma unroll
            for (int m = 0; m < 4; ++m) {
                const int row = row0 + ai * HALF + m * 16;
                bf16_t* rowp = base + (size_t)row * ldc + col0;
                if (kind <= 1) {
                    const f32x4* rp = (const f32x4*)(rope + (size_t)row * 16);
                    const f32x4 c0 = rp[0], c1 = rp[1], c2 = rp[2], c3 = rp[3];
#pragma unroll
                    for (int bj = 0; bj < 2; ++bj) {
                        f32x4 v0 = acc[ai][bj][m][0], v1 = acc[ai][bj][m][1], p0, p1;
#pragma unroll
                        for (int e = 0; e < 4; ++e) { p0[e] = xor_swz<16>(v0[e]); p1[e] = xor_swz<16>(v1[e]); }
                        if (rl) {
                            v0[0] = v0[0] * c0[0] + sgn * p0[0] * c0[1]; v0[1] = v0[1] * c0[2] + sgn * p0[1] * c0[3];
                            v0[2] = v0[2] * c1[0] + sgn * p0[2] * c1[1]; v0[3] = v0[3] * c1[2] + sgn * p0[3] * c1[3];
                            v1[0] = v1[0] * c2[0] + sgn * p1[0] * c2[1]; v1[1] = v1[1] * c2[2] + sgn * p1[1] * c2[3];
                            v1[2] = v1[2] * c3[0] + sgn * p1[2] * c3[1]; v1[3] = v1[3] * c3[2] + sgn * p1[3] * c3[3];
                        }
                        if (kind == 0) { v0 = v0 * QSCALE; v1 = v1 * QSCALE; }
                        __builtin_nontemporal_store(pack8(v0, v1), (u32x4*)(rowp + bj * HALF));
                    }
                } else {
#pragma unroll
                    for (int bj = 0; bj < 2; ++bj) {
                        f32x4 v0 = acc[ai][bj][m][0], v1 = acc[ai][bj][m][1];
                        if (kind == 3) {
#pragma unroll
                            for (int e = 0; e < 4; ++e) { v0[e] = __builtin_amdgcn_rcpf(1.f + __builtin_amdgcn_exp2f(v0[e])); v1[e] = __builtin_amdgcn_rcpf(1.f + __builtin_amdgcn_exp2f(v1[e])); }
                        }
                        __builtin_nontemporal_store(pack8(v0, v1), (u32x4*)(rowp + bj * HALF));
                    }
                }
            }
    }
};

struct EpiMerge {
    static constexpr bool PERM = true, AFTER_DRAIN = false;
    const bf16_t* A; const bf16_t* G; const float* pscale; bf16_t* Mg;
    __device__ __forceinline__ void operator()(const f32x4 (&acc)[2][2][4][2], const Unit& u, int wr, int wc, int fr, int fq) const {
        const int row0 = u.pm * BM + wr * 64 + fr, col0 = u.pn * BM + wc * 32 + 8 * fq;
        f32x4 ps[2][2];
#pragma unroll
        for (int bj = 0; bj < 2; ++bj) { ps[bj][0] = *(const f32x4*)(pscale + col0 + bj * HALF); ps[bj][1] = *(const f32x4*)(pscale + col0 + bj * HALF + 4); }
#pragma unroll
        for (int ai = 0; ai < 2; ++ai)
#pragma unroll
            for (int m = 0; m < 4; ++m) {
                const size_t row = (size_t)(row0 + ai * HALF + m * 16);
#pragma unroll
                for (int bj = 0; bj < 2; ++bj) {
                    const int c = col0 + bj * HALF;
                    const u32x4 a8 = __builtin_nontemporal_load((const u32x4*)(A + row * 1024 + c)), ga = __builtin_nontemporal_load((const u32x4*)(G + row * 2048 + c)), gp = __builtin_nontemporal_load((const u32x4*)(G + row * 2048 + 1024 + c));
                    const f32x4 y0 = acc[ai][bj][m][0] * ps[bj][0], y1 = acc[ai][bj][m][1] * ps[bj][1];
                    f32x4 o0, o1;
                    o0[0] = bf_lo(ga.x) * bf_lo(a8.x) + bf_lo(gp.x) * y0[0]; o0[1] = bf_hi(ga.x) * bf_hi(a8.x) + bf_hi(gp.x) * y0[1];
                    o0[2] = bf_lo(ga.y) * bf_lo(a8.y) + bf_lo(gp.y) * y0[2]; o0[3] = bf_hi(ga.y) * bf_hi(a8.y) + bf_hi(gp.y) * y0[3];
                    o1[0] = bf_lo(ga.z) * bf_lo(a8.z) + bf_lo(gp.z) * y1[0]; o1[1] = bf_hi(ga.z) * bf_hi(a8.z) + bf_hi(gp.z) * y1[1];
                    o1[2] = bf_lo(ga.w) * bf_lo(a8.w) + bf_lo(gp.w) * y1[2]; o1[3] = bf_hi(ga.w) * bf_hi(a8.w) + bf_hi(gp.w) * y1[3];
                    __builtin_nontemporal_store(pack8(o0, o1), (u32x4*)(Mg + row * 1024 + c));
                }
                asm volatile("" ::: "memory");
            }
    }
};

struct EpiResA {
    static constexpr bool PERM = true, AFTER_DRAIN = false;
    const float* xi; bf16_t* xb; float* ssq;
    __device__ __forceinline__ void operator()(const f32x4 (&acc)[2][2][4][2], const Unit& u, int wr, int wc, int fr, int fq) const {
        const int row0 = u.pm * BM + wr * 64 + fr, col0 = u.pn * BM + wc * 32 + 8 * fq;
#pragma unroll
        for (int ai = 0; ai < 2; ++ai)
#pragma unroll
            for (int m = 0; m < 4; ++m) {
                const size_t row = (size_t)(row0 + ai * HALF + m * 16); float s = 0.f;
#pragma unroll
                for (int bj = 0; bj < 2; ++bj) {
                    const size_t off = row * 1024 + col0 + bj * HALF;
                    const f32x4 r0 = __builtin_nontemporal_load((const f32x4*)(xi + off)) + acc[ai][bj][m][0], r1 = __builtin_nontemporal_load((const f32x4*)(xi + off + 4)) + acc[ai][bj][m][1];
                    *(u32x4*)(xb + off) = pack8(r0, r1);
                    s += (r0[0] * r0[0] + r0[1] * r0[1]) + (r0[2] * r0[2] + r0[3] * r0[3]) + (r1[0] * r1[0] + r1[1] * r1[1]) + (r1[2] * r1[2] + r1[3] * r1[3]);
                }
                s += xor_swz<16>(s); s = half_sum(s);
                if (fq == 0) ssq[row * 16 + u.pn * 4 + wc] = s;
            }
    }
};
struct EpiResB {
    static constexpr bool PERM = true, AFTER_DRAIN = false;
    bf16_t* xb; float* ssq;
    __device__ __forceinline__ void operator()(const f32x4 (&acc)[2][2][4][2], const Unit& u, int wr, int wc, int fr, int fq) const {
        const int row0 = u.pm * BM + wr * 64 + fr, col0 = u.pn * BM + wc * 32 + 8 * fq;
#pragma unroll
        for (int ai = 0; ai < 2; ++ai)
#pragma unroll
            for (int m = 0; m < 4; ++m) {
                const size_t row = (size_t)(row0 + ai * HALF + m * 16); float s = 0.f;
#pragma unroll
                for (int bj = 0; bj < 2; ++bj) {
                    const size_t off = row * 1024 + col0 + bj * HALF;
                    const u32x4 w = __builtin_nontemporal_load((const u32x4*)(xb + off));
                    const f32x4 r0 = (f32x4){bf_lo(w.x), bf_hi(w.x), bf_lo(w.y), bf_hi(w.y)} + acc[ai][bj][m][0], r1 = (f32x4){bf_lo(w.z), bf_hi(w.z), bf_lo(w.w), bf_hi(w.w)} + acc[ai][bj][m][1];
                    __builtin_nontemporal_store(pack8(r0, r1), (u32x4*)(xb + off));
                    s += (r0[0] * r0[0] + r0[1] * r0[1]) + (r0[2] * r0[2] + r0[3] * r0[3]) + (r1[0] * r1[0] + r1[1] * r1[1]) + (r1[2] * r1[2] + r1[3] * r1[3]);
                }
                s += xor_swz<16>(s); s = half_sum(s);
                if (fq == 0) ssq[row * 16 + u.pn * 4 + wc] = s;
            }
    }
};

struct EpiUp {
    static constexpr bool PERM = true, AFTER_DRAIN = false;
    const float* ssq; bf16_t* Z;
    __device__ __forceinline__ void operator()(const f32x4 (&acc)[2][2][4][2], const Unit& u, int wr, int wc, int fr, int fq) const {
        typedef float f32x2v __attribute__((ext_vector_type(2)));
        const int row0 = u.pm * BM + wr * 64 + fr, col0 = u.pn * BM + wc * 32 + 8 * fq;
#pragma unroll
        for (int ai = 0; ai < 2; ++ai)
#pragma unroll
            for (int m = 0; m < 4; ++m) {
                const size_t row = (size_t)(row0 + ai * HALF + m * 16);
                const f32x4 pq = *(const f32x4*)(ssq + row * 16 + 4 * fq);
                float s = (pq[0] + pq[1]) + (pq[2] + pq[3]); s += xor_swz<16>(s); s = half_sum(s);
                const float r2 = __builtin_amdgcn_rcpf(s * (1.0f / 1024.0f) + 1e-6f);
                const f32x2v r2v = {r2, r2};
#pragma unroll
                for (int bj = 0; bj < 2; ++bj) {
                    f32x4 v0 = acc[ai][bj][m][0], v1 = acc[ai][bj][m][1];
#pragma unroll
                    for (int e = 0; e < 4; ++e) { v0[e] = fmaxf(v0[e], 0.f); v1[e] = fmaxf(v1[e], 0.f); }
                    f32x2v a = {v0[0], v0[1]}, b = {v0[2], v0[3]}, c = {v1[0], v1[1]}, d = {v1[2], v1[3]};
                    a = (a * a) * r2v; b = (b * b) * r2v; c = (c * c) * r2v; d = (d * d) * r2v;
                    u32x4 w; w.x = cvt_pk_bf16(a.x, a.y); w.y = cvt_pk_bf16(b.x, b.y); w.z = cvt_pk_bf16(c.x, c.y); w.w = cvt_pk_bf16(d.x, d.y);
                    __builtin_nontemporal_store(w, (u32x4*)(Z + row * 4096 + col0 + bj * HALF));
                }
            }
    }
};
}
namespace att {
#define ATT_LAS __attribute__((address_space(3)))
typedef unsigned short bf16_t;
typedef short bf16x8 __attribute__((ext_vector_type(8)));
typedef short s16x4 __attribute__((ext_vector_type(4)));
typedef float f32x16 __attribute__((ext_vector_type(16)));
typedef unsigned u32x4 __attribute__((ext_vector_type(4)));
constexpr int SEQ = 4096, PITCH = 1024;
constexpr int KBUF = 0, VBUF = 32768, WSF = 65536, QBUF = 65536 + 4096, ATT_LDS_BYTES = QBUF + 8 * 8192;
constexpr float THR = 8.0f;
__device__ __forceinline__ int crow(int r, int hi) { return (r & 3) + 8 * (r >> 2) + 4 * hi; }
__device__ __forceinline__ int koffs(int row, int ch) { return row * 256 + ((ch ^ (row & 15)) << 4); }
__device__ __forceinline__ int voffs(int row, int ch) { return 2048 * (row >> 3) + 512 * (ch >> 2) + 64 * (row & 7) + 16 * ((ch & 3) ^ ((row >> 2) & 3)); }
__device__ __forceinline__ unsigned cvtpk(float lo, float hi) { unsigned r; asm volatile("v_cvt_pk_bf16_f32 %0, %1, %2" : "=v"(r) : "v"(lo), "v"(hi)); return r; }
__device__ __forceinline__ s16x4 vtr(const ATT_LAS unsigned char* p) { return __builtin_bit_cast(s16x4, __builtin_amdgcn_ds_read_tr16_b64_v4i16((ATT_LAS s16x4*)p)); }
__device__ __forceinline__ int sub1(int a) { int v = a ^ 128; asm volatile("" : "+v"(v)); return v; }
__device__ __forceinline__ void glds16(const char* sbase, unsigned voff, unsigned lds_dst) { unsigned keep;
    asm volatile("s_mov_b32 %0, m0\n\ts_mov_b32 m0, %3\n\ts_nop 0\n\tglobal_load_lds_dwordx4 %1, %2\n\ts_mov_b32 m0, %0" : "=&s"(keep) : "v"(voff), "s"(sbase), "s"(lds_dst) : "memory"); }
#define ATT_MFMA(a, b, c) __builtin_amdgcn_mfma_f32_32x32x16_bf16((a), (b), (c), 0, 0, 0)

template <bool C1> __device__ __forceinline__ void qk_issue(f32x16& s0, const ATT_LAS unsigned char* kb, const ATT_LAS unsigned char* qb_, const int (&kaddr)[4]) {
#pragma unroll
    for (int i = 0; i < 16; ++i) s0[i] = 0.f;
#pragma unroll
    for (int ds = 0; ds < 4; ++ds) {
        const int ad = C1 ? sub1(kaddr[ds]) : kaddr[ds];
        const bf16x8 a0 = *(const ATT_LAS bf16x8*)(kb + ad);
        const bf16x8 qv = *(const ATT_LAS bf16x8*)(qb_ + ad);
        s0 = ATT_MFMA(a0, qv, s0);
    }
}
__device__ __forceinline__ void rowmax_rescale(bool MASK, f32x16& s0, f32x16 (&O)[4], float& m, float& l, int kvr, int r, int h, ATT_LAS float* wsf) {
    if (MASK) {
        asm volatile("" ::: "memory");
        const int d = r - 4 * h - kvr;
#pragma unroll
        for (int i = 0; i < 16; ++i) { if (((i & 3) + 8 * (i >> 2)) > d) s0[i] = -INFINITY; }
    }
    float ra = __builtin_fmaxf(__builtin_fmaxf(s0[0], s0[1]), s0[2]), rb = __builtin_fmaxf(__builtin_fmaxf(s0[3], s0[4]), s0[5]);
    ra = __builtin_fmaxf(__builtin_fmaxf(ra, s0[6]), s0[7]); rb = __builtin_fmaxf(__builtin_fmaxf(rb, s0[8]), s0[9]);
    ra = __builtin_fmaxf(__builtin_fmaxf(ra, s0[10]), s0[11]); rb = __builtin_fmaxf(__builtin_fmaxf(rb, s0[12]), s0[13]);
    ra = __builtin_fmaxf(__builtin_fmaxf(ra, s0[14]), s0[15]);
    const float rm = half_max(__builtin_fmaxf(ra, rb));
    if (__any(rm > m + THR)) {
        const float mn = fmaxf(m, rm), al = __builtin_amdgcn_exp2f(m - mn);
        l *= al; m = mn;
        if (h == 0) wsf[r] = al;
#pragma unroll
        for (int i = 0; i < 16; ++i) { const float a = wsf[crow(i, h)];
#pragma unroll
            for (int db = 0; db < 4; ++db) O[db][i] *= a; }
    }
}
template <bool HAS_PV, bool HAS_QK, bool C1>
__device__ __forceinline__ float step_fused(f32x16& Scur, float m, float& l, u32x4 (&pkout)[2],
                                           f32x16 (&Opv)[4], const u32x4 (&pkin)[2], const ATT_LAS unsigned char* vb, const int (&vaddr)[2],
                                           f32x16& Snext, const ATT_LAS unsigned char* kb, const ATT_LAS unsigned char* qb_, const int (&kaddr)[4]) {
    s16x4 vlo[2], vhi[2]; bf16x8 ka, qa;
    if (HAS_PV) {
#pragma unroll
        for (int u = 0; u < 2; ++u) { vlo[u] = vtr(vb + vaddr[0] + u * 512); vhi[u] = vtr(vb + vaddr[1] + u * 512); } }
    if (HAS_QK) { const int ad = C1 ? sub1(kaddr[0]) : kaddr[0]; ka = *(const ATT_LAS bf16x8*)(kb + ad); qa = *(const ATT_LAS bf16x8*)(qb_ + ad);
#pragma unroll
        for (int i = 0; i < 16; ++i) Snext[i] = 0.f; }
    float sa = 0.f, sb = 0.f;
#pragma unroll
    for (int g = 0; g < 4; ++g) {
        s16x4 nlo[2], nhi[2]; bf16x8 nk, nq;
        if (g < 3) {
            if (HAS_PV) {
#pragma unroll
                for (int u = 0; u < 2; ++u) { const int off = (2 * ((g + 1) & 1) + u) * 512 + ((g + 1) >> 1) * 4096; nlo[u] = vtr(vb + vaddr[0] + off); nhi[u] = vtr(vb + vaddr[1] + off); } }
            if (HAS_QK) { const int ad = C1 ? sub1(kaddr[g + 1]) : kaddr[g + 1]; nk = *(const ATT_LAS bf16x8*)(kb + ad); nq = *(const ATT_LAS bf16x8*)(qb_ + ad); }
        }
        if (HAS_PV) { const bf16x8 pa = __builtin_bit_cast(bf16x8, pkin[g >> 1]);
#pragma unroll
            for (int u = 0; u < 2; ++u) { const bf16x8 vf = __builtin_shufflevector(vlo[u], vhi[u], 0, 1, 2, 3, 4, 5, 6, 7); Opv[2 * (g & 1) + u] = ATT_MFMA(pa, vf, Opv[2 * (g & 1) + u]); } }
        if (HAS_QK) Snext = ATT_MFMA(ka, qa, Snext);
#pragma unroll
        for (int e = 4 * g; e < 4 * g + 4; e += 2) { Scur[e] = __builtin_amdgcn_exp2f(Scur[e] - m); Scur[e + 1] = __builtin_amdgcn_exp2f(Scur[e + 1] - m); sa += Scur[e]; sb += Scur[e + 1]; }
        if (g & 1) pkout[g >> 1] = (u32x4){cvtpk(Scur[4 * g - 4], Scur[4 * g - 3]), cvtpk(Scur[4 * g - 2], Scur[4 * g - 1]), cvtpk(Scur[4 * g], Scur[4 * g + 1]), cvtpk(Scur[4 * g + 2], Scur[4 * g + 3])};
        if (g < 3) {
            if (HAS_PV) {
#pragma unroll
                for (int u = 0; u < 2; ++u) { vlo[u] = nlo[u]; vhi[u] = nhi[u]; } }
            if (HAS_QK) { ka = nk; qa = nq; }
        }
        __builtin_amdgcn_sched_barrier(0);
    }
    l += sa + sb;
    return sa + sb;
}
__device__ __forceinline__ void pv_issue(f32x16 (&O)[4], const u32x4 (&pk)[2], const ATT_LAS unsigned char* vb, const int (&vaddr)[2]) {
#pragma unroll
    for (int s_ = 0; s_ < 2; ++s_) { const bf16x8 pa = __builtin_bit_cast(bf16x8, pk[s_]);
#pragma unroll
        for (int db = 0; db < 4; ++db) {
            const s16x4 lo = vtr(vb + vaddr[0] + db * 512 + s_ * 4096), hi = vtr(vb + vaddr[1] + db * 512 + s_ * 4096);
            const bf16x8 vf = __builtin_shufflevector(lo, hi, 0, 1, 2, 3, 4, 5, 6, 7);
            O[db] = ATT_MFMA(pa, vf, O[db]); } }
}

__device__ __forceinline__ void apply_mask(bool MASK, f32x16& s0, int kvr, int r, int h) {
    if (MASK) {
        asm volatile("" ::: "memory");
        const int d = r - 4 * h - kvr;
#pragma unroll
        for (int i = 0; i < 16; ++i) { if (((i & 3) + 8 * (i >> 2)) > d) s0[i] = -INFINITY; }
    }
}
constexpr float GUARD = 65536.0f;
template <bool C1> __device__ __forceinline__ void slow_step(bool MASK, f32x16& S, const ATT_LAS unsigned char* kb, const ATT_LAS unsigned char* qbase, const int (&kaddr)[4], const int (&vaddr)[2],
                                                             f32x16 (&O)[4], float& m, float& l, float l_saved, int kvr, int r, int h, ATT_LAS float* wsf, u32x4 (&pk)[2]) {
    l = l_saved;
    qk_issue<C1>(S, kb, qbase, kaddr);
    rowmax_rescale(MASK, S, O, m, l, kvr, r, h, wsf);
    f32x16 dummy;
    step_fused<false, false, false>(S, m, l, pk, O, pk, kb, vaddr, dummy, kb, qbase, kaddr);
}
__device__ __forceinline__ void tile_body(bool MASK, const ATT_LAS unsigned char* kb, const ATT_LAS unsigned char* vb, const ATT_LAS unsigned char* qbase, const int (&kaddr)[4], const int (&vaddr)[2],
                                                               f32x16 (&O1)[4], f32x16 (&O2)[4], float& m1, float& m2, float& l1, float& l2, int kvrel, int r, int h, ATT_LAS float* wsf) {
    f32x16 Sa, Sb; u32x4 pkA[2], pkB[2]; float ls, sm;
    qk_issue<false>(Sa, kb, qbase, kaddr);
    apply_mask(MASK, Sa, kvrel, r, h); ls = l1;
    sm = step_fused<false, true, true>(Sa, m1, l1, pkA, O1, pkA, vb, vaddr, Sb, kb, qbase, kaddr);
    if (__any(!(sm <= GUARD))) slow_step<false>(MASK, Sa, kb, qbase, kaddr, vaddr, O1, m1, l1, ls, kvrel, r, h, wsf, pkA);
    apply_mask(MASK, Sb, kvrel, r, h); ls = l2;
    sm = step_fused<true, true, false>(Sb, m2, l2, pkB, O1, pkA, vb, vaddr, Sa, kb + 8192, qbase, kaddr);
    if (__any(!(sm <= GUARD))) slow_step<true>(MASK, Sb, kb, qbase, kaddr, vaddr, O2, m2, l2, ls, kvrel, r, h, wsf, pkB);
    apply_mask(MASK, Sa, kvrel + 32, r, h); ls = l1;
    sm = step_fused<true, true, true>(Sa, m1, l1, pkA, O2, pkB, vb, vaddr, Sb, kb + 8192, qbase, kaddr);
    if (__any(!(sm <= GUARD))) slow_step<false>(MASK, Sa, kb + 8192, qbase, kaddr, vaddr, O1, m1, l1, ls, kvrel + 32, r, h, wsf, pkA);
    apply_mask(MASK, Sb, kvrel + 32, r, h); ls = l2;
    sm = step_fused<true, false, false>(Sb, m2, l2, pkB, O1, pkA, vb + 8192, vaddr, Sa, kb, qbase, kaddr);
    if (__any(!(sm <= GUARD))) slow_step<true>(MASK, Sb, kb + 8192, qbase, kaddr, vaddr, O2, m2, l2, ls, kvrel + 32, r, h, wsf, pkB);
    pv_issue(O2, pkB, vb + 8192, vaddr);
}

__device__ __forceinline__ void attn_unit(ATT_LAS unsigned char* lds, const bf16_t* Qg, const bf16_t* Kg, const bf16_t* Vg, bf16_t* Og, int b, int head, int qb, float lam, const float* subg) {
    int tid = threadIdx.x; asm volatile("" : "+v"(tid));
    const int lane = tid & 63, r = lane & 31, h = lane >> 5;
    const int w = __builtin_amdgcn_readfirstlane(tid >> 6);
    const size_t rowbase = (size_t)b * SEQ; const int q0 = qb * 256, NT = (q0 + 256) >> 6;
    const char* Kt = (const char*)(Kg + rowbase * PITCH + head * 128);
    const char* Vt = (const char*)(Vg + rowbase * PITCH + head * 128);
    unsigned ksrc[2], vsrc[2];
#pragma unroll
    for (int i = 0; i < 2; ++i) { const int ii = w * 2 + i;
        { const int row = 4 * ii + (lane >> 4), pc = lane & 15; ksrc[i] = (unsigned)(row * 2048 + ((pc ^ (row & 15)) << 4)); }
        { const int row = 8 * (ii >> 1) + ((lane >> 2) & 7), ch = 4 * (2 * (ii & 1) + (lane >> 5)) + ((lane & 3) ^ ((row >> 2) & 3)); vsrc[i] = (unsigned)(row * 2048 + ch * 16); } }
    const unsigned ldsb = (unsigned)(uintptr_t)lds;
#define ATT_STAGE(t, buf) do { _Pragma("unroll") for (int i_ = 0; i_ < 2; ++i_) { \
        glds16(Kt + (size_t)(t) * 131072, ksrc[i_], (unsigned)__builtin_amdgcn_readfirstlane(ldsb + KBUF + (buf) * 16384 + (w * 2 + i_) * 1024)); \
        glds16(Vt + (size_t)(t) * 131072, vsrc[i_], (unsigned)__builtin_amdgcn_readfirstlane(ldsb + VBUF + (buf) * 16384 + (w * 2 + i_) * 1024)); } } while (0)
    ATT_STAGE(0, 0);
    { const char* Qw = (const char*)(Qg + (rowbase + q0 + w * 32) * PITCH + head * 128);
#pragma unroll
      for (int i = 0; i < 8; ++i) { const int row = 4 * i + (lane >> 4), pc = lane & 15;
          glds16(Qw, (unsigned)(row * 2048 + ((pc ^ (row & 15)) << 4)), (unsigned)__builtin_amdgcn_readfirstlane(ldsb + QBUF + w * 8192 + i * 1024)); } }
    const ATT_LAS unsigned char* qbase = lds + QBUF + w * 8192;
    int kaddr[4], vaddr[2];
#pragma unroll
    for (int ds = 0; ds < 4; ++ds) kaddr[ds] = koffs(r, 2 * ds + h);
    { const int q = (lane & 15) >> 2, p = lane & 3, blk = (lane >> 4) & 1;
#pragma unroll
      for (int sub = 0; sub < 2; ++sub) vaddr[sub] = voffs(8 * sub + 4 * h + q, 2 * blk + (p >> 1)) + 8 * (p & 1); }
    ATT_LAS float* wsf = (ATT_LAS float*)(lds + WSF + w * 512);
    f32x16 O1[4], O2[4];
#pragma unroll
    for (int db = 0; db < 4; ++db)
#pragma unroll
        for (int i = 0; i < 16; ++i) { O1[db][i] = 0.f; O2[db][i] = 0.f; }
    float m1 = -1e30f, m2 = -1e30f, l1 = 0.f, l2 = 0.f;
    asm volatile("s_waitcnt vmcnt(0)" ::: "memory"); __syncthreads();
    for (int t = 0; t < NT; ++t) {
        const int buf = t & 1;
        if (t + 1 < NT) ATT_STAGE(t + 1, buf ^ 1);
        const int kvrel = 64 * t - q0 - 32 * w;
        if (kvrel <= 31) {
            const ATT_LAS unsigned char* kb = lds + KBUF + buf * 16384;
            const ATT_LAS unsigned char* vb = lds + VBUF + buf * 16384;
            tile_body(kvrel + 63 > 0, kb, vb, qbase, kaddr, vaddr, O1, O2, m1, m2, l1, l2, kvrel, r, h, wsf);
        }
        asm volatile("s_waitcnt vmcnt(0)" ::: "memory"); __syncthreads();
    }
    l1 = half_sum(l1); l2 = half_sum(l2);
    if (h == 0) { wsf[r] = 1.0f / l1; wsf[32 + r] = lam / l2; }
    float sg[4];
#pragma unroll
    for (int db = 0; db < 4; ++db) sg[db] = subg[32 * db + r] * 0.8f;
    bf16_t* Ow = Og + (rowbase + q0 + w * 32) * PITCH + head * 128 + r;
#pragma unroll
    for (int i = 0; i < 16; ++i) {
        const int qr = crow(i, h); const float a1 = wsf[qr], a2 = wsf[32 + qr];
        float o[4], ss = 0.f;
#pragma unroll
        for (int db = 0; db < 4; ++db) { o[db] = O1[db][i] * a1 - O2[db][i] * a2; ss += o[db] * o[db]; }
        ss += xor_swz<1>(ss); ss += xor_swz<2>(ss); ss += xor_swz<4>(ss); ss += xor_swz<8>(ss); ss += xor_swz<16>(ss);
        const float rs = __builtin_amdgcn_rsqf(ss * (1.0f / 128.0f) + 1e-6f);
#pragma unroll
        for (int db = 0; db < 4; ++db) Ow[(size_t)qr * PITCH + 32 * db] = (bf16_t)(cvtpk(o[db] * rs * sg[db], 0.f) & 0xffffu);
    }
#undef ATT_STAGE
}
}
constexpr int NWAVES = 8;
constexpr int BATCH = 16, SEQ = 4096, D = 1024, NH = 8, FF = 4096, INW = 5632, M = BATCH * SEQ;
constexpr float RMS_EPS = 1e-6f;
constexpr size_t MiB = 1u << 20;
constexpr size_t WS_WIN = 0, WS_WOUT = 11 * MiB, WS_WUP = 13 * MiB, WS_WDOWN = 21 * MiB, WS_WPOOL = 29 * MiB;
constexpr size_t WS_ROPE = 30 * MiB;
constexpr size_t WS_SSQ1 = 34 * MiB, WS_SSQ2 = 38 * MiB;
constexpr size_t WS_BAR = 42 * MiB, BAR_ZERO_BYTES = 32768;
constexpr size_t WS_XN = 48 * MiB;
constexpr size_t WS_Q = 176 * MiB;
constexpr size_t WS_K = 304 * MiB;
constexpr size_t WS_V = 432 * MiB;
constexpr size_t WS_U = 560 * MiB;
constexpr size_t WS_G = 624 * MiB;
constexpr size_t WS_DP = 880 * MiB;
constexpr size_t WS_Z = 176 * MiB;
constexpr size_t WS_END = 944 * MiB;
static_assert(WS_Z + (size_t)M * FF * 2 <= WS_DP && WS_DP + (size_t)M * 512 * 2 <= WS_END, "d_ws map");
constexpr int LDS_MISC_OFF = 147456 - 256;
constexpr int LDS_BYTES = 147456;

#define LAS __attribute__((address_space(3)))
typedef unsigned short bf16;
typedef unsigned v4u __attribute__((ext_vector_type(4)));
typedef float f32x4 __attribute__((ext_vector_type(4)));
__device__ __forceinline__ unsigned f2bf(float f) { unsigned u = __builtin_bit_cast(unsigned, f); return (u + 0x7fffu + ((u >> 16) & 1u)) >> 16; }
__device__ __forceinline__ unsigned pk2(float lo, float hi) { return f2bf(lo) | (f2bf(hi) << 16); }
__device__ __forceinline__ float wave_sum(float v) {
    v += xor_swz<1>(v); v += xor_swz<2>(v); v += xor_swz<4>(v); v += xor_swz<8>(v); v += xor_swz<16>(v);
    return half_sum(v);
}
template <bool WIN = false>
__device__ __forceinline__ void p0_transpose_item(const float* W, int K, int N, bf16* WT, int row_off, const float* kscale, LAS float* scr, int item, int lane) {
    const int nblk = N / 32, kb = item / nblk, nb = item % nblk, k0 = 64 * kb, n0 = 32 * nb;
#pragma unroll 8
    for (int i = 0; i < 32; ++i) { const int kk = 2 * i + (lane >> 5); float v = W[(size_t)(k0 + kk) * N + n0 + (lane & 31)]; if (kscale) v *= kscale[k0 + kk]; if (WIN && n0 + (lane & 31) >= 3584) v *= -1.4426950408889634f; scr[kk * 33 + (lane & 31)] = v; }
    asm volatile("s_waitcnt lgkmcnt(0)" ::: "memory");
    const int c = lane & 7;
#pragma unroll
    for (int j = 0; j < 4; ++j) { const int n = (lane >> 3) + 8 * j; const LAS float* s = scr + (8 * c) * 33 + n;
        v4u o; o.x = pk2(s[0 * 33], s[1 * 33]); o.y = pk2(s[2 * 33], s[3 * 33]); o.z = pk2(s[4 * 33], s[5 * 33]); o.w = pk2(s[6 * 33], s[7 * 33]);
        *(v4u*)(WT + (size_t)(row_off + n0 + n) * K + k0 + 8 * c) = o; }
    asm volatile("s_waitcnt lgkmcnt(0)" ::: "memory");
}

#define XB_TMO      128
#define XB_XCNT(j)  (256  + 64 * (j))
#define XB_XSUB(j)  (1280 + 64 * (j))
#define XB_XGEN(j)  (2304 + 64 * (j))
#define XB_TOP      3328
#define XB_TOPGEN   3392
#define XCD_BAR_WORDS 3456
#define XB_SPIN_CAP (1u << 18)

__device__ __forceinline__ unsigned xb_ld(unsigned* p)              { return __hip_atomic_load(p, __ATOMIC_RELAXED, __HIP_MEMORY_SCOPE_AGENT); }
__device__ __forceinline__ unsigned xb_add(unsigned* p, unsigned v) { return __hip_atomic_fetch_add(p, v, __ATOMIC_RELAXED, __HIP_MEMORY_SCOPE_AGENT); }
__device__ __forceinline__ unsigned xb_xcc_id() { return (unsigned)__builtin_amdgcn_s_getreg((3 << 11) | 20) & 0xFu; }
#define XB_SPIN(cond, bar) do { unsigned _sp = 0; while (cond) { __builtin_amdgcn_s_sleep(1); \
    if ((++_sp & 255u) == 0u) { if (xb_ld(&(bar)[XB_TMO])) break; if (_sp > XB_SPIN_CAP) { atomicAdd(&(bar)[XB_TMO], 1u); break; } } } } while (0)

struct XcdBarrier {
    unsigned* bar; unsigned x;
    volatile LAS unsigned* st;
};

__device__ __forceinline__ XcdBarrier xcd_barrier_post(unsigned* bar, volatile LAS unsigned* st) {
    XcdBarrier b; b.bar = bar; b.x = xb_xcc_id(); b.st = st;
    if (threadIdx.x == 0) (void)xb_add(&bar[XB_XCNT(b.x)], 1u);
    return b;
}
__device__ __forceinline__ void xcd_barrier_complete(unsigned* bar, unsigned x, unsigned& nloc, unsigned& nx) {
    const unsigned G = gridDim.x * gridDim.y * gridDim.z;
    unsigned sum, cnt, mine, sp = 0u;
    for (;;) {
        sum = 0u; cnt = 0u; mine = 0u;
#pragma unroll
        for (unsigned j = 0; j < 16; ++j) { const unsigned c = xb_ld(&bar[XB_XCNT(j)]); sum += c; cnt += (c > 0u) ? 1u : 0u; mine = (j == x) ? c : mine; }
        if (sum == G) break;
        __builtin_amdgcn_s_sleep(1);
        if ((++sp & 255u) == 0u) { if (xb_ld(&bar[XB_TMO])) break; if (sp > XB_SPIN_CAP) { atomicAdd(&bar[XB_TMO], 1u); break; } }
    }
    nloc = mine > 0u ? mine : 1u; nx = cnt > 0u ? cnt : 1u;
}

__device__ __forceinline__ void xcd_barrier(const XcdBarrier& b) {
    asm volatile("s_waitcnt vmcnt(0)" ::: "memory");
    __syncthreads();
    if (threadIdx.x == 0) {
        unsigned* bar = b.bar;
        __builtin_amdgcn_s_waitcnt(0);
        unsigned nloc = b.st[0], nx = b.st[1];
        if (nloc == 0u) { xcd_barrier_complete(bar, b.x, nloc, nx); b.st[0] = nloc; b.st[1] = nx; }
        const unsigned old = xb_add(&bar[XB_XSUB(b.x)], 1u);
        const unsigned gen = old / nloc;
        if (old + 1u == (gen + 1u) * nloc) {
            __builtin_amdgcn_fence(__ATOMIC_RELEASE, "agent");
            asm volatile("s_waitcnt vmcnt(0)" ::: "memory");
            const unsigned og = xb_add(&bar[XB_TOP], 1u);
            const unsigned tg = og / nx;
            if (og + 1u == (tg + 1u) * nx) xb_add(&bar[XB_TOPGEN], 1u);
            else XB_SPIN(xb_ld(&bar[XB_TOPGEN]) == tg, bar);
            __builtin_amdgcn_fence(__ATOMIC_ACQUIRE, "agent");
            xb_add(&bar[XB_XGEN(b.x)], 1u);
            asm volatile("s_waitcnt vmcnt(0)" ::: "memory");
        } else {
            XB_SPIN(xb_ld(&bar[XB_XGEN(b.x)]) == gen, bar);
            __builtin_amdgcn_fence(__ATOMIC_ACQUIRE, "agent");
            asm volatile("s_waitcnt vmcnt(0)" ::: "memory");
        }
    }
    __syncthreads();
}

#ifndef REP_P0
#define REP_P0 1
#endif
#ifndef REP_P1
#define REP_P1 1
#endif
#ifndef REP_P2
#define REP_P2 1
#endif
#ifndef REP_P3
#define REP_P3 1
#endif
#ifndef REP_P4
#define REP_P4 1
#endif
#ifndef REP_P5
#define REP_P5 1
#endif
template <int W> __device__ __forceinline__ v4u pool_window(const bf16* up, int t) {
    v4u q[W];
#pragma unroll
    for (int j = 0; j < W; ++j) q[j] = *(const v4u*)(up - (size_t)((j <= t) ? j : 0) * 512);
    float acc[8];
#pragma unroll
    for (int e = 0; e < 8; ++e) acc[e] = 0.f;
#pragma unroll
    for (int j = 0; j < W; ++j) { const float wgt = (j <= t) ? 1.f : 0.f;
        acc[0] += wgt * pg8::bf_lo(q[j].x); acc[1] += wgt * pg8::bf_hi(q[j].x); acc[2] += wgt * pg8::bf_lo(q[j].y); acc[3] += wgt * pg8::bf_hi(q[j].y);
        acc[4] += wgt * pg8::bf_lo(q[j].z); acc[5] += wgt * pg8::bf_hi(q[j].z); acc[6] += wgt * pg8::bf_lo(q[j].w); acc[7] += wgt * pg8::bf_hi(q[j].w); }
    const float inv = 1.0f / (float)((t + 1 < W) ? (t + 1) : W);
    v4u o;
    o.x = pk2(acc[0] * inv - pg8::bf_lo(q[0].x), acc[1] * inv - pg8::bf_hi(q[0].x)); o.y = pk2(acc[2] * inv - pg8::bf_lo(q[0].y), acc[3] * inv - pg8::bf_hi(q[0].y));
    o.z = pk2(acc[4] * inv - pg8::bf_lo(q[0].z), acc[5] * inv - pg8::bf_hi(q[0].z)); o.w = pk2(acc[6] * inv - pg8::bf_lo(q[0].w), acc[7] * inv - pg8::bf_hi(q[0].w));
    return o;
}

struct Args {
    const float* x; const int* pos; const float* g_attn; const float* w_in; const float* lq1; const float* lk1; const float* lq2; const float* lk2;
    const float* subln_g; const float* w_pool; const float* pool_scale; const float* w_out; const float* g_mlp; const float* w_up; const float* w_down; const float* g_final;
    float* out; unsigned char* ws;
};

__global__ void __launch_bounds__(NWAVES * 64, 2) hybrid_fwd(Args a) {
    extern __shared__ __attribute__((aligned(16))) unsigned char lds_raw[];
    LAS unsigned char* lds = (LAS unsigned char*)lds_raw;
    cg::grid_group grid = cg::this_grid();
    if (threadIdx.x < 2) ((volatile LAS unsigned*)(lds + LDS_MISC_OFF))[threadIdx.x] = 0u;
    __syncthreads();
    const int G = gridDim.x, bx = blockIdx.x;
#define PHASE_IDS int tid = threadIdx.x; asm volatile("" : "+v"(tid)); const int lane = tid & 63, wave = __builtin_amdgcn_readfirstlane(tid >> 6); const int gw = vcu * NWAVES + wave, NGW = G * NWAVES; (void)lane; (void)gw; (void)NGW
    const int vcu = (G % 8 == 0) ? (bx % 8) * (G / 8) + bx / 8 : bx;
    unsigned char* ws = a.ws;
    bf16* Win_t = (bf16*)(ws + WS_WIN); bf16* Wout_t = (bf16*)(ws + WS_WOUT); bf16* Wup_t = (bf16*)(ws + WS_WUP); bf16* Wdown_t = (bf16*)(ws + WS_WDOWN); bf16* Wpool_t = (bf16*)(ws + WS_WPOOL);
    float* rope = (float*)(ws + WS_ROPE); float* ssq1 = (float*)(ws + WS_SSQ1); float* ssq2 = (float*)(ws + WS_SSQ2);
    bf16* XN = (bf16*)(ws + WS_XN); bf16* Qb = (bf16*)(ws + WS_Q); bf16* Kb = (bf16*)(ws + WS_K); bf16* Vb = (bf16*)(ws + WS_V);
    bf16* Ub = (bf16*)(ws + WS_U); bf16* Gb = (bf16*)(ws + WS_G); bf16* Dp = (bf16*)(ws + WS_DP); bf16* Zb = (bf16*)(ws + WS_Z); bf16* Mg = Kb; bf16* Ab = XN;

    for (int rep_ = 0; rep_ < REP_P0; ++rep_) {
        PHASE_IDS;
        LAS float* scr = (LAS float*)(lds + wave * 16384);
        constexpr int I_IN = (D / 64) * (INW / 32), I_OUT = (D / 64) * (D / 32), I_UP = (D / 64) * (FF / 32), I_DOWN = (FF / 64) * (D / 32), I_POOL1 = (128 / 64) * (256 / 32);
        constexpr int NITEMS = I_IN + I_OUT + I_UP + I_DOWN + 4 * I_POOL1;
        for (int it = gw; it < NITEMS; it += NGW) {
            int r = it;
            if (r < I_IN) { p0_transpose_item<true>(a.w_in, D, INW, Win_t, 0, nullptr, scr, r, lane); continue; } r -= I_IN;
            if (r < I_OUT) { p0_transpose_item(a.w_out, D, D, Wout_t, 0, nullptr, scr, r, lane); continue; } r -= I_OUT;
            if (r < I_UP) { p0_transpose_item(a.w_up, D, FF, Wup_t, 0, a.g_mlp, scr, r, lane); continue; } r -= I_UP;
            if (r < I_DOWN) { p0_transpose_item(a.w_down, FF, D, Wdown_t, 0, nullptr, scr, r, lane); continue; } r -= I_DOWN;
            { const int g = r / I_POOL1; p0_transpose_item(a.w_pool + (size_t)g * 128 * 256, 128, 256, Wpool_t, g * 256, nullptr, scr, r % I_POOL1, lane); }
        }
        for (int e = bx * (NWAVES * 64) + tid; e < M * 8; e += G * NWAVES * 64) {
            const int row = e >> 3, i = e & 7;
            const float invf = (i == 0) ? 1.0f : (i == 1) ? 0.19392274474868576f : (i == 2) ? 0.03760603093086393f : (i == 3) ? 0.007292664737217109f :
                               (i == 4) ? 0.001414213562373095f : (i == 5) ? 0.0002742481756762073f : (i == 6) ? 5.318295896944988e-05f : 1.031338537721246e-05f;
            const float ang = (float)a.pos[row] * invf;
            double rev = (double)ang * 0.15915494309189535; rev -= __builtin_rint(rev);
            const float rf = (float)rev;
            rope[(size_t)e * 2] = __builtin_amdgcn_cosf(rf); rope[(size_t)e * 2 + 1] = __builtin_amdgcn_sinf(rf);
        }
        {
            const f32x4* gr = (const f32x4*)a.g_attn + lane; f32x4 gg[4];
#pragma unroll
            for (int j = 0; j < 4; ++j) gg[j] = gr[64 * j];
            for (int m0 = gw * 4; m0 < M; m0 += NGW * 4) {
                f32x4 v[4][4]; float s2[4];
#pragma unroll
                for (int q = 0; q < 4; ++q) { const f32x4* xr = (const f32x4*)(a.x + (size_t)(m0 + q) * D) + lane;
#pragma unroll
                    for (int j = 0; j < 4; ++j) v[q][j] = __builtin_nontemporal_load(xr + 64 * j); }
#pragma unroll
                for (int q = 0; q < 4; ++q) { s2[q] = 0.f;
#pragma unroll
                    for (int j = 0; j < 4; ++j) s2[q] += (v[q][j].x * v[q][j].x + v[q][j].y * v[q][j].y) + (v[q][j].z * v[q][j].z + v[q][j].w * v[q][j].w); }
#pragma unroll
                for (int q = 0; q < 4; ++q) { const float rstd = __builtin_amdgcn_rsqf(wave_sum(s2[q]) * (1.f / D) + RMS_EPS);
                    unsigned long long* o8 = (unsigned long long*)(XN + (size_t)(m0 + q) * D) + lane;
#pragma unroll
                    for (int j = 0; j < 4; ++j) { const f32x4 y = v[q][j] * rstd * gg[j];
                        o8[64 * j] = (unsigned long long)pk2(y.x, y.y) | ((unsigned long long)pk2(y.z, y.w) << 32); } }
            }
        }
    if (bx == 0) { for (int i = threadIdx.x; i < (int)(BAR_ZERO_BYTES / 4); i += NWAVES * 64) ((unsigned*)(a.ws + WS_BAR))[i] = 0u; }
    grid.sync(); }
    unsigned seam_no = 0, seam2_no = 0, xc_nloc = 1, xc_ngroups = 1;
    const unsigned xcc = (unsigned)__builtin_amdgcn_s_getreg((3 << 11) | 20) & 0xFu;
    if (threadIdx.x == 0) __hip_atomic_fetch_add((unsigned*)(a.ws + WS_BAR) + 64 * (80 + xcc), 1u, __ATOMIC_RELAXED, __HIP_MEMORY_SCOPE_AGENT);
#define SEAM2() do { ++seam2_no; asm volatile("s_waitcnt vmcnt(0)" ::: "memory"); __syncthreads(); \
        if (threadIdx.x == 0) { unsigned* w_ = (unsigned*)(a.ws + WS_BAR); \
            const unsigned old_ = __hip_atomic_fetch_add(w_ + 64 * (32 + xcc), 1u, __ATOMIC_RELAXED, __HIP_MEMORY_SCOPE_AGENT); \
            if (old_ + 1u == seam2_no * xc_nloc) { \
                __builtin_amdgcn_fence(__ATOMIC_RELEASE, "agent"); asm volatile("s_waitcnt vmcnt(0)" ::: "memory"); \
                __hip_atomic_fetch_add(w_ + 64 * 64, 1u, __ATOMIC_RELAXED, __HIP_MEMORY_SCOPE_AGENT); \
                while (__hip_atomic_load(w_ + 64 * 64, __ATOMIC_RELAXED, __HIP_MEMORY_SCOPE_AGENT) < seam2_no * xc_ngroups) __builtin_amdgcn_s_sleep(1); \
                __hip_atomic_store(w_ + 64 * (48 + xcc), seam2_no, __ATOMIC_RELAXED, __HIP_MEMORY_SCOPE_AGENT); \
            } else { while (__hip_atomic_load(w_ + 64 * (48 + xcc), __ATOMIC_RELAXED, __HIP_MEMORY_SCOPE_AGENT) < seam2_no) __builtin_amdgcn_s_sleep(1); } \
            __builtin_amdgcn_fence(__ATOMIC_ACQUIRE, "agent"); asm volatile("s_waitcnt vmcnt(0)" ::: "memory"); } \
        __syncthreads(); } while (0)
#define SEAM() do { ++seam_no; asm volatile("s_waitcnt vmcnt(0)" ::: "memory"); __syncthreads(); \
        if (threadIdx.x == 0) { unsigned* w_ = (unsigned*)(a.ws + WS_BAR); const unsigned g_ = (unsigned)bx & 7u, ng_ = ((unsigned)G - g_ + 7u) / 8u, ngroups_ = (unsigned)G < 8u ? (unsigned)G : 8u; \
            __builtin_amdgcn_fence(__ATOMIC_RELEASE, "agent"); asm volatile("s_waitcnt vmcnt(0)" ::: "memory");     \
            const unsigned old_ = __hip_atomic_fetch_add(w_ + 64 * g_, 1u, __ATOMIC_RELAXED, __HIP_MEMORY_SCOPE_AGENT); \
            if (old_ + 1u == seam_no * ng_) { \
                __hip_atomic_fetch_add(w_ + 64 * 16, 1u, __ATOMIC_RELAXED, __HIP_MEMORY_SCOPE_AGENT); \
                while (__hip_atomic_load(w_ + 64 * 16, __ATOMIC_RELAXED, __HIP_MEMORY_SCOPE_AGENT) < seam_no * ngroups_) __builtin_amdgcn_s_sleep(1); \
                __hip_atomic_store(w_ + 64 * (8 + g_), seam_no, __ATOMIC_RELAXED, __HIP_MEMORY_SCOPE_AGENT); \
            } else { while (__hip_atomic_load(w_ + 64 * (8 + g_), __ATOMIC_RELAXED, __HIP_MEMORY_SCOPE_AGENT) < seam_no) __builtin_amdgcn_s_sleep(1); } \
            __builtin_amdgcn_fence(__ATOMIC_ACQUIRE, "agent"); asm volatile("s_waitcnt vmcnt(0)" ::: "memory"); } \
        __syncthreads(); } while (0)

    for (int rep_ = 0; rep_ < REP_P1; ++rep_) {
        pg8::Gemm g{XN, Win_t, M, INW, D, 0}; pg8::StaticOrder S; S.init(M, INW, G, bx);
        pg8::EpiIn E{Qb, Kb, Vb, Ub, Gb, rope};
        pg8::gemm_phase<pg8::EpiIn, pg8::StaticOrder, true, true>(lds, g, S, E);
    SEAM(); }
    if (threadIdx.x == 0) { unsigned ng_ = 0u;
        for (unsigned j = 0; j < 16u; ++j) { const unsigned c_ = __hip_atomic_load((unsigned*)(a.ws + WS_BAR) + 64 * (80 + j), __ATOMIC_RELAXED, __HIP_MEMORY_SCOPE_AGENT); ng_ += (c_ != 0u); if (j == xcc) xc_nloc = c_; }
        xc_ngroups = ng_; }


    for (int rep_ = 0; rep_ < REP_P2; ++rep_) {
        PHASE_IDS;
        for (int wi = gw; wi < M; wi += NGW) {
            const int rq = wi >> 2, gp = ((wi & 3) + (wi >> 11)) & 3;
            const int row = 4 * rq + (lane >> 4), t = row & (SEQ - 1);
            const bf16* up = Ub + (size_t)row * 512 + gp * 128 + (lane & 15) * 8;
            v4u o;
            if (gp == 0) o = pool_window<2>(up, t); else if (gp == 1) o = pool_window<4>(up, t); else if (gp == 2) o = pool_window<8>(up, t); else o = pool_window<16>(up, t);
            *(v4u*)(Dp + ((size_t)gp * M + row) * 128 + (lane & 15) * 8) = o;
        }
        const float sa = wave_sum(a.lq1[lane] * a.lk1[lane]), sb = wave_sum(a.lq2[lane] * a.lk2[lane]);
        const float lam = expf(sa) - expf(sb) + 0.2f;
        for (int pu = vcu; pu < BATCH * NH * 8; pu += G) {
            const int bh = pu >> 3, s = pu & 7, b = bh >> 3, head = bh & 7;
            for (int k = 0; k < 2; ++k) att::attn_unit(lds, Qb, Kb, Vb, Ab, b, head, k ? s : 15 - s, lam, a.subln_g);
        }
    SEAM2(); }

    for (int rep_ = 0; rep_ < REP_P3; ++rep_) {
        pg8::Gemm g{Dp, Wpool_t, M, D, 128, (size_t)M * 128 * 2}; pg8::StaticOrder S; S.init(M, D, G, bx);
        pg8::EpiMerge E{Ab, Gb, a.pool_scale, Mg};
        pg8::gemm_phase<pg8::EpiMerge, pg8::StaticOrder, true, true>(lds, g, S, E);
    SEAM2(); }

    for (int rep_ = 0; rep_ < REP_P4; ++rep_) {
        pg8::Gemm g{Mg, Wout_t, M, D, D, 0}; pg8::StaticOrder S; S.init(M, D, G, bx);
        pg8::EpiResA E{a.x, XN, ssq1};
        pg8::gemm_phase<pg8::EpiResA, pg8::StaticOrder, true, true>(lds, g, S, E);
    SEAM2(); }

    for (int rep_ = 0; rep_ < REP_P5; ++rep_) {
        pg8::Gemm g{XN, Wup_t, M, FF, D, 0}; pg8::StaticOrder S; S.init(M, FF, G, bx);
        pg8::EpiUp E{ssq1, Zb};
        pg8::gemm_phase<pg8::EpiUp, pg8::StaticOrder, true, true>(lds, g, S, E);
    SEAM2(); }

    {
        pg8::Gemm g{Zb, Wdown_t, M, D, FF, 0}; pg8::StaticOrder S; S.init(M, D, G, bx);
        pg8::EpiResB E{XN, ssq2};
        pg8::gemm_phase<pg8::EpiResB, pg8::StaticOrder, true, true>(lds, g, S, E);
    }
    SEAM2();

    { PHASE_IDS;
    const f32x4* gr = (const f32x4*)a.g_final + lane; f32x4 gg[4];
#pragma unroll
    for (int j = 0; j < 4; ++j) gg[j] = gr[64 * j];
    for (int m0 = gw * 4; m0 < M; m0 += NGW * 4) {
        unsigned long long v[4][4]; float s[4];
#pragma unroll
        for (int q = 0; q < 4; ++q) { const unsigned long long* xr = (const unsigned long long*)(XN + (size_t)(m0 + q) * D) + lane; s[q] = ssq2[(size_t)(m0 + q) * 16 + (lane & 15)];
#pragma unroll
            for (int j = 0; j < 4; ++j) v[q][j] = __builtin_nontemporal_load(xr + 64 * j); }
#pragma unroll
        for (int q = 0; q < 4; ++q) { float t = s[q]; t += xor_swz<1>(t); t += xor_swz<2>(t); t += xor_swz<4>(t); t += xor_swz<8>(t);
            const float rstd = __builtin_amdgcn_rsqf(t * (1.f / D) + RMS_EPS);
            f32x4* xr = (f32x4*)(a.out + (size_t)(m0 + q) * D) + lane;
#pragma unroll
            for (int j = 0; j < 4; ++j) { const unsigned lo = (unsigned)v[q][j], hi = (unsigned)(v[q][j] >> 32);
                const f32x4 x = (f32x4){pg8::bf_lo(lo), pg8::bf_hi(lo), pg8::bf_lo(hi), pg8::bf_hi(hi)};
                __builtin_nontemporal_store(x * rstd * gg[j], xr + 64 * j); } }
    } }
}

extern "C" void kernel_launch(void* const* d_in, const int* in_sizes, int n_in, void* d_out, int out_size, void* d_ws, size_t ws_size, hipStream_t stream) {
    static int grid = 0;
    if (grid == 0) {
        if (n_in != 16 || in_sizes[0] != M * D || out_size != M * D || ws_size < WS_END) { fprintf(stderr, "kernel_launch: unexpected shapes (n_in %d, in0 %d, out %d, ws %zu); nothing launched\n", n_in, n_in > 0 ? in_sizes[0] : -1, out_size, ws_size); grid = -1; return; }
        int dev = 0, cus = 0, per_cu = 0;
        if (hipGetDevice(&dev) != hipSuccess || hipDeviceGetAttribute(&cus, hipDeviceAttributeMultiprocessorCount, dev) != hipSuccess) { grid = -1; return; }
        if (hipFuncSetAttribute((const void*)hybrid_fwd, hipFuncAttributeMaxDynamicSharedMemorySize, LDS_BYTES) != hipSuccess) { fprintf(stderr, "kernel_launch: hipFuncSetAttribute failed\n"); grid = -1; return; }
        if (hipOccupancyMaxActiveBlocksPerMultiprocessor(&per_cu, (const void*)hybrid_fwd, NWAVES * 64, LDS_BYTES) != hipSuccess || per_cu < 1) per_cu = 1;
        (void)hipGetLastError();
        grid = cus * per_cu;
    }
    if (grid < 0) return;
    Args a{};
    a.x = (const float*)d_in[0]; a.pos = (const int*)d_in[1]; a.g_attn = (const float*)d_in[2]; a.w_in = (const float*)d_in[3];
    a.lq1 = (const float*)d_in[4]; a.lk1 = (const float*)d_in[5]; a.lq2 = (const float*)d_in[6]; a.lk2 = (const float*)d_in[7];
    a.subln_g = (const float*)d_in[8]; a.w_pool = (const float*)d_in[9]; a.pool_scale = (const float*)d_in[10]; a.w_out = (const float*)d_in[11];
    a.g_mlp = (const float*)d_in[12]; a.w_up = (const float*)d_in[13]; a.w_down = (const float*)d_in[14]; a.g_final = (const float*)d_in[15];
    a.out = (float*)d_out; a.ws = (unsigned char*)d_ws;
    void* args[] = {&a};
    const hipError_t e = hipLaunchCooperativeKernel((const void*)hybrid_fwd, dim3(grid), dim3(NWAVES * 64), args, LDS_BYTES, stream);
    if (e != hipSuccess) fprintf(stderr, "kernel_launch: cooperative launch failed: %s (grid %d)\n", hipGetErrorString(e), grid);
}
```

```cpp
#include <hip/hip_runtime.h>
#include <hip/hip_cooperative_groups.h>
#include <cstdio>
#include <cstdint>
#include <cmath>
namespace cg = cooperative_groups;
template <int K> __device__ __forceinline__ float xor_swz(float v) { return __int_as_float(__builtin_amdgcn_ds_swizzle(__float_as_int(v), (K << 10) | 0x1f)); }
__device__ __forceinline__ float half_sum(float v) { auto rr = __builtin_amdgcn_permlane32_swap(__float_as_uint(v), __float_as_uint(v), false, false); return __uint_as_float(rr[0]) + __uint_as_float(rr[1]); }
__device__ __forceinline__ float half_max(float v) { auto rr = __builtin_amdgcn_permlane32_swap(__float_as_uint(v), __float_as_uint(v), false, false); return fmaxf(__uint_as_float(rr[0]), __uint_as_float(rr[1])); }
namespace pg8 {
#define PG8_LAS __attribute__((address_space(3)))
typedef unsigned short bf16_t;
typedef short bf16x8 __attribute__((ext_vector_type(8)));
typedef float f32x4 __attribute__((ext_vector_type(4)));
typedef unsigned u32x4 __attribute__((ext_vector_type(4)));
constexpr int BM = 256, BK = 64, HALF = 128, HTB = HALF * BK * 2  , STAGE_BYTES = 8 * HTB, NXCD = 8, WGM = 8;

__host__ __device__ __forceinline__ int lds_byte(int r, int c) { const int st = (r >> 4) * 2 + (c >> 5), rr = r & 15, cc = c & 31, ob = rr * 64 + cc * 2; return st * 1024 + (ob ^ (((ob >> 9) & 1) << 5)); }
__host__ __device__ __forceinline__ void stage_rc(int b, int& R, int& C) { const int st = b / 1024, sb = b % 1024, swz = sb ^ (((sb >> 9) & 1) << 5); R = (st >> 1) * 16 + swz / 64; C = (st & 1) * 32 + (swz % 64) / 2; }
__host__ __device__ __forceinline__ int perm32(int rho) { const int n = rho >> 4, i = rho & 15; return 8 * (i >> 2) + 4 * n + (i & 3); }

struct Unit { int pm, pn; };
struct Gemm { const bf16_t* A; const bf16_t* Bt; int M, N, K; size_t a_pn_off; };

struct StaticOrder {
    int nM, nN, nwg, G, c;
    __host__ __device__ void init(int M, int N, int G_, int c_) { nM = M / BM; nN = N / BM; nwg = nM * nN; G = G_; c = c_; }
    __host__ __device__ bool next(int i, Unit& u) const {
        const long L = (long)i * G + c; if (L >= nwg) return false;
        int wgid = (int)L; { const int q = nwg / NXCD, r = nwg % NXCD, xcd = wgid % NXCD, off = wgid / NXCD; wgid = (xcd < r ? xcd * (q + 1) : r * (q + 1) + (xcd - r) * q) + off; }
        const int nig = WGM * nN, gid = wgid / nig, fm = gid * WGM, gsz = (nM - fm) < WGM ? (nM - fm) : WGM;
        u.pm = fm + ((wgid % nig) % gsz); u.pn = (wgid % nig) / gsz; return true;
    }
    __device__ __forceinline__ void a_ready(const Unit&) const {}
    __device__ __forceinline__ void done(const Unit&) const {}
};

__device__ __forceinline__ unsigned cvt_pk_bf16(float lo, float hi) { unsigned r; asm volatile("v_cvt_pk_bf16_f32 %0, %1, %2" : "=v"(r) : "v"(lo), "v"(hi)); return r; }
typedef float f32x2 __attribute__((ext_vector_type(2)));
template <class Epi, class Sched, bool ALIGN_EPI = false, bool SP2 = false>
__device__ __forceinline__ void gemm_phase(PG8_LAS unsigned char* lds, const Gemm g, const Sched& S, const Epi& E) {
    int tid = threadIdx.x; asm volatile("" : "+v"(tid));
    const int wid = __builtin_amdgcn_readfirstlane(tid >> 6), lane = tid & 63, wr = wid >> 2, wc = wid & 3, fr = lane & 15, fq = lane >> 4;
    const int K = g.K, nt = K / BK;
    unsigned voffA[2], voffB[2];
#pragma unroll
    for (int i = 0; i < 2; ++i) { int R, C; stage_rc(tid * 16 + i * 8192, R, C); const int Rb = Epi::PERM ? ((R & ~31) + perm32(R & 31)) : R;
        voffA[i] = (unsigned)(R * K + C) * 2u; voffB[i] = (unsigned)(Rb * K + C) * 2u; }
    const size_t kstep = (size_t)(BK * 2);
    const size_t hstep = (size_t)HALF * K * 2;
    const size_t tstep = 2 * hstep;
    const unsigned ldsw = (unsigned)wid * 1024u;
    const int aoff = lds_byte(wr * 64 + fr, fq * 8), boff = lds_byte(wc * 32 + fr, fq * 8);
#define PG8_SA(b, h) (((b) * 2 + (h)) * HTB)
#define PG8_SB(b, h) ((4 + (b) * 2 + (h)) * HTB)
#define PG8_STAGE(bufoff, gbase, voff) do { _Pragma("unroll") for (int _i = 0; _i < 2; ++_i) \
        __builtin_amdgcn_global_load_lds((const unsigned*)((const char*)(gbase) + (voff)[_i]), (PG8_LAS unsigned*)(lds + (bufoff) + ldsw + _i * 8192), 16, 0, 0); } while (0)
#define PG8_LDA(dst, b, h) do { _Pragma("unroll") for (int m = 0; m < 4; ++m) _Pragma("unroll") for (int k = 0; k < 2; ++k) dst[m][k] = *(const PG8_LAS bf16x8*)(lds + PG8_SA(b, h) + aoff + m * 2048 + k * 1024); } while (0)
#define PG8_LDB(dst, b, h) do { _Pragma("unroll") for (int n = 0; n < 2; ++n) _Pragma("unroll") for (int k = 0; k < 2; ++k) dst[n][k] = *(const PG8_LAS bf16x8*)(lds + PG8_SB(b, h) + boff + n * 2048 + k * 1024); } while (0)
#define PG8_MMA(ai, bj, At, Bt) do { __builtin_amdgcn_s_setprio(1); _Pragma("unroll") for (int m = 0; m < 4; ++m) _Pragma("unroll") for (int n = 0; n < 2; ++n) _Pragma("unroll") for (int k = 0; k < 2; ++k) \
        acc[ai][bj][m][n] = __builtin_amdgcn_mfma_f32_16x16x32_bf16(Bt[n][k], At[m][k], acc[ai][bj][m][n], 0, 0, 0); __builtin_amdgcn_s_setprio(0); } while (0)
#define PG8_WAIT_V(n) asm volatile("s_waitcnt vmcnt(" #n ")" ::: "memory")
#define PG8_WAIT_L(n) asm volatile("s_waitcnt lgkmcnt(" #n ")" ::: "memory")
#define PG8_BAR __builtin_amdgcn_s_barrier()
#define PG8_SCHED __builtin_amdgcn_sched_barrier(0)
    Unit cur, nxt; int ui = 0;
    if (!S.next(0, cur)) return;
    f32x4 acc[2][2][4][2];
#pragma unroll
    for (int a = 0; a < 2; ++a)
#pragma unroll
        for (int b = 0; b < 2; ++b)
#pragma unroll
            for (int m = 0; m < 4; ++m)
#pragma unroll
                for (int n = 0; n < 2; ++n) acc[a][b][m][n] = (f32x4){0.f, 0.f, 0.f, 0.f};
    bf16x8 At[4][2], B0[2][2], B1[2][2];
    const char* cA = (const char*)g.A + (size_t)cur.pm * tstep + (size_t)cur.pn * g.a_pn_off; const char* cB = (const char*)g.Bt + (size_t)cur.pn * tstep;
    S.a_ready(cur);
    if constexpr (SP2) {
        PG8_STAGE(PG8_SB(0, 0), cB, voffB); PG8_STAGE(PG8_SB(0, 1), cB + hstep, voffB); PG8_STAGE(PG8_SA(0, 0), cA, voffA); PG8_STAGE(PG8_SA(0, 1), cA + hstep, voffA);
        if (wr == 1) PG8_BAR;
        PG8_WAIT_V(2); PG8_BAR;
        PG8_STAGE(PG8_SB(1, 0), cB + kstep, voffB); PG8_STAGE(PG8_SA(1, 0), cA + kstep, voffA); PG8_STAGE(PG8_SB(1, 1), cB + hstep + kstep, voffB);
        PG8_WAIT_V(6); PG8_BAR;
    } else {
        PG8_STAGE(PG8_SB(0, 0), cB, voffB); PG8_STAGE(PG8_SA(0, 0), cA, voffA); PG8_STAGE(PG8_SB(0, 1), cB + hstep, voffB); PG8_STAGE(PG8_SA(0, 1), cA + hstep, voffA);
        if (wr == 1) PG8_BAR;
        PG8_WAIT_V(4); PG8_BAR;
        PG8_STAGE(PG8_SB(1, 0), cB + kstep, voffB); PG8_STAGE(PG8_SA(1, 0), cA + kstep, voffA); PG8_STAGE(PG8_SB(1, 1), cB + hstep + kstep, voffB);
        PG8_WAIT_V(6); PG8_BAR;
    }
    for (;;) {
        const bool has_next = S.next(ui + 1, nxt);
        const char* nA = has_next ? (const char*)g.A + (size_t)nxt.pm * tstep + (size_t)nxt.pn * g.a_pn_off : cA; const char* nB = has_next ? (const char*)g.Bt + (size_t)nxt.pn * tstep : cB;
        for (int t = 0; t < nt; t += 2) {
            const bool last = (t == nt - 2);
            const char* a1 = cA + (size_t)(t + 1) * kstep;
            const char* a2 = last ? nA : cA + (size_t)(t + 2) * kstep; const char* b2 = last ? nB : cB + (size_t)(t + 2) * kstep;
            const char* a3 = a2 + kstep; const char* b3 = b2 + kstep;
            if (last && has_next) S.a_ready(nxt);
            if constexpr (SP2) {
            PG8_LDB(B0, 0, 0); PG8_LDB(B1, 0, 1); PG8_SCHED; PG8_LDA(At, 0, 0); PG8_STAGE(PG8_SA(1, 1), a1 + hstep, voffA);
            PG8_WAIT_V(8); PG8_WAIT_L(0); PG8_BAR; PG8_MMA(0, 0, At, B0); PG8_MMA(0, 1, At, B1); PG8_BAR; PG8_SCHED;
            PG8_LDA(At, 0, 1); PG8_STAGE(PG8_SB(0, 0), b2, voffB); PG8_STAGE(PG8_SB(0, 1), b2 + hstep, voffB); PG8_STAGE(PG8_SA(0, 0), a2, voffA);
            PG8_WAIT_V(8); PG8_WAIT_L(0); PG8_BAR; PG8_MMA(1, 0, At, B0); PG8_MMA(1, 1, At, B1); PG8_BAR; PG8_SCHED;
            PG8_LDB(B0, 1, 0); PG8_LDB(B1, 1, 1); PG8_SCHED; PG8_LDA(At, 1, 0); PG8_STAGE(PG8_SA(0, 1), a2 + hstep, voffA);
            PG8_WAIT_V(8); PG8_WAIT_L(0); PG8_BAR; PG8_MMA(0, 0, At, B0); PG8_MMA(0, 1, At, B1); PG8_BAR; PG8_SCHED;
            PG8_LDA(At, 1, 1); PG8_STAGE(PG8_SB(1, 0), b3, voffB); PG8_STAGE(PG8_SB(1, 1), b3 + hstep, voffB); PG8_STAGE(PG8_SA(1, 0), a3, voffA);
            PG8_WAIT_V(8); PG8_WAIT_L(0); PG8_BAR; PG8_MMA(1, 0, At, B0); PG8_MMA(1, 1, At, B1); PG8_BAR; PG8_SCHED;
            } else {
            PG8_LDB(B0, 0, 0); PG8_SCHED; PG8_LDA(At, 0, 0); PG8_STAGE(PG8_SA(1, 1), a1 + hstep, voffA);
            PG8_WAIT_L(8); PG8_BAR; PG8_WAIT_L(0); PG8_MMA(0, 0, At, B0); PG8_BAR; PG8_SCHED;
            PG8_LDB(B1, 0, 1); PG8_STAGE(PG8_SB(0, 0), b2, voffB);
            PG8_BAR; PG8_WAIT_L(0); PG8_MMA(0, 1, At, B1); PG8_BAR;
            PG8_LDA(At, 0, 1); PG8_STAGE(PG8_SA(0, 0), a2, voffA);
            PG8_BAR; PG8_WAIT_L(0); PG8_MMA(1, 0, At, B0); PG8_BAR; PG8_SCHED;
            PG8_STAGE(PG8_SB(0, 1), b2 + hstep, voffB);
            PG8_WAIT_V(6); PG8_BAR; PG8_MMA(1, 1, At, B1); PG8_BAR;
            PG8_LDB(B0, 1, 0); PG8_SCHED; PG8_LDA(At, 1, 0); PG8_STAGE(PG8_SA(0, 1), a2 + hstep, voffA);
            PG8_WAIT_L(8); PG8_BAR; PG8_WAIT_L(0); PG8_MMA(0, 0, At, B0); PG8_BAR; PG8_SCHED;
            PG8_LDB(B1, 1, 1); PG8_STAGE(PG8_SB(1, 0), b3, voffB);
            PG8_BAR; PG8_WAIT_L(0); PG8_MMA(0, 1, At, B1); PG8_BAR;
            PG8_LDA(At, 1, 1); PG8_STAGE(PG8_SA(1, 0), a3, voffA);
            PG8_BAR; PG8_WAIT_L(0); PG8_MMA(1, 0, At, B0); PG8_BAR; PG8_SCHED;
            PG8_STAGE(PG8_SB(1, 1), b3 + hstep, voffB);
            PG8_WAIT_V(6); PG8_BAR; PG8_MMA(1, 1, At, B1); PG8_BAR;
            }
        }
        if constexpr (ALIGN_EPI) { if (wr == 0) PG8_BAR; }
        if constexpr (!Epi::AFTER_DRAIN) { E(acc, cur, wr, wc, fr, fq); S.done(cur); }
        if (!has_next) break;
#pragma unroll
        for (int a = 0; a < 2; ++a)
#pragma unroll
            for (int b = 0; b < 2; ++b)
#pragma unroll
                for (int m = 0; m < 4; ++m)
#pragma unroll
                    for (int n = 0; n < 2; ++n) acc[a][b][m][n] = (f32x4){0.f, 0.f, 0.f, 0.f};
        cur = nxt; cA = nA; cB = nB; ++ui;
        if constexpr (ALIGN_EPI) { if (wr == 1) PG8_BAR; }
    }
    PG8_WAIT_V(0);
    if constexpr (!ALIGN_EPI) { if (wr == 0) PG8_BAR; }
    PG8_BAR;
    if constexpr (Epi::AFTER_DRAIN) { E.fused(acc, cur, wr, wc, fr, fq, lds, wid, lane); S.done(cur); }
#undef PG8_SA
#undef PG8_SB
#undef PG8_STAGE
#undef PG8_LDA
#undef PG8_LDB
#undef PG8_MMA
#undef PG8_WAIT_V
#undef PG8_WAIT_L
#undef PG8_BAR
#undef PG8_SCHED
}
}
namespace pg8 {
typedef unsigned u32x2 __attribute__((ext_vector_type(2)));
__device__ __forceinline__ float bf_lo(unsigned w) { return __uint_as_float(w << 16); }
__device__ __forceinline__ float bf_hi(unsigned w) { return __uint_as_float(w & 0xffff0000u); }
__device__ __forceinline__ u32x4 pack8(const f32x4 a, const f32x4 b) { u32x4 w; w.x = cvt_pk_bf16(a[0], a[1]); w.y = cvt_pk_bf16(a[2], a[3]); w.z = cvt_pk_bf16(b[0], b[1]); w.w = cvt_pk_bf16(b[2], b[3]); return w; }
constexpr float QSCALE = 0.125f * 1.4426950408889634f;

struct EpiIn {
    static constexpr bool PERM = true, AFTER_DRAIN = false;
    bf16_t *Q, *K, *V, *U, *G; const float* rope;
    __device__ __forceinline__ void operator()(const f32x4 (&acc)[2][2][4][2], const Unit& u, int wr, int wc, int fr, int fq) const {
        const int pn = u.pn; int kind, ldc, colt; bf16_t* base;
        if (pn < 4)       { kind = 0; base = Q; ldc = 1024; colt = pn * 256; }
        else if (pn < 8)  { kind = 1; base = K; ldc = 1024; colt = (pn - 4) * 256; }
        else if (pn < 12) { kind = 2; base = V; ldc = 1024; colt = (pn - 8) * 256; }
        else if (pn < 14) { kind = 2; base = U; ldc = 512;  colt = (pn - 12) * 256; }
        else              { kind = 3; base = G; ldc = 2048; colt = (pn - 14) * 256; }
        const int row0 = u.pm * BM + wr * 64 + fr, col0 = colt + wc * 32 + 8 * fq;
        const bool rl = ((wc & 1) == 0) && (fq < 2);
#pragma unroll
        for (int ai = 0; ai < 2; ++ai)
#pragma unroll
            for (int m = 0; m < 4; ++m) {
                const int row = row0 + ai * HALF + m * 16;
                bf16_t* rowp = base + (size_t)row * ldc + col0;
                if (kind <= 1) {
                    f32x4 c0, c1;
                    if (rl) { const f32x4* rp = (const f32x4*)(rope + (size_t)row * 16 + 8 * fq); c0 = rp[0]; c1 = rp[1]; }
#pragma unroll
                    for (int bj = 0; bj < 2; ++bj) {
                        f32x4 v0 = acc[ai][bj][m][0], v1 = acc[ai][bj][m][1];
                        if (rl) {
                            const float a0 = v0[0], b0 = v0[1], a1 = v0[2], b1 = v0[3], a2 = v1[0], b2 = v1[1], a3 = v1[2], b3 = v1[3];
                            v0[0] = a0 * c0[0] - b0 * c0[1]; v0[1] = b0 * c0[0] + a0 * c0[1]; v0[2] = a1 * c0[2] - b1 * c0[3]; v0[3] = b1 * c0[2] + a1 * c0[3];
                            v1[0] = a2 * c1[0] - b2 * c1[1]; v1[1] = b2 * c1[0] + a2 * c1[1]; v1[2] = a3 * c1[2] - b3 * c1[3]; v1[3] = b3 * c1[2] + a3 * c1[3];
                        }
                        if (kind == 0) { v0 = v0 * QSCALE; v1 = v1 * QSCALE; }
                        __builtin_nontemporal_store(pack8(v0, v1), (u32x4*)(rowp + bj * HALF));
                    }
                } else {
#pragma unroll
                    for (int bj = 0; bj < 2; ++bj) {
                        f32x4 v0 = acc[ai][bj][m][0], v1 = acc[ai][bj][m][1];
                        if (kind == 3) {
#pragma unroll
                            for (int e = 0; e < 4; ++e) { v0[e] = __builtin_amdgcn_rcpf(1.f + __builtin_amdgcn_exp2f(v0[e])); v1[e] = __builtin_amdgcn_rcpf(1.f + __builtin_amdgcn_exp2f(v1[e])); }
                        }
                        __builtin_nontemporal_store(pack8(v0, v1), (u32x4*)(rowp + bj * HALF));
                    }
                }
            }
    }
};

struct EpiMerge {
    static constexpr bool PERM = true, AFTER_DRAIN = false;
    const bf16_t* A; const bf16_t* G; const float* pscale; bf16_t* Mg;
    __device__ __forceinline__ void operator()(const f32x4 (&acc)[2][2][4][2], const Unit& u, int wr, int wc, int fr, int fq) const {
        const int row0 = u.pm * BM + wr * 64 + fr, col0 = u.pn * BM + wc * 32 + 8 * fq;
        f32x4 ps[2][2];
#pragma unroll
        for (int bj = 0; bj < 2; ++bj) { ps[bj][0] = *(const f32x4*)(pscale + col0 + bj * HALF); ps[bj][1] = *(const f32x4*)(pscale + col0 + bj * HALF + 4); }
#pragma unroll
        for (int ai = 0; ai < 2; ++ai)
#pragma unroll
            for (int m = 0; m < 4; ++m) {
                const size_t row = (size_t)(row0 + ai * HALF + m * 16);
#pragma unroll
                for (int bj = 0; bj < 2; ++bj) {
                    const int c = col0 + bj * HALF;
                    const u32x4 a8 = __builtin_nontemporal_load((const u32x4*)(A + row * 1024 + c)), ga = __builtin_nontemporal_load((const u32x4*)(G + row * 2048 + c)), gp = __builtin_nontemporal_load((const u32x4*)(G + row * 2048 + 1024 + c));
                    const f32x4 y0 = acc[ai][bj][m][0] * ps[bj][0], y1 = acc[ai][bj][m][1] * ps[bj][1];
                    f32x4 o0, o1;
                    o0[0] = bf_lo(ga.x) * bf_lo(a8.x) + bf_lo(gp.x) * y0[0]; o0[1] = bf_hi(ga.x) * bf_hi(a8.x) + bf_hi(gp.x) * y0[1];
                    o0[2] = bf_lo(ga.y) * bf_lo(a8.y) + bf_lo(gp.y) * y0[2]; o0[3] = bf_hi(ga.y) * bf_hi(a8.y) + bf_hi(gp.y) * y0[3];
                    o1[0] = bf_lo(ga.z) * bf_lo(a8.z) + bf_lo(gp.z) * y1[0]; o1[1] = bf_hi(ga.z) * bf_hi(a8.z) + bf_hi(gp.z) * y1[1];
                    o1[2] = bf_lo(ga.w) * bf_lo(a8.w) + bf_lo(gp.w) * y1[2]; o1[3] = bf_hi(ga.w) * bf_hi(a8.w) + bf_hi(gp.w) * y1[3];
                    __builtin_nontemporal_store(pack8(o0, o1), (u32x4*)(Mg + row * 1024 + c));
                }
                asm volatile("" ::: "memory");
            }
    }
};

struct EpiResA {
    static constexpr bool PERM = true, AFTER_DRAIN = false;
    const float* xi; bf16_t* xb; float* ssq;
    __device__ __forceinline__ void operator()(const f32x4 (&acc)[2][2][4][2], const Unit& u, int wr, int wc, int fr, int fq) const {
        const int row0 = u.pm * BM + wr * 64 + fr, col0 = u.pn * BM + wc * 32 + 8 * fq;
#pragma unroll
        for (int ai = 0; ai < 2; ++ai)
#pragma unroll
            for (int m = 0; m < 4; ++m) {
                const size_t row = (size_t)(row0 + ai * HALF + m * 16); float s = 0.f;
#pragma unroll
                for (int bj = 0; bj < 2; ++bj) {
                    const size_t off = row * 1024 + col0 + bj * HALF;
                    const f32x4 r0 = __builtin_nontemporal_load((const f32x4*)(xi + off)) + acc[ai][bj][m][0], r1 = __builtin_nontemporal_load((const f32x4*)(xi + off + 4)) + acc[ai][bj][m][1];
                    *(u32x4*)(xb + off) = pack8(r0, r1);
                    s += (r0[0] * r0[0] + r0[1] * r0[1]) + (r0[2] * r0[2] + r0[3] * r0[3]) + (r1[0] * r1[0] + r1[1] * r1[1]) + (r1[2] * r1[2] + r1[3] * r1[3]);
                }
                s += xor_swz<16>(s); s = half_sum(s);
                if (fq == 0) ssq[row * 16 + u.pn * 4 + wc] = s;
            }
    }
};
struct EpiResB {
    static constexpr bool PERM = true, AFTER_DRAIN = false;
    bf16_t* xb; float* ssq;
    __device__ __forceinline__ void operator()(const f32x4 (&acc)[2][2][4][2], const Unit& u, int wr, int wc, int fr, int fq) const {
        const int row0 = u.pm * BM + wr * 64 + fr, col0 = u.pn * BM + wc * 32 + 8 * fq;
#pragma unroll
        for (int ai = 0; ai < 2; ++ai)
#pragma unroll
            for (int m = 0; m < 4; ++m) {
                const size_t row = (size_t)(row0 + ai * HALF + m * 16); float s = 0.f;
#pragma unroll
                for (int bj = 0; bj < 2; ++bj) {
                    const size_t off = row * 1024 + col0 + bj * HALF;
                    const u32x4 w = __builtin_nontemporal_load((const u32x4*)(xb + off));
                    const f32x4 r0 = (f32x4){bf_lo(w.x), bf_hi(w.x), bf_lo(w.y), bf_hi(w.y)} + acc[ai][bj][m][0], r1 = (f32x4){bf_lo(w.z), bf_hi(w.z), bf_lo(w.w), bf_hi(w.w)} + acc[ai][bj][m][1];
                    __builtin_nontemporal_store(pack8(r0, r1), (u32x4*)(xb + off));
                    s += (r0[0] * r0[0] + r0[1] * r0[1]) + (r0[2] * r0[2] + r0[3] * r0[3]) + (r1[0] * r1[0] + r1[1] * r1[1]) + (r1[2] * r1[2] + r1[3] * r1[3]);
                }
                s += xor_swz<16>(s); s = half_sum(s);
                if (fq == 0) ssq[row * 16 + u.pn * 4 + wc] = s;
            }
    }
};

struct EpiUp {
    static constexpr bool PERM = true, AFTER_DRAIN = false;
    const float* ssq; bf16_t* Z;
    __device__ __forceinline__ void operator()(const f32x4 (&acc)[2][2][4][2], const Unit& u, int wr, int wc, int fr, int fq) const {
        typedef float f32x2v __attribute__((ext_vector_type(2)));
        const int row0 = u.pm * BM + wr * 64 + fr, col0 = u.pn * BM + wc * 32 + 8 * fq;
#pragma unroll
        for (int ai = 0; ai < 2; ++ai)
#pragma unroll
            for (int m = 0; m < 4; ++m) {
                const size_t row = (size_t)(row0 + ai * HALF + m * 16);
                const f32x4 pq = *(const f32x4*)(ssq + row * 16 + 4 * fq);
                float s = (pq[0] + pq[1]) + (pq[2] + pq[3]); s += xor_swz<16>(s); s = half_sum(s);
                const float r2 = __builtin_amdgcn_rcpf(s * (1.0f / 1024.0f) + 1e-6f);
                const f32x2v r2v = {r2, r2};
#pragma unroll
                for (int bj = 0; bj < 2; ++bj) {
                    f32x4 v0 = acc[ai][bj][m][0], v1 = acc[ai][bj][m][1];
#pragma unroll
                    for (int e = 0; e < 4; ++e) { v0[e] = fmaxf(v0[e], 0.f); v1[e] = fmaxf(v1[e], 0.f); }
                    f32x2v a = {v0[0], v0[1]}, b = {v0[2], v0[3]}, c = {v1[0], v1[1]}, d = {v1[2], v1[3]};
                    a = (a * a) * r2v; b = (b * b) * r2v; c = (c * c) * r2v; d = (d * d) * r2v;
                    u32x4 w; w.x = cvt_pk_bf16(a.x, a.y); w.y = cvt_pk_bf16(b.x, b.y); w.z = cvt_pk_bf16(c.x, c.y); w.w = cvt_pk_bf16(d.x, d.y);
                    __builtin_nontemporal_store(w, (u32x4*)(Z + row * 4096 + col0 + bj * HALF));
                }
            }
    }
};
}
namespace att {
#define ATT_LAS __attribute__((address_space(3)))
typedef unsigned short bf16_t;
typedef short bf16x8 __attribute__((ext_vector_type(8)));
typedef short s16x4 __attribute__((ext_vector_type(4)));
typedef float f32x16 __attribute__((ext_vector_type(16)));
typedef unsigned u32x4 __attribute__((ext_vector_type(4)));
constexpr int SEQ = 4096, PITCH = 1024;
constexpr int KBUF = 0, VBUF = 32768, WSF = 65536, QBUF = 65536 + 4096, ATT_LDS_BYTES = QBUF + 8 * 8192;
constexpr float THR = 8.0f;
__device__ __forceinline__ int crow(int r, int hi) { return (r & 3) + 8 * (r >> 2) + 4 * hi; }
__device__ __forceinline__ int koffs(int row, int ch) { return row * 256 + ((ch ^ (row & 15)) << 4); }
__device__ __forceinline__ int voffs(int row, int ch) { return 2048 * (row >> 3) + 512 * (ch >> 2) + 64 * (row & 7) + 16 * ((ch & 3) ^ ((row >> 2) & 3)); }
__device__ __forceinline__ unsigned cvtpk(float lo, float hi) { unsigned r; asm volatile("v_cvt_pk_bf16_f32 %0, %1, %2" : "=v"(r) : "v"(lo), "v"(hi)); return r; }
__device__ __forceinline__ s16x4 vtr(const ATT_LAS unsigned char* p) { return __builtin_bit_cast(s16x4, __builtin_amdgcn_ds_read_tr16_b64_v4i16((ATT_LAS s16x4*)p)); }
__device__ __forceinline__ int sub1(int a) { int v = a ^ 128; asm volatile("" : "+v"(v)); return v; }
__device__ __forceinline__ void glds16(const char* sbase, unsigned voff, unsigned lds_dst) { unsigned keep;
    asm volatile("s_mov_b32 %0, m0\n\ts_mov_b32 m0, %3\n\ts_nop 0\n\tglobal_load_lds_dwordx4 %1, %2\n\ts_mov_b32 m0, %0" : "=&s"(keep) : "v"(voff), "s"(sbase), "s"(lds_dst) : "memory"); }
#define ATT_MFMA(a, b, c) __builtin_amdgcn_mfma_f32_32x32x16_bf16((a), (b), (c), 0, 0, 0)

template <bool C1> __device__ __forceinline__ void qk_issue(f32x16& s0, const ATT_LAS unsigned char* kb, const ATT_LAS unsigned char* qb_, const int (&kaddr)[4]) {
#pragma unroll
    for (int i = 0; i < 16; ++i) s0[i] = 0.f;
#pragma unroll
    for (int ds = 0; ds < 4; ++ds) {
        const int ad = C1 ? sub1(kaddr[ds]) : kaddr[ds];
        const bf16x8 a0 = *(const ATT_LAS bf16x8*)(kb + ad);
        const bf16x8 qv = *(const ATT_LAS bf16x8*)(qb_ + ad);
        s0 = ATT_MFMA(a0, qv, s0);
    }
}
__device__ __forceinline__ void rowmax_rescale(bool MASK, f32x16& s0, f32x16 (&O)[4], float& m, float& l, int kvr, int r, int h, ATT_LAS float* wsf) {
    if (MASK) {
        asm volatile("" ::: "memory");
        const int d = r - 4 * h - kvr;
#pragma unroll
        for (int i = 0; i < 16; ++i) { if (((i & 3) + 8 * (i >> 2)) > d) s0[i] = -INFINITY; }
    }
    float ra = __builtin_fmaxf(__builtin_fmaxf(s0[0], s0[1]), s0[2]), rb = __builtin_fmaxf(__builtin_fmaxf(s0[3], s0[4]), s0[5]);
    ra = __builtin_fmaxf(__builtin_fmaxf(ra, s0[6]), s0[7]); rb = __builtin_fmaxf(__builtin_fmaxf(rb, s0[8]), s0[9]);
    ra = __builtin_fmaxf(__builtin_fmaxf(ra, s0[10]), s0[11]); rb = __builtin_fmaxf(__builtin_fmaxf(rb, s0[12]), s0[13]);
    ra = __builtin_fmaxf(__builtin_fmaxf(ra, s0[14]), s0[15]);
    const float rm = half_max(__builtin_fmaxf(ra, rb));
    if (__any(rm > m + THR)) {
        const float mn = fmaxf(m, rm), al = __builtin_amdgcn_exp2f(m - mn);
        l *= al; m = mn;
        if (h == 0) wsf[r] = al;
#pragma unroll
        for (int i = 0; i < 16; ++i) { const float a = wsf[crow(i, h)];
#pragma unroll
            for (int db = 0; db < 4; ++db) O[db][i] *= a; }
    }
}
template <bool HAS_PV, bool HAS_QK, bool C1>
__device__ __forceinline__ float step_fused(f32x16& Scur, float m, float& l, u32x4 (&pkout)[2],
                                           f32x16 (&Opv)[4], const u32x4 (&pkin)[2], const ATT_LAS unsigned char* vb, const int (&vaddr)[2],
                                           f32x16& Snext, const ATT_LAS unsigned char* kb, const ATT_LAS unsigned char* qb_, const int (&kaddr)[4]) {
    s16x4 vlo[2], vhi[2]; bf16x8 ka, qa;
    if (HAS_PV) {
#pragma unroll
        for (int u = 0; u < 2; ++u) { vlo[u] = vtr(vb + vaddr[0] + u * 512); vhi[u] = vtr(vb + vaddr[1] + u * 512); } }
    if (HAS_QK) { const int ad = C1 ? sub1(kaddr[0]) : kaddr[0]; ka = *(const ATT_LAS bf16x8*)(kb + ad); qa = *(const ATT_LAS bf16x8*)(qb_ + ad);
#pragma unroll
        for (int i = 0; i < 16; ++i) Snext[i] = 0.f; }
    float sa = 0.f, sb = 0.f;
#pragma unroll
    for (int g = 0; g < 4; ++g) {
        s16x4 nlo[2], nhi[2]; bf16x8 nk, nq;
        if (g < 3) {
            if (HAS_PV) {
#pragma unroll
                for (int u = 0; u < 2; ++u) { const int off = (2 * ((g + 1) & 1) + u) * 512 + ((g + 1) >> 1) * 4096; nlo[u] = vtr(vb + vaddr[0] + off); nhi[u] = vtr(vb + vaddr[1] + off); } }
            if (HAS_QK) { const int ad = C1 ? sub1(kaddr[g + 1]) : kaddr[g + 1]; nk = *(const ATT_LAS bf16x8*)(kb + ad); nq = *(const ATT_LAS bf16x8*)(qb_ + ad); }
        }
        if (HAS_PV) { const bf16x8 pa = __builtin_bit_cast(bf16x8, pkin[g >> 1]);
#pragma unroll
            for (int u = 0; u < 2; ++u) { const bf16x8 vf = __builtin_shufflevector(vlo[u], vhi[u], 0, 1, 2, 3, 4, 5, 6, 7); Opv[2 * (g & 1) + u] = ATT_MFMA(pa, vf, Opv[2 * (g & 1) + u]); } }
        if (HAS_QK) Snext = ATT_MFMA(ka, qa, Snext);
#pragma unroll
        for (int e = 4 * g; e < 4 * g + 4; e += 2) { Scur[e] = __builtin_amdgcn_exp2f(Scur[e] - m); Scur[e + 1] = __builtin_amdgcn_exp2f(Scur[e + 1] - m); sa += Scur[e]; sb += Scur[e + 1]; }
        if (g & 1) pkout[g >> 1] = (u32x4){cvtpk(Scur[4 * g - 4], Scur[4 * g - 3]), cvtpk(Scur[4 * g - 2], Scur[4 * g - 1]), cvtpk(Scur[4 * g], Scur[4 * g + 1]), cvtpk(Scur[4 * g + 2], Scur[4 * g + 3])};
        if (g < 3) {
            if (HAS_PV) {
#pragma unroll
                for (int u = 0; u < 2; ++u) { vlo[u] = nlo[u]; vhi[u] = nhi[u]; } }
            if (HAS_QK) { ka = nk; qa = nq; }
        }
        __builtin_amdgcn_sched_barrier(0);
    }
    l += sa + sb;
    return sa + sb;
}
__device__ __forceinline__ void pv_issue(f32x16 (&O)[4], const u32x4 (&pk)[2], const ATT_LAS unsigned char* vb, const int (&vaddr)[2]) {
#pragma unroll
    for (int s_ = 0; s_ < 2; ++s_) { const bf16x8 pa = __builtin_bit_cast(bf16x8, pk[s_]);
#pragma unroll
        for (int db = 0; db < 4; ++db) {
            const s16x4 lo = vtr(vb + vaddr[0] + db * 512 + s_ * 4096), hi = vtr(vb + vaddr[1] + db * 512 + s_ * 4096);
            const bf16x8 vf = __builtin_shufflevector(lo, hi, 0, 1, 2, 3, 4, 5, 6, 7);
            O[db] = ATT_MFMA(pa, vf, O[db]); } }
}

__device__ __forceinline__ void apply_mask(bool MASK, f32x16& s0, int kvr, int r, int h) {
    if (MASK) {
        asm volatile("" ::: "memory");
        const int d = r - 4 * h - kvr;
#pragma unroll
        for (int i = 0; i < 16; ++i) { if (((i & 3) + 8 * (i >> 2)) > d) s0[i] = -INFINITY; }
    }
}
constexpr float GUARD = 65536.0f;
template <bool C1> __device__ __forceinline__ void slow_step(bool MASK, f32x16& S, const ATT_LAS unsigned char* kb, const ATT_LAS unsigned char* qbase, const int (&kaddr)[4], const int (&vaddr)[2],
                                                             f32x16 (&O)[4], float& m, float& l, float l_saved, int kvr, int r, int h, ATT_LAS float* wsf, u32x4 (&pk)[2]) {
    l = l_saved;
    qk_issue<C1>(S, kb, qbase, kaddr);
    rowmax_rescale(MASK, S, O, m, l, kvr, r, h, wsf);
    f32x16 dummy;
    step_fused<false, false, false>(S, m, l, pk, O, pk, kb, vaddr, dummy, kb, qbase, kaddr);
}
__device__ __forceinline__ void tile_body(bool MASK, const ATT_LAS unsigned char* kb, const ATT_LAS unsigned char* vb, const ATT_LAS unsigned char* qbase, const int (&kaddr)[4], const int (&vaddr)[2],
                                                               f32x16 (&O1)[4], f32x16 (&O2)[4], float& m1, float& m2, float& l1, float& l2, int kvrel, int r, int h, ATT_LAS float* wsf) {
    f32x16 Sa, Sb; u32x4 pkA[2], pkB[2]; float ls, sm;
    qk_issue<false>(Sa, kb, qbase, kaddr);
    apply_mask(MASK, Sa, kvrel, r, h); ls = l1;
    sm = step_fused<false, true, true>(Sa, m1, l1, pkA, O1, pkA, vb, vaddr, Sb, kb, qbase, kaddr);
    if (__any(!(sm <= GUARD))) slow_step<false>(MASK, Sa, kb, qbase, kaddr, vaddr, O1, m1, l1, ls, kvrel, r, h, wsf, pkA);
    apply_mask(MASK, Sb, kvrel, r, h); ls = l2;
    sm = step_fused<true, true, false>(Sb, m2, l2, pkB, O1, pkA, vb, vaddr, Sa, kb + 8192, qbase, kaddr);
    if (__any(!(sm <= GUARD))) slow_step<true>(MASK, Sb, kb, qbase, kaddr, vaddr, O2, m2, l2, ls, kvrel, r, h, wsf, pkB);
    apply_mask(MASK, Sa, kvrel + 32, r, h); ls = l1;
    sm = step_fused<true, true, true>(Sa, m1, l1, pkA, O2, pkB, vb, vaddr, Sb, kb + 8192, qbase, kaddr);
    if (__any(!(sm <= GUARD))) slow_step<false>(MASK, Sa, kb + 8192, qbase, kaddr, vaddr, O1, m1, l1, ls, kvrel + 32, r, h, wsf, pkA);
    apply_mask(MASK, Sb, kvrel + 32, r, h); ls = l2;
    sm = step_fused<true, false, false>(Sb, m2, l2, pkB, O1, pkA, vb + 8192, vaddr, Sa, kb, qbase, kaddr);
    if (__any(!(sm <= GUARD))) slow_step<true>(MASK, Sb, kb + 8192, qbase, kaddr, vaddr, O2, m2, l2, ls, kvrel + 32, r, h, wsf, pkB);
    pv_issue(O2, pkB, vb + 8192, vaddr);
}

__device__ __forceinline__ void attn_unit(ATT_LAS unsigned char* lds, const bf16_t* Qg, const bf16_t* Kg, const bf16_t* Vg, bf16_t* Og, int b, int head, int qb, float lam, const float* subg) {
    int tid = threadIdx.x; asm volatile("" : "+v"(tid));
    const int lane = tid & 63, r = lane & 31, h = lane >> 5;
    const int w = __builtin_amdgcn_readfirstlane(tid >> 6);
    const size_t rowbase = (size_t)b * SEQ; const int q0 = qb * 256, NT = (q0 + 256) >> 6;
    const char* Kt = (const char*)(Kg + rowbase * PITCH + head * 128);
    const char* Vt = (const char*)(Vg + rowbase * PITCH + head * 128);
    unsigned ksrc[2], vsrc[2];
#pragma unroll
    for (int i = 0; i < 2; ++i) { const int ii = w * 2 + i;
        { const int row = 4 * ii + (lane >> 4), pc = lane & 15; ksrc[i] = (unsigned)(row * 2048 + ((pc ^ (row & 15)) << 4)); }
        { const int row = 8 * (ii >> 1) + ((lane >> 2) & 7), ch = 4 * (2 * (ii & 1) + (lane >> 5)) + ((lane & 3) ^ ((row >> 2) & 3)); vsrc[i] = (unsigned)(row * 2048 + ch * 16); } }
    const unsigned ldsb = (unsigned)(uintptr_t)lds;
#define ATT_STAGE(t, buf) do { _Pragma("unroll") for (int i_ = 0; i_ < 2; ++i_) { \
        glds16(Kt + (size_t)(t) * 131072, ksrc[i_], (unsigned)__builtin_amdgcn_readfirstlane(ldsb + KBUF + (buf) * 16384 + (w * 2 + i_) * 1024)); \
        glds16(Vt + (size_t)(t) * 131072, vsrc[i_], (unsigned)__builtin_amdgcn_readfirstlane(ldsb + VBUF + (buf) * 16384 + (w * 2 + i_) * 1024)); } } while (0)
    ATT_STAGE(0, 0);
    { const char* Qw = (const char*)(Qg + (rowbase + q0 + w * 32) * PITCH + head * 128);
#pragma unroll
      for (int i = 0; i < 8; ++i) { const int row = 4 * i + (lane >> 4), pc = lane & 15;
          glds16(Qw, (unsigned)(row * 2048 + ((pc ^ (row & 15)) << 4)), (unsigned)__builtin_amdgcn_readfirstlane(ldsb + QBUF + w * 8192 + i * 1024)); } }
    const ATT_LAS unsigned char* qbase = lds + QBUF + w * 8192;
    int kaddr[4], vaddr[2];
#pragma unroll
    for (int ds = 0; ds < 4; ++ds) kaddr[ds] = koffs(r, 2 * ds + h);
    { const int q = (lane & 15) >> 2, p = lane & 3, blk = (lane >> 4) & 1;
#pragma unroll
      for (int sub = 0; sub < 2; ++sub) vaddr[sub] = voffs(8 * sub + 4 * h + q, 2 * blk + (p >> 1)) + 8 * (p & 1); }
    ATT_LAS float* wsf = (ATT_LAS float*)(lds + WSF + w * 512);
    f32x16 O1[4], O2[4];
#pragma unroll
    for (int db = 0; db < 4; ++db)
#pragma unroll
        for (int i = 0; i < 16; ++i) { O1[db][i] = 0.f; O2[db][i] = 0.f; }
    float m1 = -1e30f, m2 = -1e30f, l1 = 0.f, l2 = 0.f;
    asm volatile("s_waitcnt vmcnt(0)" ::: "memory"); __syncthreads();
    for (int t = 0; t < NT; ++t) {
        const int buf = t & 1;
        if (t + 1 < NT) ATT_STAGE(t + 1, buf ^ 1);
        const int kvrel = 64 * t - q0 - 32 * w;
        if (kvrel <= 31) {
            const ATT_LAS unsigned char* kb = lds + KBUF + buf * 16384;
            const ATT_LAS unsigned char* vb = lds + VBUF + buf * 16384;
            tile_body(kvrel + 63 > 0, kb, vb, qbase, kaddr, vaddr, O1, O2, m1, m2, l1, l2, kvrel, r, h, wsf);
        }
        asm volatile("s_waitcnt vmcnt(0)" ::: "memory"); __syncthreads();
    }
    l1 = half_sum(l1); l2 = half_sum(l2);
    if (h == 0) { wsf[r] = 1.0f / l1; wsf[32 + r] = lam / l2; }
    float sg[4];
#pragma unroll
    for (int db = 0; db < 4; ++db) sg[db] = subg[32 * db + r] * 0.8f;
    bf16_t* Ow = Og + (rowbase + q0 + w * 32) * PITCH + head * 128 + r;
#pragma unroll
    for (int i = 0; i < 16; ++i) {
        const int qr = crow(i, h); const float a1 = wsf[qr], a2 = wsf[32 + qr];
        float o[4], ss = 0.f;
#pragma unroll
        for (int db = 0; db < 4; ++db) { o[db] = O1[db][i] * a1 - O2[db][i] * a2; ss += o[db] * o[db]; }
        ss += xor_swz<1>(ss); ss += xor_swz<2>(ss); ss += xor_swz<4>(ss); ss += xor_swz<8>(ss); ss += xor_swz<16>(ss);
        const float rs = __builtin_amdgcn_rsqf(ss * (1.0f / 128.0f) + 1e-6f);
#pragma unroll
        for (int db = 0; db < 4; ++db) Ow[(size_t)qr * PITCH + 32 * db] = (bf16_t)(cvtpk(o[db] * rs * sg[db], 0.f) & 0xffffu);
    }
#undef ATT_STAGE
}
}
constexpr int NWAVES = 8;
constexpr int BATCH = 16, SEQ = 4096, D = 1024, NH = 8, FF = 4096, INW = 5632, M = BATCH * SEQ;
constexpr float RMS_EPS = 1e-6f;
constexpr size_t MiB = 1u << 20;
constexpr size_t WS_WIN = 0, WS_WOUT = 11 * MiB, WS_WUP = 13 * MiB, WS_WDOWN = 21 * MiB, WS_WPOOL = 29 * MiB;
constexpr size_t WS_ROPE = 30 * MiB;
constexpr size_t WS_SSQ1 = 34 * MiB, WS_SSQ2 = 38 * MiB;
constexpr size_t WS_BAR = 42 * MiB, BAR_ZERO_BYTES = 32768;
constexpr size_t WS_XN = 48 * MiB;
constexpr size_t WS_Q = 176 * MiB;
constexpr size_t WS_K = 304 * MiB;
constexpr size_t WS_V = 432 * MiB;
constexpr size_t WS_U = 560 * MiB;
constexpr size_t WS_G = 624 * MiB;
constexpr size_t WS_DP = 880 * MiB;
constexpr size_t WS_Z = 176 * MiB;
constexpr size_t WS_END = 944 * MiB;
static_assert(WS_Z + (size_t)M * FF * 2 <= WS_DP && WS_DP + (size_t)M * 512 * 2 <= WS_END, "d_ws map");
constexpr int LDS_MISC_OFF = 147456 - 256;
constexpr int LDS_BYTES = 147456;

#define LAS __attribute__((address_space(3)))
typedef unsigned short bf16;
typedef unsigned v4u __attribute__((ext_vector_type(4)));
typedef float f32x4 __attribute__((ext_vector_type(4)));
__device__ __forceinline__ unsigned f2bf(float f) { unsigned u = __builtin_bit_cast(unsigned, f); return (u + 0x7fffu + ((u >> 16) & 1u)) >> 16; }
__device__ __forceinline__ unsigned pk2(float lo, float hi) { return f2bf(lo) | (f2bf(hi) << 16); }
__device__ __forceinline__ float wave_sum(float v) {
    v += xor_swz<1>(v); v += xor_swz<2>(v); v += xor_swz<4>(v); v += xor_swz<8>(v); v += xor_swz<16>(v);
    return half_sum(v);
}
template <bool WIN = false>
__device__ __forceinline__ void p0_transpose_item(const float* W, int K, int N, bf16* WT, int row_off, const float* kscale, LAS float* scr, int item, int lane) {
    const int nblk = N / 32, kb = item / nblk, nb = item % nblk, k0 = 64 * kb, n0 = 32 * nb;
#pragma unroll 8
    for (int i = 0; i < 32; ++i) { const int kk = 2 * i + (lane >> 5); float v = W[(size_t)(k0 + kk) * N + n0 + (lane & 31)]; if (kscale) v *= kscale[k0 + kk]; if (WIN && n0 + (lane & 31) >= 3584) v *= -1.4426950408889634f; scr[kk * 33 + (lane & 31)] = v; }
    asm volatile("s_waitcnt lgkmcnt(0)" ::: "memory");
    const int c = lane & 7;
#pragma unroll
    for (int j = 0; j < 4; ++j) { const int n = (lane >> 3) + 8 * j; const LAS float* s = scr + (8 * c) * 33 + n;
        v4u o; o.x = pk2(s[0 * 33], s[1 * 33]); o.y = pk2(s[2 * 33], s[3 * 33]); o.z = pk2(s[4 * 33], s[5 * 33]); o.w = pk2(s[6 * 33], s[7 * 33]);
        int nn = n0 + n;
        if (WIN && nn < 2048 && (nn & 63) < 16) { const int j = nn & 15; nn = (nn & ~15) | (2 * (j & 7) + (j >> 3)); }
        *(v4u*)(WT + (size_t)(row_off + nn) * K + k0 + 8 * c) = o; }
    asm volatile("s_waitcnt lgkmcnt(0)" ::: "memory");
}

#define XB_TMO      128
#define XB_XCNT(j)  (256  + 64 * (j))
#define XB_XSUB(j)  (1280 + 64 * (j))
#define XB_XGEN(j)  (2304 + 64 * (j))
#define XB_TOP      3328
#define XB_TOPGEN   3392
#define XCD_BAR_WORDS 3456
#define XB_SPIN_CAP (1u << 18)

__device__ __forceinline__ unsigned xb_ld(unsigned* p)              { return __hip_atomic_load(p, __ATOMIC_RELAXED, __HIP_MEMORY_SCOPE_AGENT); }
__device__ __forceinline__ unsigned xb_add(unsigned* p, unsigned v) { return __hip_atomic_fetch_add(p, v, __ATOMIC_RELAXED, __HIP_MEMORY_SCOPE_AGENT); }
__device__ __forceinline__ unsigned xb_xcc_id() { return (unsigned)__builtin_amdgcn_s_getreg((3 << 11) | 20) & 0xFu; }
#define XB_SPIN(cond, bar) do { unsigned _sp = 0; while (cond) { __builtin_amdgcn_s_sleep(1); \
    if ((++_sp & 255u) == 0u) { if (xb_ld(&(bar)[XB_TMO])) break; if (_sp > XB_SPIN_CAP) { atomicAdd(&(bar)[XB_TMO], 1u); break; } } } } while (0)

struct XcdBarrier {
    unsigned* bar; unsigned x;
    volatile LAS unsigned* st;
};

__device__ __forceinline__ XcdBarrier xcd_barrier_post(unsigned* bar, volatile LAS unsigned* st) {
    XcdBarrier b; b.bar = bar; b.x = xb_xcc_id(); b.st = st;
    if (threadIdx.x == 0) (void)xb_add(&bar[XB_XCNT(b.x)], 1u);
    return b;
}
__device__ __forceinline__ void xcd_barrier_complete(unsigned* bar, unsigned x, unsigned& nloc, unsigned& nx) {
    const unsigned G = gridDim.x * gridDim.y * gridDim.z;
    unsigned sum, cnt, mine, sp = 0u;
    for (;;) {
        sum = 0u; cnt = 0u; mine = 0u;
#pragma unroll
        for (unsigned j = 0; j < 16; ++j) { const unsigned c = xb_ld(&bar[XB_XCNT(j)]); sum += c; cnt += (c > 0u) ? 1u : 0u; mine = (j == x) ? c : mine; }
        if (sum == G) break;
        __builtin_amdgcn_s_sleep(1);
        if ((++sp & 255u) == 0u) { if (xb_ld(&bar[XB_TMO])) break; if (sp > XB_SPIN_CAP) { atomicAdd(&bar[XB_TMO], 1u); break; } }
    }
    nloc = mine > 0u ? mine : 1u; nx = cnt > 0u ? cnt : 1u;
}

__device__ __forceinline__ void xcd_barrier(const XcdBarrier& b) {
    asm volatile("s_waitcnt vmcnt(0)" ::: "memory");
    __syncthreads();
    if (threadIdx.x == 0) {
        unsigned* bar = b.bar;
        __builtin_amdgcn_s_waitcnt(0);
        unsigned nloc = b.st[0], nx = b.st[1];
        if (nloc == 0u) { xcd_barrier_complete(bar, b.x, nloc, nx); b.st[0] = nloc; b.st[1] = nx; }
        const unsigned old = xb_add(&bar[XB_XSUB(b.x)], 1u);
        const unsigned gen = old / nloc;
        if (old + 1u == (gen + 1u) * nloc) {
            __builtin_amdgcn_fence(__ATOMIC_RELEASE, "agent");
            asm volatile("s_waitcnt vmcnt(0)" ::: "memory");
            const unsigned og = xb_add(&bar[XB_TOP], 1u);
            const unsigned tg = og / nx;
            if (og + 1u == (tg + 1u) * nx) xb_add(&bar[XB_TOPGEN], 1u);
            else XB_SPIN(xb_ld(&bar[XB_TOPGEN]) == tg, bar);
            __builtin_amdgcn_fence(__ATOMIC_ACQUIRE, "agent");
            xb_add(&bar[XB_XGEN(b.x)], 1u);
            asm volatile("s_waitcnt vmcnt(0)" ::: "memory");
        } else {
            XB_SPIN(xb_ld(&bar[XB_XGEN(b.x)]) == gen, bar);
            __builtin_amdgcn_fence(__ATOMIC_ACQUIRE, "agent");
            asm volatile("s_waitcnt vmcnt(0)" ::: "memory");
        }
    }
    __syncthreads();
}

#ifndef REP_P0
#define REP_P0 1
#endif
#ifndef REP_P1
#define REP_P1 1
#endif
#ifndef REP_P2
#define REP_P2 1
#endif
#ifndef REP_P3
#define REP_P3 1
#endif
#ifndef REP_P4
#define REP_P4 1
#endif
#ifndef REP_P5
#define REP_P5 1
#endif
template <int W> __device__ __forceinline__ v4u pool_window(const bf16* up, int t) {
    v4u q[W];
#pragma unroll
    for (int j = 0; j < W; ++j) q[j] = *(const v4u*)(up - (size_t)((j <= t) ? j : 0) * 512);
    float acc[8];
#pragma unroll
    for (int e = 0; e < 8; ++e) acc[e] = 0.f;
#pragma unroll
    for (int j = 0; j < W; ++j) { const float wgt = (j <= t) ? 1.f : 0.f;
        acc[0] += wgt * pg8::bf_lo(q[j].x); acc[1] += wgt * pg8::bf_hi(q[j].x); acc[2] += wgt * pg8::bf_lo(q[j].y); acc[3] += wgt * pg8::bf_hi(q[j].y);
        acc[4] += wgt * pg8::bf_lo(q[j].z); acc[5] += wgt * pg8::bf_hi(q[j].z); acc[6] += wgt * pg8::bf_lo(q[j].w); acc[7] += wgt * pg8::bf_hi(q[j].w); }
    const float inv = 1.0f / (float)((t + 1 < W) ? (t + 1) : W);
    v4u o;
    o.x = pk2(acc[0] * inv - pg8::bf_lo(q[0].x), acc[1] * inv - pg8::bf_hi(q[0].x)); o.y = pk2(acc[2] * inv - pg8::bf_lo(q[0].y), acc[3] * inv - pg8::bf_hi(q[0].y));
    o.z = pk2(acc[4] * inv - pg8::bf_lo(q[0].z), acc[5] * inv - pg8::bf_hi(q[0].z)); o.w = pk2(acc[6] * inv - pg8::bf_lo(q[0].w), acc[7] * inv - pg8::bf_hi(q[0].w));
    return o;
}

struct Args {
    const float* x; const int* pos; const float* g_attn; const float* w_in; const float* lq1; const float* lk1; const float* lq2; const float* lk2;
    const float* subln_g; const float* w_pool; const float* pool_scale; const float* w_out; const float* g_mlp; const float* w_up; const float* w_down; const float* g_final;
    float* out; unsigned char* ws;
};

__global__ void __launch_bounds__(NWAVES * 64, 2) hybrid_fwd(Args a) {
    extern __shared__ __attribute__((aligned(16))) unsigned char lds_raw[];
    LAS unsigned char* lds = (LAS unsigned char*)lds_raw;
    cg::grid_group grid = cg::this_grid();
    if (threadIdx.x < 2) ((volatile LAS unsigned*)(lds + LDS_MISC_OFF))[threadIdx.x] = 0u;
    __syncthreads();
    const int G = gridDim.x, bx = blockIdx.x;
#define PHASE_IDS int tid = threadIdx.x; asm volatile("" : "+v"(tid)); const int lane = tid & 63, wave = __builtin_amdgcn_readfirstlane(tid >> 6); const int gw = vcu * NWAVES + wave, NGW = G * NWAVES; (void)lane; (void)gw; (void)NGW
    const int vcu = (G % 8 == 0) ? (bx % 8) * (G / 8) + bx / 8 : bx;
    unsigned char* ws = a.ws;
    bf16* Win_t = (bf16*)(ws + WS_WIN); bf16* Wout_t = (bf16*)(ws + WS_WOUT); bf16* Wup_t = (bf16*)(ws + WS_WUP); bf16* Wdown_t = (bf16*)(ws + WS_WDOWN); bf16* Wpool_t = (bf16*)(ws + WS_WPOOL);
    float* rope = (float*)(ws + WS_ROPE); float* ssq1 = (float*)(ws + WS_SSQ1); float* ssq2 = (float*)(ws + WS_SSQ2);
    bf16* XN = (bf16*)(ws + WS_XN); bf16* Qb = (bf16*)(ws + WS_Q); bf16* Kb = (bf16*)(ws + WS_K); bf16* Vb = (bf16*)(ws + WS_V);
    bf16* Ub = (bf16*)(ws + WS_U); bf16* Gb = (bf16*)(ws + WS_G); bf16* Dp = (bf16*)(ws + WS_DP); bf16* Zb = (bf16*)(ws + WS_Z); bf16* Mg = Kb; bf16* Ab = XN;

    for (int rep_ = 0; rep_ < REP_P0; ++rep_) {
        PHASE_IDS;
        LAS float* scr = (LAS float*)(lds + wave * 16384);
        constexpr int I_IN = (D / 64) * (INW / 32), I_OUT = (D / 64) * (D / 32), I_UP = (D / 64) * (FF / 32), I_DOWN = (FF / 64) * (D / 32), I_POOL1 = (128 / 64) * (256 / 32);
        constexpr int NITEMS = I_IN + I_OUT + I_UP + I_DOWN + 4 * I_POOL1;
        for (int it = gw; it < NITEMS; it += NGW) {
            int r = it;
            if (r < I_IN) { p0_transpose_item<true>(a.w_in, D, INW, Win_t, 0, nullptr, scr, r, lane); continue; } r -= I_IN;
            if (r < I_OUT) { p0_transpose_item(a.w_out, D, D, Wout_t, 0, nullptr, scr, r, lane); continue; } r -= I_OUT;
            if (r < I_UP) { p0_transpose_item(a.w_up, D, FF, Wup_t, 0, a.g_mlp, scr, r, lane); continue; } r -= I_UP;
            if (r < I_DOWN) { p0_transpose_item(a.w_down, FF, D, Wdown_t, 0, nullptr, scr, r, lane); continue; } r -= I_DOWN;
            { const int g = r / I_POOL1; p0_transpose_item(a.w_pool + (size_t)g * 128 * 256, 128, 256, Wpool_t, g * 256, nullptr, scr, r % I_POOL1, lane); }
        }
        for (int e = bx * (NWAVES * 64) + tid; e < M * 8; e += G * NWAVES * 64) {
            const int row = e >> 3, i = e & 7;
            const float invf = (i == 0) ? 1.0f : (i == 1) ? 0.19392274474868576f : (i == 2) ? 0.03760603093086393f : (i == 3) ? 0.007292664737217109f :
                               (i == 4) ? 0.001414213562373095f : (i == 5) ? 0.0002742481756762073f : (i == 6) ? 5.318295896944988e-05f : 1.031338537721246e-05f;
            const float ang = (float)a.pos[row] * invf;
            double rev = (double)ang * 0.15915494309189535; rev -= __builtin_rint(rev);
            const float rf = (float)rev;
            rope[(size_t)e * 2] = __builtin_amdgcn_cosf(rf); rope[(size_t)e * 2 + 1] = __builtin_amdgcn_sinf(rf);
        }
        {
            const f32x4* gr = (const f32x4*)a.g_attn + lane; f32x4 gg[4];
#pragma unroll
            for (int j = 0; j < 4; ++j) gg[j] = gr[64 * j];
            for (int m0 = gw * 4; m0 < M; m0 += NGW * 4) {
                f32x4 v[4][4]; float s2[4];
#pragma unroll
                for (int q = 0; q < 4; ++q) { const f32x4* xr = (const f32x4*)(a.x + (size_t)(m0 + q) * D) + lane;
#pragma unroll
                    for (int j = 0; j < 4; ++j) v[q][j] = __builtin_nontemporal_load(xr + 64 * j); }
#pragma unroll
                for (int q = 0; q < 4; ++q) { s2[q] = 0.f;
#pragma unroll
                    for (int j = 0; j < 4; ++j) s2[q] += (v[q][j].x * v[q][j].x + v[q][j].y * v[q][j].y) + (v[q][j].z * v[q][j].z + v[q][j].w * v[q][j].w); }
#pragma unroll
                for (int q = 0; q < 4; ++q) { const float rstd = __builtin_amdgcn_rsqf(wave_sum(s2[q]) * (1.f / D) + RMS_EPS);
                    unsigned long long* o8 = (unsigned long long*)(XN + (size_t)(m0 + q) * D) + lane;
#pragma unroll
                    for (int j = 0; j < 4; ++j) { const f32x4 y = v[q][j] * rstd * gg[j];
                        o8[64 * j] = (unsigned long long)pk2(y.x, y.y) | ((unsigned long long)pk2(y.z, y.w) << 32); } }
            }
        }
    if (bx == 0) { for (int i = threadIdx.x; i < (int)(BAR_ZERO_BYTES / 4); i += NWAVES * 64) ((unsigned*)(a.ws + WS_BAR))[i] = 0u; }
    grid.sync(); }
    unsigned seam_no = 0, seam2_no = 0, xc_nloc = 1, xc_ngroups = 1;
    const unsigned xcc = (unsigned)__builtin_amdgcn_s_getreg((3 << 11) | 20) & 0xFu;
    if (threadIdx.x == 0) __hip_atomic_fetch_add((unsigned*)(a.ws + WS_BAR) + 64 * (80 + xcc), 1u, __ATOMIC_RELAXED, __HIP_MEMORY_SCOPE_AGENT);
#define SEAM2() do { ++seam2_no; asm volatile("s_waitcnt vmcnt(0)" ::: "memory"); __syncthreads(); \
        if (threadIdx.x == 0) { unsigned* w_ = (unsigned*)(a.ws + WS_BAR); \
            const unsigned old_ = __hip_atomic_fetch_add(w_ + 64 * (32 + xcc), 1u, __ATOMIC_RELAXED, __HIP_MEMORY_SCOPE_AGENT); \
            if (old_ + 1u == seam2_no * xc_nloc) { \
                __builtin_amdgcn_fence(__ATOMIC_RELEASE, "agent"); asm volatile("s_waitcnt vmcnt(0)" ::: "memory"); \
                __hip_atomic_fetch_add(w_ + 64 * 64, 1u, __ATOMIC_RELAXED, __HIP_MEMORY_SCOPE_AGENT); \
                while (__hip_atomic_load(w_ + 64 * 64, __ATOMIC_RELAXED, __HIP_MEMORY_SCOPE_AGENT) < seam2_no * xc_ngroups) __builtin_amdgcn_s_sleep(1); \
                __hip_atomic_store(w_ + 64 * (48 + xcc), seam2_no, __ATOMIC_RELAXED, __HIP_MEMORY_SCOPE_AGENT); \
            } else { while (__hip_atomic_load(w_ + 64 * (48 + xcc), __ATOMIC_RELAXED, __HIP_MEMORY_SCOPE_AGENT) < seam2_no) __builtin_amdgcn_s_sleep(1); } \
            __builtin_amdgcn_fence(__ATOMIC_ACQUIRE, "agent"); asm volatile("s_waitcnt vmcnt(0)" ::: "memory"); } \
        __syncthreads(); } while (0)
#define SEAM() do { ++seam_no; asm volatile("s_waitcnt vmcnt(0)" ::: "memory"); __syncthreads(); \
        if (threadIdx.x == 0) { unsigned* w_ = (unsigned*)(a.ws + WS_BAR); const unsigned g_ = (unsigned)bx & 7u, ng_ = ((unsigned)G - g_ + 7u) / 8u, ngroups_ = (unsigned)G < 8u ? (unsigned)G : 8u; \
            __builtin_amdgcn_fence(__ATOMIC_RELEASE, "agent"); asm volatile("s_waitcnt vmcnt(0)" ::: "memory");     \
            const unsigned old_ = __hip_atomic_fetch_add(w_ + 64 * g_, 1u, __ATOMIC_RELAXED, __HIP_MEMORY_SCOPE_AGENT); \
            if (old_ + 1u == seam_no * ng_) { \
                __hip_atomic_fetch_add(w_ + 64 * 16, 1u, __ATOMIC_RELAXED, __HIP_MEMORY_SCOPE_AGENT); \
                while (__hip_atomic_load(w_ + 64 * 16, __ATOMIC_RELAXED, __HIP_MEMORY_SCOPE_AGENT) < seam_no * ngroups_) __builtin_amdgcn_s_sleep(1); \
                __hip_atomic_store(w_ + 64 * (8 + g_), seam_no, __ATOMIC_RELAXED, __HIP_MEMORY_SCOPE_AGENT); \
            } else { while (__hip_atomic_load(w_ + 64 * (8 + g_), __ATOMIC_RELAXED, __HIP_MEMORY_SCOPE_AGENT) < seam_no) __builtin_amdgcn_s_sleep(1); } \
            __builtin_amdgcn_fence(__ATOMIC_ACQUIRE, "agent"); asm volatile("s_waitcnt vmcnt(0)" ::: "memory"); } \
        __syncthreads(); } while (0)

    for (int rep_ = 0; rep_ < REP_P1; ++rep_) {
        pg8::Gemm g{XN, Win_t, M, INW, D, 0}; pg8::StaticOrder S; S.init(M, INW, G, bx);
        pg8::EpiIn E{Qb, Kb, Vb, Ub, Gb, rope};
        pg8::gemm_phase<pg8::EpiIn, pg8::StaticOrder, true, true>(lds, g, S, E);
    SEAM(); }
    if (threadIdx.x == 0) { unsigned ng_ = 0u;
        for (unsigned j = 0; j < 16u; ++j) { const unsigned c_ = __hip_atomic_load((unsigned*)(a.ws + WS_BAR) + 64 * (80 + j), __ATOMIC_RELAXED, __HIP_MEMORY_SCOPE_AGENT); ng_ += (c_ != 0u); if (j == xcc) xc_nloc = c_; }
        xc_ngroups = ng_; }


    for (int rep_ = 0; rep_ < REP_P2; ++rep_) {
        PHASE_IDS;
        for (int wi = gw; wi < M; wi += NGW) {
            const int rq = wi >> 2, gp = ((wi & 3) + (wi >> 11)) & 3;
            const int row = 4 * rq + (lane >> 4), t = row & (SEQ - 1);
            const bf16* up = Ub + (size_t)row * 512 + gp * 128 + (lane & 15) * 8;
            v4u o;
            if (gp == 0) o = pool_window<2>(up, t); else if (gp == 1) o = pool_window<4>(up, t); else if (gp == 2) o = pool_window<8>(up, t); else o = pool_window<16>(up, t);
            *(v4u*)(Dp + ((size_t)gp * M + row) * 128 + (lane & 15) * 8) = o;
        }
        const float sa = wave_sum(a.lq1[lane] * a.lk1[lane]), sb = wave_sum(a.lq2[lane] * a.lk2[lane]);
        const float lam = expf(sa) - expf(sb) + 0.2f;
        for (int pu = vcu; pu < BATCH * NH * 8; pu += G) {
            const int bh = pu >> 3, s = pu & 7, b = bh >> 3, head = bh & 7;
            for (int k = 0; k < 2; ++k) att::attn_unit(lds, Qb, Kb, Vb, Ab, b, head, k ? s : 15 - s, lam, a.subln_g);
        }
    SEAM2(); }

    for (int rep_ = 0; rep_ < REP_P3; ++rep_) {
        pg8::Gemm g{Dp, Wpool_t, M, D, 128, (size_t)M * 128 * 2}; pg8::StaticOrder S; S.init(M, D, G, bx);
        pg8::EpiMerge E{Ab, Gb, a.pool_scale, Mg};
        pg8::gemm_phase<pg8::EpiMerge, pg8::StaticOrder, true, true>(lds, g, S, E);
    SEAM2(); }

    for (int rep_ = 0; rep_ < REP_P4; ++rep_) {
        pg8::Gemm g{Mg, Wout_t, M, D, D, 0}; pg8::StaticOrder S; S.init(M, D, G, bx);
        pg8::EpiResA E{a.x, XN, ssq1};
        pg8::gemm_phase<pg8::EpiResA, pg8::StaticOrder, true, true>(lds, g, S, E);
    SEAM2(); }

    for (int rep_ = 0; rep_ < REP_P5; ++rep_) {
        pg8::Gemm g{XN, Wup_t, M, FF, D, 0}; pg8::StaticOrder S; S.init(M, FF, G, bx);
        pg8::EpiUp E{ssq1, Zb};
        pg8::gemm_phase<pg8::EpiUp, pg8::StaticOrder, true, true>(lds, g, S, E);
    SEAM2(); }

    {
        pg8::Gemm g{Zb, Wdown_t, M, D, FF, 0}; pg8::StaticOrder S; S.init(M, D, G, bx);
        pg8::EpiResB E{XN, ssq2};
        pg8::gemm_phase<pg8::EpiResB, pg8::StaticOrder, true, true>(lds, g, S, E);
    }
    SEAM2();

    { PHASE_IDS;
    const f32x4* gr = (const f32x4*)a.g_final + lane; f32x4 gg[4];
#pragma unroll
    for (int j = 0; j < 4; ++j) gg[j] = gr[64 * j];
    for (int m0 = gw * 4; m0 < M; m0 += NGW * 4) {
        unsigned long long v[4][4]; float s[4];
#pragma unroll
        for (int q = 0; q < 4; ++q) { const unsigned long long* xr = (const unsigned long long*)(XN + (size_t)(m0 + q) * D) + lane; s[q] = ssq2[(size_t)(m0 + q) * 16 + (lane & 15)];
#pragma unroll
            for (int j = 0; j < 4; ++j) v[q][j] = __builtin_nontemporal_load(xr + 64 * j); }
#pragma unroll
        for (int q = 0; q < 4; ++q) { float t = s[q]; t += xor_swz<1>(t); t += xor_swz<2>(t); t += xor_swz<4>(t); t += xor_swz<8>(t);
            const float rstd = __builtin_amdgcn_rsqf(t * (1.f / D) + RMS_EPS);
            f32x4* xr = (f32x4*)(a.out + (size_t)(m0 + q) * D) + lane;
#pragma unroll
            for (int j = 0; j < 4; ++j) { const unsigned lo = (unsigned)v[q][j], hi = (unsigned)(v[q][j] >> 32);
                const f32x4 x = (f32x4){pg8::bf_lo(lo), pg8::bf_hi(lo), pg8::bf_lo(hi), pg8::bf_hi(hi)};
                __builtin_nontemporal_store(x * rstd * gg[j], xr + 64 * j); } }
    } }
}

extern "C" void kernel_launch(void* const* d_in, const int* in_sizes, int n_in, void* d_out, int out_size, void* d_ws, size_t ws_size, hipStream_t stream) {
    static int grid = 0;
    if (grid == 0) {
        if (n_in != 16 || in_sizes[0] != M * D || out_size != M * D || ws_size < WS_END) { fprintf(stderr, "kernel_launch: unexpected shapes (n_in %d, in0 %d, out %d, ws %zu); nothing launched\n", n_in, n_in > 0 ? in_sizes[0] : -1, out_size, ws_size); grid = -1; return; }
        int dev = 0, cus = 0, per_cu = 0;
        if (hipGetDevice(&dev) != hipSuccess || hipDeviceGetAttribute(&cus, hipDeviceAttributeMultiprocessorCount, dev) != hipSuccess) { grid = -1; return; }
        if (hipFuncSetAttribute((const void*)hybrid_fwd, hipFuncAttributeMaxDynamicSharedMemorySize, LDS_BYTES) != hipSuccess) { fprintf(stderr, "kernel_launch: hipFuncSetAttribute failed\n"); grid = -1; return; }
        if (hipOccupancyMaxActiveBlocksPerMultiprocessor(&per_cu, (const void*)hybrid_fwd, NWAVES * 64, LDS_BYTES) != hipSuccess || per_cu < 1) per_cu = 1;
        (void)hipGetLastError();
        grid = cus * per_cu;
    }
    if (grid < 0) return;
    Args a{};
    a.x = (const float*)d_in[0]; a.pos = (const int*)d_in[1]; a.g_attn = (const float*)d_in[2]; a.w_in = (const float*)d_in[3];
    a.lq1 = (const float*)d_in[4]; a.lk1 = (const float*)d_in[5]; a.lq2 = (const float*)d_in[6]; a.lk2 = (const float*)d_in[7];
    a.subln_g = (const float*)d_in[8]; a.w_pool = (const float*)d_in[9]; a.pool_scale = (const float*)d_in[10]; a.w_out = (const float*)d_in[11];
    a.g_mlp = (const float*)d_in[12]; a.w_up = (const float*)d_in[13]; a.w_down = (const float*)d_in[14]; a.g_final = (const float*)d_in[15];
    a.out = (float*)d_out; a.ws = (unsigned char*)d_ws;
    void* args[] = {&a};
    const hipError_t e = hipLaunchCooperativeKernel((const void*)hybrid_fwd, dim3(grid), dim3(NWAVES * 64), args, LDS_BYTES, stream);
    if (e != hipSuccess) fprintf(stderr, "kernel_launch: cooperative launch failed: %s (grid %d)\n", hipGetErrorString(e), grid);
}
```

```cpp
#include <hip/hip_runtime.h>
#include <hip/hip_cooperative_groups.h>
#include <cstdio>
#include <cstdint>
#include <cmath>
namespace cg = cooperative_groups;
template <int K> __device__ __forceinline__ float xor_swz(float v) { return __int_as_float(__builtin_amdgcn_ds_swizzle(__float_as_int(v), (K << 10) | 0x1f)); }
__device__ __forceinline__ float half_sum(float v) { auto rr = __builtin_amdgcn_permlane32_swap(__float_as_uint(v), __float_as_uint(v), false, false); return __uint_as_float(rr[0]) + __uint_as_float(rr[1]); }
__device__ __forceinline__ float half_max(float v) { auto rr = __builtin_amdgcn_permlane32_swap(__float_as_uint(v), __float_as_uint(v), false, false); return fmaxf(__uint_as_float(rr[0]), __uint_as_float(rr[1])); }
namespace pg8 {
#define PG8_LAS __attribute__((address_space(3)))
typedef unsigned short bf16_t;
typedef short bf16x8 __attribute__((ext_vector_type(8)));
typedef float f32x4 __attribute__((ext_vector_type(4)));
typedef unsigned u32x4 __attribute__((ext_vector_type(4)));
constexpr int BM = 256, BK = 64, HALF = 128, HTB = HALF * BK * 2  , STAGE_BYTES = 8 * HTB, NXCD = 8, WGM = 8;

__host__ __device__ __forceinline__ int lds_byte(int r, int c) { const int st = (r >> 4) * 2 + (c >> 5), rr = r & 15, cc = c & 31, ob = rr * 64 + cc * 2; return st * 1024 + (ob ^ (((ob >> 9) & 1) << 5)); }
__host__ __device__ __forceinline__ void stage_rc(int b, int& R, int& C) { const int st = b / 1024, sb = b % 1024, swz = sb ^ (((sb >> 9) & 1) << 5); R = (st >> 1) * 16 + swz / 64; C = (st & 1) * 32 + (swz % 64) / 2; }
__host__ __device__ __forceinline__ int perm32(int rho) { const int n = rho >> 4, i = rho & 15; return 8 * (i >> 2) + 4 * n + (i & 3); }

struct Unit { int pm, pn; };
struct Gemm { const bf16_t* A; const bf16_t* Bt; int M, N, K; size_t a_pn_off; };

struct StaticOrder {
    int nM, nN, nwg, G, c;
    __host__ __device__ void init(int M, int N, int G_, int c_) { nM = M / BM; nN = N / BM; nwg = nM * nN; G = G_; c = c_; }
    __host__ __device__ bool next(int i, Unit& u) const {
        const long L = (long)i * G + c; if (L >= nwg) return false;
        int wgid = (int)L; { const int q = nwg / NXCD, r = nwg % NXCD, xcd = wgid % NXCD, off = wgid / NXCD; wgid = (xcd < r ? xcd * (q + 1) : r * (q + 1) + (xcd - r) * q) + off; }
        const int nig = WGM * nN, gid = wgid / nig, fm = gid * WGM, gsz = (nM - fm) < WGM ? (nM - fm) : WGM;
        u.pm = fm + ((wgid % nig) % gsz); u.pn = (wgid % nig) / gsz; return true;
    }
    __device__ __forceinline__ void a_ready(const Unit&) const {}
    __device__ __forceinline__ void done(const Unit&) const {}
};

__device__ __forceinline__ unsigned cvt_pk_bf16(float lo, float hi) { unsigned r; asm volatile("v_cvt_pk_bf16_f32 %0, %1, %2" : "=v"(r) : "v"(lo), "v"(hi)); return r; }
typedef float f32x2 __attribute__((ext_vector_type(2)));
template <class Epi, class Sched, bool ALIGN_EPI = false, bool SP2 = false>
__device__ __forceinline__ void gemm_phase(PG8_LAS unsigned char* lds, const Gemm g, const Sched& S, const Epi& E) {
    int tid = threadIdx.x; asm volatile("" : "+v"(tid));
    const int wid = __builtin_amdgcn_readfirstlane(tid >> 6), lane = tid & 63, wr = wid >> 2, wc = wid & 3, fr = lane & 15, fq = lane >> 4;
    const int K = g.K, nt = K / BK;
    unsigned voffA[2], voffB[2];
#pragma unroll
    for (int i = 0; i < 2; ++i) { int R, C; stage_rc(tid * 16 + i * 8192, R, C); const int Rb = Epi::PERM ? ((R & ~31) + perm32(R & 31)) : R;
        voffA[i] = (unsigned)(R * K + C) * 2u; voffB[i] = (unsigned)(Rb * K + C) * 2u; }
    const size_t kstep = (size_t)(BK * 2);
    const size_t hstep = (size_t)HALF * K * 2;
    const size_t tstep = 2 * hstep;
    const unsigned ldsw = (unsigned)wid * 1024u;
    const int aoff = lds_byte(wr * 64 + fr, fq * 8), boff = lds_byte(wc * 32 + fr, fq * 8);
#define PG8_SA(b, h) (((b) * 2 + (h)) * HTB)
#define PG8_SB(b, h) ((4 + (b) * 2 + (h)) * HTB)
#define PG8_STAGE(bufoff, gbase, voff) do { _Pragma("unroll") for (int _i = 0; _i < 2; ++_i) \
        __builtin_amdgcn_global_load_lds((const unsigned*)((const char*)(gbase) + (voff)[_i]), (PG8_LAS unsigned*)(lds + (bufoff) + ldsw + _i * 8192), 16, 0, 0); } while (0)
#define PG8_LDA(dst, b, h) do { _Pragma("unroll") for (int m = 0; m < 4; ++m) _Pragma("unroll") for (int k = 0; k < 2; ++k) dst[m][k] = *(const PG8_LAS bf16x8*)(lds + PG8_SA(b, h) + aoff + m * 2048 + k * 1024); } while (0)
#define PG8_LDB(dst, b, h) do { _Pragma("unroll") for (int n = 0; n < 2; ++n) _Pragma("unroll") for (int k = 0; k < 2; ++k) dst[n][k] = *(const PG8_LAS bf16x8*)(lds + PG8_SB(b, h) + boff + n * 2048 + k * 1024); } while (0)
#define PG8_MMA(ai, bj, At, Bt) do { __builtin_amdgcn_s_setprio(1); _Pragma("unroll") for (int m = 0; m < 4; ++m) _Pragma("unroll") for (int n = 0; n < 2; ++n) _Pragma("unroll") for (int k = 0; k < 2; ++k) \
        acc[ai][bj][m][n] = __builtin_amdgcn_mfma_f32_16x16x32_bf16(Bt[n][k], At[m][k], acc[ai][bj][m][n], 0, 0, 0); __builtin_amdgcn_s_setprio(0); } while (0)
#define PG8_WAIT_V(n) asm volatile("s_waitcnt vmcnt(" #n ")" ::: "memory")
#define PG8_WAIT_L(n) asm volatile("s_waitcnt lgkmcnt(" #n ")" ::: "memory")
#define PG8_BAR __builtin_amdgcn_s_barrier()
#define PG8_SCHED __builtin_amdgcn_sched_barrier(0)
    Unit cur, nxt; int ui = 0;
    if (!S.next(0, cur)) return;
    f32x4 acc[2][2][4][2];
#pragma unroll
    for (int a = 0; a < 2; ++a)
#pragma unroll
        for (int b = 0; b < 2; ++b)
#pragma unroll
            for (int m = 0; m < 4; ++m)
#pragma unroll
                for (int n = 0; n < 2; ++n) acc[a][b][m][n] = (f32x4){0.f, 0.f, 0.f, 0.f};
    bf16x8 At[4][2], B0[2][2], B1[2][2];
    const char* cA = (const char*)g.A + (size_t)cur.pm * tstep + (size_t)cur.pn * g.a_pn_off; const char* cB = (const char*)g.Bt + (size_t)cur.pn * tstep;
    S.a_ready(cur);
    if constexpr (SP2) {
        PG8_STAGE(PG8_SB(0, 0), cB, voffB); PG8_STAGE(PG8_SB(0, 1), cB + hstep, voffB); PG8_STAGE(PG8_SA(0, 0), cA, voffA); PG8_STAGE(PG8_SA(0, 1), cA + hstep, voffA);
        if (wr == 1) PG8_BAR;
        PG8_WAIT_V(2); PG8_BAR;
        PG8_STAGE(PG8_SB(1, 0), cB + kstep, voffB); PG8_STAGE(PG8_SA(1, 0), cA + kstep, voffA); PG8_STAGE(PG8_SB(1, 1), cB + hstep + kstep, voffB);
        PG8_WAIT_V(6); PG8_BAR;
    } else {
        PG8_STAGE(PG8_SB(0, 0), cB, voffB); PG8_STAGE(PG8_SA(0, 0), cA, voffA); PG8_STAGE(PG8_SB(0, 1), cB + hstep, voffB); PG8_STAGE(PG8_SA(0, 1), cA + hstep, voffA);
        if (wr == 1) PG8_BAR;
        PG8_WAIT_V(4); PG8_BAR;
        PG8_STAGE(PG8_SB(1, 0), cB + kstep, voffB); PG8_STAGE(PG8_SA(1, 0), cA + kstep, voffA); PG8_STAGE(PG8_SB(1, 1), cB + hstep + kstep, voffB);
        PG8_WAIT_V(6); PG8_BAR;
    }
    for (;;) {
        const bool has_next = S.next(ui + 1, nxt);
        const char* nA = has_next ? (const char*)g.A + (size_t)nxt.pm * tstep + (size_t)nxt.pn * g.a_pn_off : cA; const char* nB = has_next ? (const char*)g.Bt + (size_t)nxt.pn * tstep : cB;
        for (int t = 0; t < nt; t += 2) {
            const bool last = (t == nt - 2);
            const char* a1 = cA + (size_t)(t + 1) * kstep;
            const char* a2 = last ? nA : cA + (size_t)(t + 2) * kstep; const char* b2 = last ? nB : cB + (size_t)(t + 2) * kstep;
            const char* a3 = a2 + kstep; const char* b3 = b2 + kstep;
            if (last && has_next) S.a_ready(nxt);
            if constexpr (SP2) {
            PG8_LDB(B0, 0, 0); PG8_LDB(B1, 0, 1); PG8_SCHED; PG8_LDA(At, 0, 0); PG8_STAGE(PG8_SA(1, 1), a1 + hstep, voffA);
            PG8_WAIT_V(8); PG8_WAIT_L(0); PG8_BAR; PG8_MMA(0, 0, At, B0); PG8_MMA(0, 1, At, B1); PG8_BAR; PG8_SCHED;
            PG8_LDA(At, 0, 1); PG8_STAGE(PG8_SB(0, 0), b2, voffB); PG8_STAGE(PG8_SB(0, 1), b2 + hstep, voffB); PG8_STAGE(PG8_SA(0, 0), a2, voffA);
            PG8_WAIT_V(8); PG8_WAIT_L(0); PG8_BAR; PG8_MMA(1, 0, At, B0); PG8_MMA(1, 1, At, B1); PG8_BAR; PG8_SCHED;
            PG8_LDB(B0, 1, 0); PG8_LDB(B1, 1, 1); PG8_SCHED; PG8_LDA(At, 1, 0); PG8_STAGE(PG8_SA(0, 1), a2 + hstep, voffA);
            PG8_WAIT_V(8); PG8_WAIT_L(0); PG8_BAR; PG8_MMA(0, 0, At, B0); PG8_MMA(0, 1, At, B1); PG8_BAR; PG8_SCHED;
            PG8_LDA(At, 1, 1); PG8_STAGE(PG8_SB(1, 0), b3, voffB); PG8_STAGE(PG8_SB(1, 1), b3 + hstep, voffB); PG8_STAGE(PG8_SA(1, 0), a3, voffA);
            PG8_WAIT_V(8); PG8_WAIT_L(0); PG8_BAR; PG8_MMA(1, 0, At, B0); PG8_MMA(1, 1, At, B1); PG8_BAR; PG8_SCHED;
            } else {
            PG8_LDB(B0, 0, 0); PG8_SCHED; PG8_LDA(At, 0, 0); PG8_STAGE(PG8_SA(1, 1), a1 + hstep, voffA);
            PG8_WAIT_L(8); PG8_BAR; PG8_WAIT_L(0); PG8_MMA(0, 0, At, B0); PG8_BAR; PG8_SCHED;
            PG8_LDB(B1, 0, 1); PG8_STAGE(PG8_SB(0, 0), b2, voffB);
            PG8_BAR; PG8_WAIT_L(0); PG8_MMA(0, 1, At, B1); PG8_BAR;
            PG8_LDA(At, 0, 1); PG8_STAGE(PG8_SA(0, 0), a2, voffA);
            PG8_BAR; PG8_WAIT_L(0); PG8_MMA(1, 0, At, B0); PG8_BAR; PG8_SCHED;
            PG8_STAGE(PG8_SB(0, 1), b2 + hstep, voffB);
            PG8_WAIT_V(6); PG8_BAR; PG8_MMA(1, 1, At, B1); PG8_BAR;
            PG8_LDB(B0, 1, 0); PG8_SCHED; PG8_LDA(At, 1, 0); PG8_STAGE(PG8_SA(0, 1), a2 + hstep, voffA);
            PG8_WAIT_L(8); PG8_BAR; PG8_WAIT_L(0); PG8_MMA(0, 0, At, B0); PG8_BAR; PG8_SCHED;
            PG8_LDB(B1, 1, 1); PG8_STAGE(PG8_SB(1, 0), b3, voffB);
            PG8_BAR; PG8_WAIT_L(0); PG8_MMA(0, 1, At, B1); PG8_BAR;
            PG8_LDA(At, 1, 1); PG8_STAGE(PG8_SA(1, 0), a3, voffA);
            PG8_BAR; PG8_WAIT_L(0); PG8_MMA(1, 0, At, B0); PG8_BAR; PG8_SCHED;
            PG8_STAGE(PG8_SB(1, 1), b3 + hstep, voffB);
            PG8_WAIT_V(6); PG8_BAR; PG8_MMA(1, 1, At, B1); PG8_BAR;
            }
        }
        if constexpr (ALIGN_EPI) { if (wr == 0) PG8_BAR; }
        if constexpr (!Epi::AFTER_DRAIN) { E(acc, cur, wr, wc, fr, fq); S.done(cur); }
        if (!has_next) break;
#pragma unroll
        for (int a = 0; a < 2; ++a)
#pragma unroll
            for (int b = 0; b < 2; ++b)
#pragma unroll
                for (int m = 0; m < 4; ++m)
#pragma unroll
                    for (int n = 0; n < 2; ++n) acc[a][b][m][n] = (f32x4){0.f, 0.f, 0.f, 0.f};
        cur = nxt; cA = nA; cB = nB; ++ui;
        if constexpr (ALIGN_EPI) { if (wr == 1) PG8_BAR; }
    }
    PG8_WAIT_V(0);
    if constexpr (!ALIGN_EPI) { if (wr == 0) PG8_BAR; }
    PG8_BAR;
    if constexpr (Epi::AFTER_DRAIN) { E.fused(acc, cur, wr, wc, fr, fq, lds, wid, lane); S.done(cur); }
#undef PG8_SA
#undef PG8_SB
#undef PG8_STAGE
#undef PG8_LDA
#undef PG8_LDB
#undef PG8_MMA
#undef PG8_WAIT_V
#undef PG8_WAIT_L
#undef PG8_BAR
#undef PG8_SCHED
}
}
namespace pg8 {
typedef unsigned u32x2 __attribute__((ext_vector_type(2)));
__device__ __forceinline__ float bf_lo(unsigned w) { return __uint_as_float(w << 16); }
__device__ __forceinline__ float bf_hi(unsigned w) { return __uint_as_float(w & 0xffff0000u); }
__device__ __forceinline__ u32x4 pack8(const f32x4 a, const f32x4 b) { u32x4 w; w.x = cvt_pk_bf16(a[0], a[1]); w.y = cvt_pk_bf16(a[2], a[3]); w.z = cvt_pk_bf16(b[0], b[1]); w.w = cvt_pk_bf16(b[2], b[3]); return w; }
constexpr float QSCALE = 0.125f * 1.4426950408889634f;

struct EpiIn {
    static constexpr bool PERM = true, AFTER_DRAIN = false;
    bf16_t *Q, *K, *V, *U, *G; const float* rope;
    __device__ __forceinline__ void operator()(const f32x4 (&acc)[2][2][4][2], const Unit& u, int wr, int wc, int fr, int fq) const {
        const int pn = u.pn; int kind, ldc, colt; bf16_t* base;
        if (pn < 4)       { kind = 0; base = Q; ldc = 1024; colt = pn * 256; }
        else if (pn < 8)  { kind = 1; base = K; ldc = 1024; colt = (pn - 4) * 256; }
        else if (pn < 12) { kind = 2; base = V; ldc = 1024; colt = (pn - 8) * 256; }
        else if (pn < 14) { kind = 2; base = U; ldc = 512;  colt = (pn - 12) * 256; }
        else              { kind = 3; base = G; ldc = 2048; colt = (pn - 14) * 256; }
        const int row0 = u.pm * BM + wr * 64 + fr, col0 = colt + wc * 32 + 8 * fq;
        const bool rl = ((wc & 1) == 0) && (fq < 2);
#pragma unroll
        for (int ai = 0; ai < 2; ++ai)
#pragma unroll
            for (int m = 0; m < 4; ++m) {
                const int row = row0 + ai * HALF + m * 16;
                bf16_t* rowp = base + (size_t)row * ldc + col0;
                if (kind <= 1) {
                    f32x4 c0, c1;
                    if (rl) { const f32x4* rp = (const f32x4*)(rope + (size_t)row * 16 + 8 * fq); c0 = rp[0]; c1 = rp[1]; }
#pragma unroll
                    for (int bj = 0; bj < 2; ++bj) {
                        f32x4 v0 = acc[ai][bj][m][0], v1 = acc[ai][bj][m][1];
                        if (rl) {
                            const float a0 = v0[0], b0 = v0[1], a1 = v0[2], b1 = v0[3], a2 = v1[0], b2 = v1[1], a3 = v1[2], b3 = v1[3];
                            v0[0] = a0 * c0[0] - b0 * c0[1]; v0[1] = b0 * c0[0] + a0 * c0[1]; v0[2] = a1 * c0[2] - b1 * c0[3]; v0[3] = b1 * c0[2] + a1 * c0[3];
                            v1[0] = a2 * c1[0] - b2 * c1[1]; v1[1] = b2 * c1[0] + a2 * c1[1]; v1[2] = a3 * c1[2] - b3 * c1[3]; v1[3] = b3 * c1[2] + a3 * c1[3];
                        }
                        if (kind == 0) { v0 = v0 * QSCALE; v1 = v1 * QSCALE; }
                        __builtin_nontemporal_store(pack8(v0, v1), (u32x4*)(rowp + bj * HALF));
                    }
                } else {
#pragma unroll
                    for (int bj = 0; bj < 2; ++bj) {
                        f32x4 v0 = acc[ai][bj][m][0], v1 = acc[ai][bj][m][1];
                        if (kind == 3) {
#pragma unroll
                            for (int e = 0; e < 4; ++e) { v0[e] = __builtin_amdgcn_rcpf(1.f + __builtin_amdgcn_exp2f(v0[e])); v1[e] = __builtin_amdgcn_rcpf(1.f + __builtin_amdgcn_exp2f(v1[e])); }
                        }
                        __builtin_nontemporal_store(pack8(v0, v1), (u32x4*)(rowp + bj * HALF));
                    }
                }
            }
    }
};

struct EpiMerge {
    static constexpr bool PERM = true, AFTER_DRAIN = false;
    const bf16_t* A; const bf16_t* G; const float* pscale; bf16_t* Mg;
    __device__ __forceinline__ void operator()(const f32x4 (&acc)[2][2][4][2], const Unit& u, int wr, int wc, int fr, int fq) const {
        const int row0 = u.pm * BM + wr * 64 + fr, col0 = u.pn * BM + wc * 32 + 8 * fq;
        f32x4 ps[2][2];
#pragma unroll
        for (int bj = 0; bj < 2; ++bj) { ps[bj][0] = *(const f32x4*)(pscale + col0 + bj * HALF); ps[bj][1] = *(const f32x4*)(pscale + col0 + bj * HALF + 4); }
#pragma unroll
        for (int ai = 0; ai < 2; ++ai)
#pragma unroll
            for (int m = 0; m < 4; ++m) {
                const size_t row = (size_t)(row0 + ai * HALF + m * 16);
#pragma unroll
                for (int bj = 0; bj < 2; ++bj) {
                    const int c = col0 + bj * HALF;
                    const u32x4 a8 = __builtin_nontemporal_load((const u32x4*)(A + row * 1024 + c)), ga = __builtin_nontemporal_load((const u32x4*)(G + row * 2048 + c)), gp = __builtin_nontemporal_load((const u32x4*)(G + row * 2048 + 1024 + c));
                    const f32x4 y0 = acc[ai][bj][m][0] * ps[bj][0], y1 = acc[ai][bj][m][1] * ps[bj][1];
                    f32x4 o0, o1;
                    o0[0] = bf_lo(ga.x) * bf_lo(a8.x) + bf_lo(gp.x) * y0[0]; o0[1] = bf_hi(ga.x) * bf_hi(a8.x) + bf_hi(gp.x) * y0[1];
                    o0[2] = bf_lo(ga.y) * bf_lo(a8.y) + bf_lo(gp.y) * y0[2]; o0[3] = bf_hi(ga.y) * bf_hi(a8.y) + bf_hi(gp.y) * y0[3];
                    o1[0] = bf_lo(ga.z) * bf_lo(a8.z) + bf_lo(gp.z) * y1[0]; o1[1] = bf_hi(ga.z) * bf_hi(a8.z) + bf_hi(gp.z) * y1[1];
                    o1[2] = bf_lo(ga.w) * bf_lo(a8.w) + bf_lo(gp.w) * y1[2]; o1[3] = bf_hi(ga.w) * bf_hi(a8.w) + bf_hi(gp.w) * y1[3];
                    __builtin_nontemporal_store(pack8(o0, o1), (u32x4*)(Mg + row * 1024 + c));
                }
                asm volatile("" ::: "memory");
            }
    }
};

struct EpiResA {
    static constexpr bool PERM = true, AFTER_DRAIN = false;
    const float* xi; bf16_t* xb; float* ssq;
    __device__ __forceinline__ void operator()(const f32x4 (&acc)[2][2][4][2], const Unit& u, int wr, int wc, int fr, int fq) const {
        const int row0 = u.pm * BM + wr * 64 + fr, col0 = u.pn * BM + wc * 32 + 8 * fq;
#pragma unroll
        for (int ai = 0; ai < 2; ++ai)
#pragma unroll
            for (int m = 0; m < 4; ++m) {
                const size_t row = (size_t)(row0 + ai * HALF + m * 16); float s = 0.f;
#pragma unroll
                for (int bj = 0; bj < 2; ++bj) {
                    const size_t off = row * 1024 + col0 + bj * HALF;
                    const f32x4 r0 = __builtin_nontemporal_load((const f32x4*)(xi + off)) + acc[ai][bj][m][0], r1 = __builtin_nontemporal_load((const f32x4*)(xi + off + 4)) + acc[ai][bj][m][1];
                    *(u32x4*)(xb + off) = pack8(r0, r1);
                    s += (r0[0] * r0[0] + r0[1] * r0[1]) + (r0[2] * r0[2] + r0[3] * r0[3]) + (r1[0] * r1[0] + r1[1] * r1[1]) + (r1[2] * r1[2] + r1[3] * r1[3]);
                }
                s += xor_swz<16>(s); s = half_sum(s);
                if (fq == 0) ssq[row * 16 + u.pn * 4 + wc] = s;
            }
    }
};
struct EpiResB {
    static constexpr bool PERM = true, AFTER_DRAIN = false;
    bf16_t* xb; float* ssq;
    __device__ __forceinline__ void operator()(const f32x4 (&acc)[2][2][4][2], const Unit& u, int wr, int wc, int fr, int fq) const {
        const int row0 = u.pm * BM + wr * 64 + fr, col0 = u.pn * BM + wc * 32 + 8 * fq;
#pragma unroll
        for (int ai = 0; ai < 2; ++ai)
#pragma unroll
            for (int m = 0; m < 4; ++m) {
                const size_t row = (size_t)(row0 + ai * HALF + m * 16); float s = 0.f;
#pragma unroll
                for (int bj = 0; bj < 2; ++bj) {
                    const size_t off = row * 1024 + col0 + bj * HALF;
                    const u32x4 w = __builtin_nontemporal_load((const u32x4*)(xb + off));
                    const f32x4 r0 = (f32x4){bf_lo(w.x), bf_hi(w.x), bf_lo(w.y), bf_hi(w.y)} + acc[ai][bj][m][0], r1 = (f32x4){bf_lo(w.z), bf_hi(w.z), bf_lo(w.w), bf_hi(w.w)} + acc[ai][bj][m][1];
                    __builtin_nontemporal_store(pack8(r0, r1), (u32x4*)(xb + off));
                    s += (r0[0] * r0[0] + r0[1] * r0[1]) + (r0[2] * r0[2] + r0[3] * r0[3]) + (r1[0] * r1[0] + r1[1] * r1[1]) + (r1[2] * r1[2] + r1[3] * r1[3]);
                }
                s += xor_swz<16>(s); s = half_sum(s);
                if (fq == 0) ssq[row * 16 + u.pn * 4 + wc] = s;
            }
    }
};

struct EpiUp {
    static constexpr bool PERM = true, AFTER_DRAIN = false;
    const float* ssq; bf16_t* Z;
    __device__ __forceinline__ void operator()(const f32x4 (&acc)[2][2][4][2], const Unit& u, int wr, int wc, int fr, int fq) const {
        typedef float f32x2v __attribute__((ext_vector_type(2)));
        const int row0 = u.pm * BM + wr * 64 + fr, col0 = u.pn * BM + wc * 32 + 8 * fq;
#pragma unroll
        for (int ai = 0; ai < 2; ++ai)
#pragma unroll
            for (int m = 0; m < 4; ++m) {
                const size_t row = (size_t)(row0 + ai * HALF + m * 16);
                const f32x4 pq = *(const f32x4*)(ssq + row * 16 + 4 * fq);
                float s = (pq[0] + pq[1]) + (pq[2] + pq[3]); s += xor_swz<16>(s); s = half_sum(s);
                const float r2 = __builtin_amdgcn_rcpf(s * (1.0f / 1024.0f) + 1e-6f);
                const f32x2v r2v = {r2, r2};
#pragma unroll
                for (int bj = 0; bj < 2; ++bj) {
                    f32x4 v0 = acc[ai][bj][m][0], v1 = acc[ai][bj][m][1];
#pragma unroll
                    for (int e = 0; e < 4; ++e) { v0[e] = fmaxf(v0[e], 0.f); v1[e] = fmaxf(v1[e], 0.f); }
                    f32x2v a = {v0[0], v0[1]}, b = {v0[2], v0[3]}, c = {v1[0], v1[1]}, d = {v1[2], v1[3]};
                    a = (a * a) * r2v; b = (b * b) * r2v; c = (c * c) * r2v; d = (d * d) * r2v;
                    u32x4 w; w.x = cvt_pk_bf16(a.x, a.y); w.y = cvt_pk_bf16(b.x, b.y); w.z = cvt_pk_bf16(c.x, c.y); w.w = cvt_pk_bf16(d.x, d.y);
                    __builtin_nontemporal_store(w, (u32x4*)(Z + row * 4096 + col0 + bj * HALF));
                }
            }
    }
};
}
namespace att {
#define ATT_LAS __attribute__((address_space(3)))
typedef unsigned short bf16_t;
typedef short bf16x8 __attribute__((ext_vector_type(8)));
typedef short s16x4 __attribute__((ext_vector_type(4)));
typedef float f32x16 __attribute__((ext_vector_type(16)));
typedef unsigned u32x4 __attribute__((ext_vector_type(4)));
constexpr int SEQ = 4096, PITCH = 1024;
constexpr int KBUF = 0, VBUF = 32768, WSF = 65536, QBUF = 65536 + 4096, ATT_LDS_BYTES = QBUF + 8 * 8192;
constexpr float THR = 8.0f;
__device__ __forceinline__ int crow(int r, int hi) { return (r & 3) + 8 * (r >> 2) + 4 * hi; }
__device__ __forceinline__ int koffs(int row, int ch) { return row * 256 + ((ch ^ (row & 15)) << 4); }
__device__ __forceinline__ int voffs(int row, int ch) { return 2048 * (row >> 3) + 512 * (ch >> 2) + 64 * (row & 7) + 16 * ((ch & 3) ^ ((row >> 2) & 3)); }
__device__ __forceinline__ unsigned cvtpk(float lo, float hi) { unsigned r; asm volatile("v_cvt_pk_bf16_f32 %0, %1, %2" : "=v"(r) : "v"(lo), "v"(hi)); return r; }
__device__ __forceinline__ s16x4 vtr(const ATT_LAS unsigned char* p) { return __builtin_bit_cast(s16x4, __builtin_amdgcn_ds_read_tr16_b64_v4i16((ATT_LAS s16x4*)p)); }
__device__ __forceinline__ int sub1(int a) { int v = a ^ 128; asm volatile("" : "+v"(v)); return v; }
__device__ __forceinline__ void glds16(const char* sbase, unsigned voff, unsigned lds_dst) { unsigned keep;
    asm volatile("s_mov_b32 %0, m0\n\ts_mov_b32 m0, %3\n\ts_nop 0\n\tglobal_load_lds_dwordx4 %1, %2\n\ts_mov_b32 m0, %0" : "=&s"(keep) : "v"(voff), "s"(sbase), "s"(lds_dst) : "memory"); }
#define ATT_MFMA(a, b, c) __builtin_amdgcn_mfma_f32_32x32x16_bf16((a), (b), (c), 0, 0, 0)

template <bool C1> __device__ __forceinline__ void qk_issue(f32x16& s0, const ATT_LAS unsigned char* kb, const ATT_LAS unsigned char* qb_, const int (&kaddr)[4]) {
#pragma unroll
    for (int i = 0; i < 16; ++i) s0[i] = 0.f;
#pragma unroll
    for (int ds = 0; ds < 4; ++ds) {
        const int ad = C1 ? sub1(kaddr[ds]) : kaddr[ds];
        const bf16x8 a0 = *(const ATT_LAS bf16x8*)(kb + ad);
        const bf16x8 qv = *(const ATT_LAS bf16x8*)(qb_ + ad);
        s0 = ATT_MFMA(a0, qv, s0);
    }
}
__device__ __forceinline__ void rowmax_rescale(bool MASK, f32x16& s0, f32x16 (&O)[4], float& m, float& l, int kvr, int r, int h, ATT_LAS float* wsf) {
    if (MASK) {
        asm volatile("" ::: "memory");
        const int d = r - 4 * h - kvr;
#pragma unroll
        for (int i = 0; i < 16; ++i) { if (((i & 3) + 8 * (i >> 2)) > d) s0[i] = -INFINITY; }
    }
    float ra = __builtin_fmaxf(__builtin_fmaxf(s0[0], s0[1]), s0[2]), rb = __builtin_fmaxf(__builtin_fmaxf(s0[3], s0[4]), s0[5]);
    ra = __builtin_fmaxf(__builtin_fmaxf(ra, s0[6]), s0[7]); rb = __builtin_fmaxf(__builtin_fmaxf(rb, s0[8]), s0[9]);
    ra = __builtin_fmaxf(__builtin_fmaxf(ra, s0[10]), s0[11]); rb = __builtin_fmaxf(__builtin_fmaxf(rb, s0[12]), s0[13]);
    ra = __builtin_fmaxf(__builtin_fmaxf(ra, s0[14]), s0[15]);
    const float rm = half_max(__builtin_fmaxf(ra, rb));
    if (__any(rm > m + THR)) {
        const float mn = fmaxf(m, rm), al = __builtin_amdgcn_exp2f(m - mn);
        l *= al; m = mn;
        if (h == 0) wsf[r] = al;
#pragma unroll
        for (int i = 0; i < 16; ++i) { const float a = wsf[crow(i, h)];
#pragma unroll
            for (int db = 0; db < 4; ++db) O[db][i] *= a; }
    }
}
template <bool HAS_PV, bool HAS_QK, bool C1>
__device__ __forceinline__ float step_fused(f32x16& Scur, float m, float& l, u32x4 (&pkout)[2],
                                           f32x16 (&Opv)[4], const u32x4 (&pkin)[2], const ATT_LAS unsigned char* vb, const int (&vaddr)[2],
                                           f32x16& Snext, const ATT_LAS unsigned char* kb, const ATT_LAS unsigned char* qb_, const int (&kaddr)[4]) {
    s16x4 vlo[2], vhi[2]; bf16x8 ka, qa;
    if (HAS_PV) {
#pragma unroll
        for (int u = 0; u < 2; ++u) { vlo[u] = vtr(vb + vaddr[0] + u * 512); vhi[u] = vtr(vb + vaddr[1] + u * 512); } }
    if (HAS_QK) { const int ad = C1 ? sub1(kaddr[0]) : kaddr[0]; ka = *(const ATT_LAS bf16x8*)(kb + ad); qa = *(const ATT_LAS bf16x8*)(qb_ + ad);
#pragma unroll
        for (int i = 0; i < 16; ++i) Snext[i] = 0.f; }
    float sa = 0.f, sb = 0.f;
#pragma unroll
    for (int g = 0; g < 4; ++g) {
        s16x4 nlo[2], nhi[2]; bf16x8 nk, nq;
        if (g < 3) {
            if (HAS_PV) {
#pragma unroll
                for (int u = 0; u < 2; ++u) { const int off = (2 * ((g + 1) & 1) + u) * 512 + ((g + 1) >> 1) * 4096; nlo[u] = vtr(vb + vaddr[0] + off); nhi[u] = vtr(vb + vaddr[1] + off); } }
            if (HAS_QK) { const int ad = C1 ? sub1(kaddr[g + 1]) : kaddr[g + 1]; nk = *(const ATT_LAS bf16x8*)(kb + ad); nq = *(const ATT_LAS bf16x8*)(qb_ + ad); }
        }
        if (HAS_PV) { const bf16x8 pa = __builtin_bit_cast(bf16x8, pkin[g >> 1]);
#pragma unroll
            for (int u = 0; u < 2; ++u) { const bf16x8 vf = __builtin_shufflevector(vlo[u], vhi[u], 0, 1, 2, 3, 4, 5, 6, 7); Opv[2 * (g & 1) + u] = ATT_MFMA(pa, vf, Opv[2 * (g & 1) + u]); } }
        if (HAS_QK) Snext = ATT_MFMA(ka, qa, Snext);
#pragma unroll
        for (int e = 4 * g; e < 4 * g + 4; e += 2) { Scur[e] = __builtin_amdgcn_exp2f(Scur[e] - m); Scur[e + 1] = __builtin_amdgcn_exp2f(Scur[e + 1] - m); sa += Scur[e]; sb += Scur[e + 1]; }
        if (g & 1) pkout[g >> 1] = (u32x4){cvtpk(Scur[4 * g - 4], Scur[4 * g - 3]), cvtpk(Scur[4 * g - 2], Scur[4 * g - 1]), cvtpk(Scur[4 * g], Scur[4 * g + 1]), cvtpk(Scur[4 * g + 2], Scur[4 * g + 3])};
        if (g < 3) {
            if (HAS_PV) {
#pragma unroll
                for (int u = 0; u < 2; ++u) { vlo[u] = nlo[u]; vhi[u] = nhi[u]; } }
            if (HAS_QK) { ka = nk; qa = nq; }
        }
        __builtin_amdgcn_sched_barrier(0);
    }
    l += sa + sb;
    return sa + sb;
}
__device__ __forceinline__ void pv_issue(f32x16 (&O)[4], const u32x4 (&pk)[2], const ATT_LAS unsigned char* vb, const int (&vaddr)[2]) {
#pragma unroll
    for (int s_ = 0; s_ < 2; ++s_) { const bf16x8 pa = __builtin_bit_cast(bf16x8, pk[s_]);
#pragma unroll
        for (int db = 0; db < 4; ++db) {
            const s16x4 lo = vtr(vb + vaddr[0] + db * 512 + s_ * 4096), hi = vtr(vb + vaddr[1] + db * 512 + s_ * 4096);
            const bf16x8 vf = __builtin_shufflevector(lo, hi, 0, 1, 2, 3, 4, 5, 6, 7);
            O[db] = ATT_MFMA(pa, vf, O[db]); } }
}

__device__ __forceinline__ void apply_mask(bool MASK, f32x16& s0, int kvr, int r, int h) {
    if (MASK) {
        asm volatile("" ::: "memory");
        const int d = r - 4 * h - kvr;
#pragma unroll
        for (int i = 0; i < 16; ++i) { if (((i & 3) + 8 * (i >> 2)) > d) s0[i] = -INFINITY; }
    }
}
constexpr float GUARD = 65536.0f;
template <bool C1> __device__ __forceinline__ void slow_step(bool MASK, f32x16& S, const ATT_LAS unsigned char* kb, const ATT_LAS unsigned char* qbase, const int (&kaddr)[4], const int (&vaddr)[2],
                                                             f32x16 (&O)[4], float& m, float& l, float l_saved, int kvr, int r, int h, ATT_LAS float* wsf, u32x4 (&pk)[2]) {
    l = l_saved;
    qk_issue<C1>(S, kb, qbase, kaddr);
    rowmax_rescale(MASK, S, O, m, l, kvr, r, h, wsf);
    f32x16 dummy;
    step_fused<false, false, false>(S, m, l, pk, O, pk, kb, vaddr, dummy, kb, qbase, kaddr);
}
__device__ __forceinline__ void tile_body(bool MASK, const ATT_LAS unsigned char* kb, const ATT_LAS unsigned char* vb, const ATT_LAS unsigned char* qbase, const int (&kaddr)[4], const int (&vaddr)[2],
                                                               f32x16 (&O1)[4], f32x16 (&O2)[4], float& m1, float& m2, float& l1, float& l2, int kvrel, int r, int h, ATT_LAS float* wsf) {
    f32x16 Sa, Sb; u32x4 pkA[2], pkB[2]; float ls, sm;
    qk_issue<false>(Sa, kb, qbase, kaddr);
    apply_mask(MASK, Sa, kvrel, r, h); ls = l1;
    sm = step_fused<false, true, true>(Sa, m1, l1, pkA, O1, pkA, vb, vaddr, Sb, kb, qbase, kaddr);
    if (__any(!(sm <= GUARD))) slow_step<false>(MASK, Sa, kb, qbase, kaddr, vaddr, O1, m1, l1, ls, kvrel, r, h, wsf, pkA);
    apply_mask(MASK, Sb, kvrel, r, h); ls = l2;
    sm = step_fused<true, true, false>(Sb, m2, l2, pkB, O1, pkA, vb, vaddr, Sa, kb + 8192, qbase, kaddr);
    if (__any(!(sm <= GUARD))) slow_step<true>(MASK, Sb, kb, qbase, kaddr, vaddr, O2, m2, l2, ls, kvrel, r, h, wsf, pkB);
    apply_mask(MASK, Sa, kvrel + 32, r, h); ls = l1;
    sm = step_fused<true, true, true>(Sa, m1, l1, pkA, O2, pkB, vb, vaddr, Sb, kb + 8192, qbase, kaddr);
    if (__any(!(sm <= GUARD))) slow_step<false>(MASK, Sa, kb + 8192, qbase, kaddr, vaddr, O1, m1, l1, ls, kvrel + 32, r, h, wsf, pkA);
    apply_mask(MASK, Sb, kvrel + 32, r, h); ls = l2;
    sm = step_fused<true, false, false>(Sb, m2, l2, pkB, O1, pkA, vb + 8192, vaddr, Sa, kb, qbase, kaddr);
    if (__any(!(sm <= GUARD))) slow_step<true>(MASK, Sb, kb + 8192, qbase, kaddr, vaddr, O2, m2, l2, ls, kvrel + 32, r, h, wsf, pkB);
    pv_issue(O2, pkB, vb + 8192, vaddr);
}

__device__ __forceinline__ void attn_unit(ATT_LAS unsigned char* lds, const bf16_t* Qg, const bf16_t* Kg, const bf16_t* Vg, bf16_t* Og, int b, int head, int qb, float lam, const float* subg) {
    int tid = threadIdx.x; asm volatile("" : "+v"(tid));
    const int lane = tid & 63, r = lane & 31, h = lane >> 5;
    const int w = __builtin_amdgcn_readfirstlane(tid >> 6);
    const size_t rowbase = (size_t)b * SEQ; const int q0 = qb * 256, NT = (q0 + 256) >> 6;
    const int wq = (w < 4) ? w : 11 - w;
    const char* Kt = (const char*)(Kg + rowbase * PITCH + head * 128);
    const char* Vt = (const char*)(Vg + rowbase * PITCH + head * 128);
    unsigned ksrc[2], vsrc[2];
#pragma unroll
    for (int i = 0; i < 2; ++i) { const int ii = w * 2 + i;
        { const int row = 4 * ii + (lane >> 4), pc = lane & 15; ksrc[i] = (unsigned)(row * 2048 + ((pc ^ (row & 15)) << 4)); }
        { const int row = 8 * (ii >> 1) + ((lane >> 2) & 7), ch = 4 * (2 * (ii & 1) + (lane >> 5)) + ((lane & 3) ^ ((row >> 2) & 3)); vsrc[i] = (unsigned)(row * 2048 + ch * 16); } }
    const unsigned ldsb = (unsigned)(uintptr_t)lds;
#define ATT_STAGE(t, buf) do { _Pragma("unroll") for (int i_ = 0; i_ < 2; ++i_) { \
        glds16(Kt + (size_t)(t) * 131072, ksrc[i_], (unsigned)__builtin_amdgcn_readfirstlane(ldsb + KBUF + (buf) * 16384 + (w * 2 + i_) * 1024)); \
        glds16(Vt + (size_t)(t) * 131072, vsrc[i_], (unsigned)__builtin_amdgcn_readfirstlane(ldsb + VBUF + (buf) * 16384 + (w * 2 + i_) * 1024)); } } while (0)
    ATT_STAGE(0, 0);
    { const char* Qw = (const char*)(Qg + (rowbase + q0 + wq * 32) * PITCH + head * 128);
#pragma unroll
      for (int i = 0; i < 8; ++i) { const int row = 4 * i + (lane >> 4), pc = lane & 15;
          glds16(Qw, (unsigned)(row * 2048 + ((pc ^ (row & 15)) << 4)), (unsigned)__builtin_amdgcn_readfirstlane(ldsb + QBUF + w * 8192 + i * 1024)); } }
    const ATT_LAS unsigned char* qbase = lds + QBUF + w * 8192;
    int kaddr[4], vaddr[2];
#pragma unroll
    for (int ds = 0; ds < 4; ++ds) kaddr[ds] = koffs(r, 2 * ds + h);
    { const int q = (lane & 15) >> 2, p = lane & 3, blk = (lane >> 4) & 1;
#pragma unroll
      for (int sub = 0; sub < 2; ++sub) vaddr[sub] = voffs(8 * sub + 4 * h + q, 2 * blk + (p >> 1)) + 8 * (p & 1); }
    ATT_LAS float* wsf = (ATT_LAS float*)(lds + WSF + w * 512);
    f32x16 O1[4], O2[4];
#pragma unroll
    for (int db = 0; db < 4; ++db)
#pragma unroll
        for (int i = 0; i < 16; ++i) { O1[db][i] = 0.f; O2[db][i] = 0.f; }
    float m1 = -1e30f, m2 = -1e30f, l1 = 0.f, l2 = 0.f;
    asm volatile("s_waitcnt vmcnt(0)" ::: "memory"); __syncthreads();
    for (int t = 0; t < NT; ++t) {
        const int buf = t & 1;
        if (t + 1 < NT) ATT_STAGE(t + 1, buf ^ 1);
        const int kvrel = 64 * t - q0 - 32 * wq;
        if (kvrel <= 31) {
            const ATT_LAS unsigned char* kb = lds + KBUF + buf * 16384;
            const ATT_LAS unsigned char* vb = lds + VBUF + buf * 16384;
            tile_body(kvrel + 63 > 0, kb, vb, qbase, kaddr, vaddr, O1, O2, m1, m2, l1, l2, kvrel, r, h, wsf);
        }
        asm volatile("s_waitcnt vmcnt(0)" ::: "memory"); __syncthreads();
    }
    l1 = half_sum(l1); l2 = half_sum(l2);
    if (h == 0) { wsf[r] = 1.0f / l1; wsf[32 + r] = lam / l2; }
    float sg[4];
#pragma unroll
    for (int db = 0; db < 4; ++db) sg[db] = subg[32 * db + r] * 0.8f;
    bf16_t* Ow = Og + (rowbase + q0 + wq * 32) * PITCH + head * 128 + r;
#pragma unroll
    for (int i = 0; i < 16; ++i) {
        const int qr = crow(i, h); const float a1 = wsf[qr], a2 = wsf[32 + qr];
        float o[4], ss = 0.f;
#pragma unroll
        for (int db = 0; db < 4; ++db) { o[db] = O1[db][i] * a1 - O2[db][i] * a2; ss += o[db] * o[db]; }
        ss += xor_swz<1>(ss); ss += xor_swz<2>(ss); ss += xor_swz<4>(ss); ss += xor_swz<8>(ss); ss += xor_swz<16>(ss);
        const float rs = __builtin_amdgcn_rsqf(ss * (1.0f / 128.0f) + 1e-6f);
#pragma unroll
        for (int db = 0; db < 4; ++db) Ow[(size_t)qr * PITCH + 32 * db] = (bf16_t)(cvtpk(o[db] * rs * sg[db], 0.f) & 0xffffu);
    }
#undef ATT_STAGE
}
}
constexpr int NWAVES = 8;
constexpr int BATCH = 16, SEQ = 4096, D = 1024, NH = 8, FF = 4096, INW = 5632, M = BATCH * SEQ;
constexpr float RMS_EPS = 1e-6f;
constexpr size_t MiB = 1u << 20;
constexpr size_t WS_WIN = 0, WS_WOUT = 11 * MiB, WS_WUP = 13 * MiB, WS_WDOWN = 21 * MiB, WS_WPOOL = 29 * MiB;
constexpr size_t WS_ROPE = 30 * MiB;
constexpr size_t WS_SSQ1 = 34 * MiB, WS_SSQ2 = 38 * MiB;
constexpr size_t WS_BAR = 42 * MiB, BAR_ZERO_BYTES = 32768;
constexpr size_t WS_XN = 48 * MiB;
constexpr size_t WS_Q = 176 * MiB;
constexpr size_t WS_K = 304 * MiB;
constexpr size_t WS_V = 432 * MiB;
constexpr size_t WS_U = 560 * MiB;
constexpr size_t WS_G = 624 * MiB;
constexpr size_t WS_DP = 880 * MiB;
constexpr size_t WS_Z = 176 * MiB;
constexpr size_t WS_END = 944 * MiB;
static_assert(WS_Z + (size_t)M * FF * 2 <= WS_DP && WS_DP + (size_t)M * 512 * 2 <= WS_END, "d_ws map");
constexpr int LDS_MISC_OFF = 147456 - 256;
constexpr int LDS_BYTES = 147456;

#define LAS __attribute__((address_space(3)))
typedef unsigned short bf16;
typedef unsigned v4u __attribute__((ext_vector_type(4)));
typedef float f32x4 __attribute__((ext_vector_type(4)));
__device__ __forceinline__ unsigned f2bf(float f) { unsigned u = __builtin_bit_cast(unsigned, f); return (u + 0x7fffu + ((u >> 16) & 1u)) >> 16; }
__device__ __forceinline__ unsigned pk2(float lo, float hi) { return f2bf(lo) | (f2bf(hi) << 16); }
__device__ __forceinline__ float wave_sum(float v) {
    v += xor_swz<1>(v); v += xor_swz<2>(v); v += xor_swz<4>(v); v += xor_swz<8>(v); v += xor_swz<16>(v);
    return half_sum(v);
}
template <bool WIN = false>
__device__ __forceinline__ void p0_transpose_item(const float* W, int K, int N, bf16* WT, int row_off, const float* kscale, LAS float* scr, int item, int lane) {
    const int nblk = N / 32, kb = item / nblk, nb = item % nblk, k0 = 64 * kb, n0 = 32 * nb;
#pragma unroll 8
    for (int i = 0; i < 32; ++i) { const int kk = 2 * i + (lane >> 5); float v = W[(size_t)(k0 + kk) * N + n0 + (lane & 31)]; if (kscale) v *= kscale[k0 + kk]; if (WIN && n0 + (lane & 31) >= 3584) v *= -1.4426950408889634f; scr[kk * 33 + (lane & 31)] = v; }
    asm volatile("s_waitcnt lgkmcnt(0)" ::: "memory");
    const int c = lane & 7;
#pragma unroll
    for (int j = 0; j < 4; ++j) { const int n = (lane >> 3) + 8 * j; const LAS float* s = scr + (8 * c) * 33 + n;
        v4u o; o.x = pk2(s[0 * 33], s[1 * 33]); o.y = pk2(s[2 * 33], s[3 * 33]); o.z = pk2(s[4 * 33], s[5 * 33]); o.w = pk2(s[6 * 33], s[7 * 33]);
        int nn = n0 + n;
        if (WIN && nn < 2048 && (nn & 63) < 16) { const int j = nn & 15; nn = (nn & ~15) | (2 * (j & 7) + (j >> 3)); }
        *(v4u*)(WT + (size_t)(row_off + nn) * K + k0 + 8 * c) = o; }
    asm volatile("s_waitcnt lgkmcnt(0)" ::: "memory");
}

#define XB_TMO      128
#define XB_XCNT(j)  (256  + 64 * (j))
#define XB_XSUB(j)  (1280 + 64 * (j))
#define XB_XGEN(j)  (2304 + 64 * (j))
#define XB_TOP      3328
#define XB_TOPGEN   3392
#define XCD_BAR_WORDS 3456
#define XB_SPIN_CAP (1u << 18)

__device__ __forceinline__ unsigned xb_ld(unsigned* p)              { return __hip_atomic_load(p, __ATOMIC_RELAXED, __HIP_MEMORY_SCOPE_AGENT); }
__device__ __forceinline__ unsigned xb_add(unsigned* p, unsigned v) { return __hip_atomic_fetch_add(p, v, __ATOMIC_RELAXED, __HIP_MEMORY_SCOPE_AGENT); }
__device__ __forceinline__ unsigned xb_xcc_id() { return (unsigned)__builtin_amdgcn_s_getreg((3 << 11) | 20) & 0xFu; }
#define XB_SPIN(cond, bar) do { unsigned _sp = 0; while (cond) { __builtin_amdgcn_s_sleep(1); \
    if ((++_sp & 255u) == 0u) { if (xb_ld(&(bar)[XB_TMO])) break; if (_sp > XB_SPIN_CAP) { atomicAdd(&(bar)[XB_TMO], 1u); break; } } } } while (0)

struct XcdBarrier {
    unsigned* bar; unsigned x;
    volatile LAS unsigned* st;
};

__device__ __forceinline__ XcdBarrier xcd_barrier_post(unsigned* bar, volatile LAS unsigned* st) {
    XcdBarrier b; b.bar = bar; b.x = xb_xcc_id(); b.st = st;
    if (threadIdx.x == 0) (void)xb_add(&bar[XB_XCNT(b.x)], 1u);
    return b;
}
__device__ __forceinline__ void xcd_barrier_complete(unsigned* bar, unsigned x, unsigned& nloc, unsigned& nx) {
    const unsigned G = gridDim.x * gridDim.y * gridDim.z;
    unsigned sum, cnt, mine, sp = 0u;
    for (;;) {
        sum = 0u; cnt = 0u; mine = 0u;
#pragma unroll
        for (unsigned j = 0; j < 16; ++j) { const unsigned c = xb_ld(&bar[XB_XCNT(j)]); sum += c; cnt += (c > 0u) ? 1u : 0u; mine = (j == x) ? c : mine; }
        if (sum == G) break;
        __builtin_amdgcn_s_sleep(1);
        if ((++sp & 255u) == 0u) { if (xb_ld(&bar[XB_TMO])) break; if (sp > XB_SPIN_CAP) { atomicAdd(&bar[XB_TMO], 1u); break; } }
    }
    nloc = mine > 0u ? mine : 1u; nx = cnt > 0u ? cnt : 1u;
}

__device__ __forceinline__ void xcd_barrier(const XcdBarrier& b) {
    asm volatile("s_waitcnt vmcnt(0)" ::: "memory");
    __syncthreads();
    if (threadIdx.x == 0) {
        unsigned* bar = b.bar;
        __builtin_amdgcn_s_waitcnt(0);
        unsigned nloc = b.st[0], nx = b.st[1];
        if (nloc == 0u) { xcd_barrier_complete(bar, b.x, nloc, nx); b.st[0] = nloc; b.st[1] = nx; }
        const unsigned old = xb_add(&bar[XB_XSUB(b.x)], 1u);
        const unsigned gen = old / nloc;
        if (old + 1u == (gen + 1u) * nloc) {
            __builtin_amdgcn_fence(__ATOMIC_RELEASE, "agent");
            asm volatile("s_waitcnt vmcnt(0)" ::: "memory");
            const unsigned og = xb_add(&bar[XB_TOP], 1u);
            const unsigned tg = og / nx;
            if (og + 1u == (tg + 1u) * nx) xb_add(&bar[XB_TOPGEN], 1u);
            else XB_SPIN(xb_ld(&bar[XB_TOPGEN]) == tg, bar);
            __builtin_amdgcn_fence(__ATOMIC_ACQUIRE, "agent");
            xb_add(&bar[XB_XGEN(b.x)], 1u);
            asm volatile("s_waitcnt vmcnt(0)" ::: "memory");
        } else {
            XB_SPIN(xb_ld(&bar[XB_XGEN(b.x)]) == gen, bar);
            __builtin_amdgcn_fence(__ATOMIC_ACQUIRE, "agent");
            asm volatile("s_waitcnt vmcnt(0)" ::: "memory");
        }
    }
    __syncthreads();
}

#ifndef REP_P0
#define REP_P0 1
#endif
#ifndef REP_P1
#define REP_P1 1
#endif
#ifndef REP_P2
#define REP_P2 1
#endif
#ifndef REP_P3
#define REP_P3 1
#endif
#ifndef REP_P4
#define REP_P4 1
#endif
#ifndef REP_P5
#define REP_P5 1
#endif
template <int W> __device__ __forceinline__ v4u pool_window(const bf16* up, int t) {
    v4u q[W];
#pragma unroll
    for (int j = 0; j < W; ++j) q[j] = *(const v4u*)(up - (size_t)((j <= t) ? j : 0) * 512);
    float acc[8];
#pragma unroll
    for (int e = 0; e < 8; ++e) acc[e] = 0.f;
#pragma unroll
    for (int j = 0; j < W; ++j) { const float wgt = (j <= t) ? 1.f : 0.f;
        acc[0] += wgt * pg8::bf_lo(q[j].x); acc[1] += wgt * pg8::bf_hi(q[j].x); acc[2] += wgt * pg8::bf_lo(q[j].y); acc[3] += wgt * pg8::bf_hi(q[j].y);
        acc[4] += wgt * pg8::bf_lo(q[j].z); acc[5] += wgt * pg8::bf_hi(q[j].z); acc[6] += wgt * pg8::bf_lo(q[j].w); acc[7] += wgt * pg8::bf_hi(q[j].w); }
    const float inv = 1.0f / (float)((t + 1 < W) ? (t + 1) : W);
    v4u o;
    o.x = pk2(acc[0] * inv - pg8::bf_lo(q[0].x), acc[1] * inv - pg8::bf_hi(q[0].x)); o.y = pk2(acc[2] * inv - pg8::bf_lo(q[0].y), acc[3] * inv - pg8::bf_hi(q[0].y));
    o.z = pk2(acc[4] * inv - pg8::bf_lo(q[0].z), acc[5] * inv - pg8::bf_hi(q[0].z)); o.w = pk2(acc[6] * inv - pg8::bf_lo(q[0].w), acc[7] * inv - pg8::bf_hi(q[0].w));
    return o;
}

struct Args {
    const float* x; const int* pos; const float* g_attn; const float* w_in; const float* lq1; const float* lk1; const float* lq2; const float* lk2;
    const float* subln_g; const float* w_pool; const float* pool_scale; const float* w_out; const float* g_mlp; const float* w_up; const float* w_down; const float* g_final;
    float* out; unsigned char* ws;
};

__global__ void __launch_bounds__(NWAVES * 64, 2) hybrid_fwd(Args a) {
    extern __shared__ __attribute__((aligned(16))) unsigned char lds_raw[];
    LAS unsigned char* lds = (LAS unsigned char*)lds_raw;
    cg::grid_group grid = cg::this_grid();
    if (threadIdx.x < 2) ((volatile LAS unsigned*)(lds + LDS_MISC_OFF))[threadIdx.x] = 0u;
    __syncthreads();
    const int G = gridDim.x, bx = blockIdx.x;
#define PHASE_IDS int tid = threadIdx.x; asm volatile("" : "+v"(tid)); const int lane = tid & 63, wave = __builtin_amdgcn_readfirstlane(tid >> 6); const int gw = vcu * NWAVES + wave, NGW = G * NWAVES; (void)lane; (void)gw; (void)NGW
    const int vcu = (G % 8 == 0) ? (bx % 8) * (G / 8) + bx / 8 : bx;
    unsigned char* ws = a.ws;
    bf16* Win_t = (bf16*)(ws + WS_WIN); bf16* Wout_t = (bf16*)(ws + WS_WOUT); bf16* Wup_t = (bf16*)(ws + WS_WUP); bf16* Wdown_t = (bf16*)(ws + WS_WDOWN); bf16* Wpool_t = (bf16*)(ws + WS_WPOOL);
    float* rope = (float*)(ws + WS_ROPE); float* ssq1 = (float*)(ws + WS_SSQ1); float* ssq2 = (float*)(ws + WS_SSQ2);
    bf16* XN = (bf16*)(ws + WS_XN); bf16* Qb = (bf16*)(ws + WS_Q); bf16* Kb = (bf16*)(ws + WS_K); bf16* Vb = (bf16*)(ws + WS_V);
    bf16* Ub = (bf16*)(ws + WS_U); bf16* Gb = (bf16*)(ws + WS_G); bf16* Dp = (bf16*)(ws + WS_DP); bf16* Zb = (bf16*)(ws + WS_Z); bf16* Mg = Kb; bf16* Ab = XN;

    if (bx == 0) { for (int i = threadIdx.x; i < (int)(BAR_ZERO_BYTES / 4); i += NWAVES * 64) ((unsigned*)(a.ws + WS_BAR))[i] = 0u; }
    grid.sync();
    unsigned seam_no = 0, seam2_no = 0, xc_nloc = 1, xc_ngroups = 1;
    const unsigned xcc = (unsigned)__builtin_amdgcn_s_getreg((3 << 11) | 20) & 0xFu;
    if (threadIdx.x == 0) __hip_atomic_fetch_add((unsigned*)(a.ws + WS_BAR) + 64 * (80 + xcc), 1u, __ATOMIC_RELAXED, __HIP_MEMORY_SCOPE_AGENT);
#define SEAM2() do { ++seam2_no; asm volatile("s_waitcnt vmcnt(0)" ::: "memory"); __syncthreads(); \
        if (threadIdx.x == 0) { unsigned* w_ = (unsigned*)(a.ws + WS_BAR); \
            const unsigned old_ = __hip_atomic_fetch_add(w_ + 64 * (32 + xcc), 1u, __ATOMIC_RELAXED, __HIP_MEMORY_SCOPE_AGENT); \
            if (old_ + 1u == seam2_no * xc_nloc) { \
                __builtin_amdgcn_fence(__ATOMIC_RELEASE, "agent"); asm volatile("s_waitcnt vmcnt(0)" ::: "memory"); \
                __hip_atomic_fetch_add(w_ + 64 * 64, 1u, __ATOMIC_RELAXED, __HIP_MEMORY_SCOPE_AGENT); \
                while (__hip_atomic_load(w_ + 64 * 64, __ATOMIC_RELAXED, __HIP_MEMORY_SCOPE_AGENT) < seam2_no * xc_ngroups) __builtin_amdgcn_s_sleep(1); \
                __hip_atomic_store(w_ + 64 * (48 + xcc), seam2_no, __ATOMIC_RELAXED, __HIP_MEMORY_SCOPE_AGENT); \
            } else { while (__hip_atomic_load(w_ + 64 * (48 + xcc), __ATOMIC_RELAXED, __HIP_MEMORY_SCOPE_AGENT) < seam2_no) __builtin_amdgcn_s_sleep(1); } \
            __builtin_amdgcn_fence(__ATOMIC_ACQUIRE, "agent"); asm volatile("s_waitcnt vmcnt(0)" ::: "memory"); } \
        __syncthreads(); } while (0)
#define SEAM() do { ++seam_no; asm volatile("s_waitcnt vmcnt(0)" ::: "memory"); __syncthreads(); \
        if (threadIdx.x == 0) { unsigned* w_ = (unsigned*)(a.ws + WS_BAR); const unsigned g_ = (unsigned)bx & 7u, ng_ = ((unsigned)G - g_ + 7u) / 8u, ngroups_ = (unsigned)G < 8u ? (unsigned)G : 8u; \
            __builtin_amdgcn_fence(__ATOMIC_RELEASE, "agent"); asm volatile("s_waitcnt vmcnt(0)" ::: "memory");     \
            const unsigned old_ = __hip_atomic_fetch_add(w_ + 64 * g_, 1u, __ATOMIC_RELAXED, __HIP_MEMORY_SCOPE_AGENT); \
            if (old_ + 1u == seam_no * ng_) { \
                __hip_atomic_fetch_add(w_ + 64 * 16, 1u, __ATOMIC_RELAXED, __HIP_MEMORY_SCOPE_AGENT); \
                while (__hip_atomic_load(w_ + 64 * 16, __ATOMIC_RELAXED, __HIP_MEMORY_SCOPE_AGENT) < seam_no * ngroups_) __builtin_amdgcn_s_sleep(1); \
                __hip_atomic_store(w_ + 64 * (8 + g_), seam_no, __ATOMIC_RELAXED, __HIP_MEMORY_SCOPE_AGENT); \
            } else { while (__hip_atomic_load(w_ + 64 * (8 + g_), __ATOMIC_RELAXED, __HIP_MEMORY_SCOPE_AGENT) < seam_no) __builtin_amdgcn_s_sleep(1); } \
            __builtin_amdgcn_fence(__ATOMIC_ACQUIRE, "agent"); asm volatile("s_waitcnt vmcnt(0)" ::: "memory"); } \
        __syncthreads(); } while (0)

    for (int rep_ = 0; rep_ < REP_P0; ++rep_) {
        PHASE_IDS;
        LAS float* scr = (LAS float*)(lds + wave * 16384);
        constexpr int I_IN = (D / 64) * (INW / 32), I_OUT = (D / 64) * (D / 32), I_UP = (D / 64) * (FF / 32), I_DOWN = (FF / 64) * (D / 32), I_POOL1 = (128 / 64) * (256 / 32);
        constexpr int NITEMS = I_IN + I_OUT + I_UP + I_DOWN + 4 * I_POOL1;
        for (int it = gw; it < NITEMS; it += NGW) {
            int r = it;
            if (r < I_IN) { p0_transpose_item<true>(a.w_in, D, INW, Win_t, 0, nullptr, scr, r, lane); continue; } r -= I_IN;
            if (r < I_OUT) { p0_transpose_item(a.w_out, D, D, Wout_t, 0, nullptr, scr, r, lane); continue; } r -= I_OUT;
            if (r < I_UP) { p0_transpose_item(a.w_up, D, FF, Wup_t, 0, a.g_mlp, scr, r, lane); continue; } r -= I_UP;
            if (r < I_DOWN) { p0_transpose_item(a.w_down, FF, D, Wdown_t, 0, nullptr, scr, r, lane); continue; } r -= I_DOWN;
            { const int g = r / I_POOL1; p0_transpose_item(a.w_pool + (size_t)g * 128 * 256, 128, 256, Wpool_t, g * 256, nullptr, scr, r % I_POOL1, lane); }
        }
        for (int e = bx * (NWAVES * 64) + tid; e < M * 8; e += G * NWAVES * 64) {
            const int row = e >> 3, i = e & 7;
            const float invf = (i == 0) ? 1.0f : (i == 1) ? 0.19392274474868576f : (i == 2) ? 0.03760603093086393f : (i == 3) ? 0.007292664737217109f :
                               (i == 4) ? 0.001414213562373095f : (i == 5) ? 0.0002742481756762073f : (i == 6) ? 5.318295896944988e-05f : 1.031338537721246e-05f;
            const float ang = (float)a.pos[row] * invf;
            double rev = (double)ang * 0.15915494309189535; rev -= __builtin_rint(rev);
            const float rf = (float)rev;
            rope[(size_t)e * 2] = __builtin_amdgcn_cosf(rf); rope[(size_t)e * 2 + 1] = __builtin_amdgcn_sinf(rf);
        }
        {
            const f32x4* gr = (const f32x4*)a.g_attn + lane; f32x4 gg[4];
#pragma unroll
            for (int j = 0; j < 4; ++j) gg[j] = gr[64 * j];
            for (int m0 = gw * 4; m0 < M; m0 += NGW * 4) {
                f32x4 v[4][4]; float s2[4];
#pragma unroll
                for (int q = 0; q < 4; ++q) { const f32x4* xr = (const f32x4*)(a.x + (size_t)(m0 + q) * D) + lane;
#pragma unroll
                    for (int j = 0; j < 4; ++j) v[q][j] = __builtin_nontemporal_load(xr + 64 * j); }
#pragma unroll
                for (int q = 0; q < 4; ++q) { s2[q] = 0.f;
#pragma unroll
                    for (int j = 0; j < 4; ++j) s2[q] += (v[q][j].x * v[q][j].x + v[q][j].y * v[q][j].y) + (v[q][j].z * v[q][j].z + v[q][j].w * v[q][j].w); }
#pragma unroll
                for (int q = 0; q < 4; ++q) { const float rstd = __builtin_amdgcn_rsqf(wave_sum(s2[q]) * (1.f / D) + RMS_EPS);
                    unsigned long long* o8 = (unsigned long long*)(XN + (size_t)(m0 + q) * D) + lane;
#pragma unroll
                    for (int j = 0; j < 4; ++j) { const f32x4 y = v[q][j] * rstd * gg[j];
                        o8[64 * j] = (unsigned long long)pk2(y.x, y.y) | ((unsigned long long)pk2(y.z, y.w) << 32); } }
            }
        }
    SEAM(); }
    if (threadIdx.x == 0) { unsigned ng_ = 0u;
        for (unsigned j = 0; j < 16u; ++j) { const unsigned c_ = __hip_atomic_load((unsigned*)(a.ws + WS_BAR) + 64 * (80 + j), __ATOMIC_RELAXED, __HIP_MEMORY_SCOPE_AGENT); ng_ += (c_ != 0u); if (j == xcc) xc_nloc = c_; }
        xc_ngroups = ng_; }
    for (int rep_ = 0; rep_ < REP_P1; ++rep_) {
        pg8::Gemm g{XN, Win_t, M, INW, D, 0}; pg8::StaticOrder S; S.init(M, INW, G, bx);
        pg8::EpiIn E{Qb, Kb, Vb, Ub, Gb, rope};
        pg8::gemm_phase<pg8::EpiIn, pg8::StaticOrder, true, true>(lds, g, S, E);
    SEAM2(); }


    for (int rep_ = 0; rep_ < REP_P2; ++rep_) {
        PHASE_IDS;
        for (int wi = gw; wi < M; wi += NGW) {
            const int rq = wi >> 2, gp = ((wi & 3) + (wi >> 11)) & 3;
            const int row = 4 * rq + (lane >> 4), t = row & (SEQ - 1);
            const bf16* up = Ub + (size_t)row * 512 + gp * 128 + (lane & 15) * 8;
            v4u o;
            if (gp == 0) o = pool_window<2>(up, t); else if (gp == 1) o = pool_window<4>(up, t); else if (gp == 2) o = pool_window<8>(up, t); else o = pool_window<16>(up, t);
            *(v4u*)(Dp + ((size_t)gp * M + row) * 128 + (lane & 15) * 8) = o;
        }
        const float sa = wave_sum(a.lq1[lane] * a.lk1[lane]), sb = wave_sum(a.lq2[lane] * a.lk2[lane]);
        const float lam = expf(sa) - expf(sb) + 0.2f;
        for (int pu = vcu; pu < BATCH * NH * 8; pu += G) {
            const int bh = pu >> 3, s = pu & 7, b = bh >> 3, head = bh & 7;
            for (int k = 0; k < 2; ++k) att::attn_unit(lds, Qb, Kb, Vb, Ab, b, head, k ? s : 15 - s, lam, a.subln_g);
        }
    SEAM2(); }

    for (int rep_ = 0; rep_ < REP_P3; ++rep_) {
        pg8::Gemm g{Dp, Wpool_t, M, D, 128, (size_t)M * 128 * 2}; pg8::StaticOrder S; S.init(M, D, G, bx);
        pg8::EpiMerge E{Ab, Gb, a.pool_scale, Mg};
        pg8::gemm_phase<pg8::EpiMerge, pg8::StaticOrder, true, true>(lds, g, S, E);
    SEAM2(); }

    for (int rep_ = 0; rep_ < REP_P4; ++rep_) {
        pg8::Gemm g{Mg, Wout_t, M, D, D, 0}; pg8::StaticOrder S; S.init(M, D, G, bx);
        pg8::EpiResA E{a.x, XN, ssq1};
        pg8::gemm_phase<pg8::EpiResA, pg8::StaticOrder, true, true>(lds, g, S, E);
    SEAM2(); }

    for (int rep_ = 0; rep_ < REP_P5; ++rep_) {
        pg8::Gemm g{XN, Wup_t, M, FF, D, 0}; pg8::StaticOrder S; S.init(M, FF, G, bx);
        pg8::EpiUp E{ssq1, Zb};
        pg8::gemm_phase<pg8::EpiUp, pg8::StaticOrder, true, true>(lds, g, S, E);
    SEAM2(); }

    {
        pg8::Gemm g{Zb, Wdown_t, M, D, FF, 0}; pg8::StaticOrder S; S.init(M, D, G, bx);
        pg8::EpiResB E{XN, ssq2};
        pg8::gemm_phase<pg8::EpiResB, pg8::StaticOrder, true, true>(lds, g, S, E);
    }
    SEAM2();

    { PHASE_IDS;
    const f32x4* gr = (const f32x4*)a.g_final + lane; f32x4 gg[4];
#pragma unroll
    for (int j = 0; j < 4; ++j) gg[j] = gr[64 * j];
    for (int m0 = gw * 4; m0 < M; m0 += NGW * 4) {
        unsigned long long v[4][4]; float s[4];
#pragma unroll
        for (int q = 0; q < 4; ++q) { const unsigned long long* xr = (const unsigned long long*)(XN + (size_t)(m0 + q) * D) + lane; s[q] = ssq2[(size_t)(m0 + q) * 16 + (lane & 15)];
#pragma unroll
            for (int j = 0; j < 4; ++j) v[q][j] = __builtin_nontemporal_load(xr + 64 * j); }
#pragma unroll
        for (int q = 0; q < 4; ++q) { float t = s[q]; t += xor_swz<1>(t); t += xor_swz<2>(t); t += xor_swz<4>(t); t += xor_swz<8>(t);
            const float rstd = __builtin_amdgcn_rsqf(t * (1.f / D) + RMS_EPS);
            f32x4* xr = (f32x4*)(a.out + (size_t)(m0 + q) * D) + lane;
#pragma unroll
            for (int j = 0; j < 4; ++j) { const unsigned lo = (unsigned)v[q][j], hi = (unsigned)(v[q][j] >> 32);
                const f32x4 x = (f32x4){pg8::bf_lo(lo), pg8::bf_hi(lo), pg8::bf_lo(hi), pg8::bf_hi(hi)};
                __builtin_nontemporal_store(x * rstd * gg[j], xr + 64 * j); } }
    } }
}

extern "C" void kernel_launch(void* const* d_in, const int* in_sizes, int n_in, void* d_out, int out_size, void* d_ws, size_t ws_size, hipStream_t stream) {
    static int grid = 0;
    if (grid == 0) {
        if (n_in != 16 || in_sizes[0] != M * D || out_size != M * D || ws_size < WS_END) { fprintf(stderr, "kernel_launch: unexpected shapes (n_in %d, in0 %d, out %d, ws %zu); nothing launched\n", n_in, n_in > 0 ? in_sizes[0] : -1, out_size, ws_size); grid = -1; return; }
        int dev = 0, cus = 0, per_cu = 0;
        if (hipGetDevice(&dev) != hipSuccess || hipDeviceGetAttribute(&cus, hipDeviceAttributeMultiprocessorCount, dev) != hipSuccess) { grid = -1; return; }
        if (hipFuncSetAttribute((const void*)hybrid_fwd, hipFuncAttributeMaxDynamicSharedMemorySize, LDS_BYTES) != hipSuccess) { fprintf(stderr, "kernel_launch: hipFuncSetAttribute failed\n"); grid = -1; return; }
        if (hipOccupancyMaxActiveBlocksPerMultiprocessor(&per_cu, (const void*)hybrid_fwd, NWAVES * 64, LDS_BYTES) != hipSuccess || per_cu < 1) per_cu = 1;
        (void)hipGetLastError();
        grid = cus * per_cu;
    }
    if (grid < 0) return;
    Args a{};
    a.x = (const float*)d_in[0]; a.pos = (const int*)d_in[1]; a.g_attn = (const float*)d_in[2]; a.w_in = (const float*)d_in[3];
    a.lq1 = (const float*)d_in[4]; a.lk1 = (const float*)d_in[5]; a.lq2 = (const float*)d_in[6]; a.lk2 = (const float*)d_in[7];
    a.subln_g = (const float*)d_in[8]; a.w_pool = (const float*)d_in[9]; a.pool_scale = (const float*)d_in[10]; a.w_out = (const float*)d_in[11];
    a.g_mlp = (const float*)d_in[12]; a.w_up = (const float*)d_in[13]; a.w_down = (const float*)d_in[14]; a.g_final = (const float*)d_in[15];
    a.out = (float*)d_out; a.ws = (unsigned char*)d_ws;
    void* args[] = {&a};
    const hipError_t e = hipLaunchCooperativeKernel((const void*)hybrid_fwd, dim3(grid), dim3(NWAVES * 64), args, LDS_BYTES, stream);
    if (e != hipSuccess) fprintf(stderr, "kernel_launch: cooperative launch failed: %s (grid %d)\n", hipGetErrorString(e), grid);
}
```
